# Optimizing an MI355X kernel written in HIP

```python
import math
import jax, jax.numpy as jnp
from jax import lax
import numpy as np

D_MODEL = 1024
BATCH = 8
SEQ = 2048
DEPTH = 2

GRID_W = 64
CTX_LEN = 256
QBLOCK = 128
ROPE_BASE = 10000.0
EPS = 1e-6
RNN_WIDTH = D_MODEL
RNN_BLOCKS = 8
RNN_BLOCK_W = RNN_WIDTH // RNN_BLOCKS
CONV_W = 4
LRU_C = 8.0
MLA_HEADS = 16
MLA_Q_RANK = 3 * D_MODEL // 8
MLA_KV_RANK = D_MODEL // 4
MLA_NOPE = 64
MLA_ROPE = 32
MLA_V = 64
MLA_SCALE = (MLA_NOPE + MLA_ROPE) ** -0.5
DIFF_HEADS = 8
DIFF_HD = 64
DIFF_V = 2 * DIFF_HD
DIFF_SCALE = DIFF_HD ** -0.5
FFN_HIDDEN = -(-8 * D_MODEL // (3 * 256)) * 256
N_BRANCH = 3
IN_SPLITS = (RNN_WIDTH, RNN_WIDTH, MLA_Q_RANK, MLA_KV_RANK, MLA_ROPE,
             DIFF_HEADS * 2 * DIFF_HD, DIFF_HEADS * 2 * DIFF_HD, DIFF_HEADS * DIFF_V,
             N_BRANCH * D_MODEL)
IN_COLS = sum(IN_SPLITS)

kernel_name = "hybrid_rglru_mla_diffattn_dit_prefix"


def _rmsnorm(x, g):
    xf = x.astype(jnp.float32)
    y = xf * lax.rsqrt(jnp.mean(xf * xf, axis=-1, keepdims=True) + EPS)
    return (y * g.astype(jnp.float32)).astype(x.dtype)


def _split_cols(p, sizes):
    idx = np.cumsum(sizes)[:-1].tolist()
    return jnp.split(p, idx, axis=-1)


def _axial_rope_tables(T, rot_dim):
    rows = T // GRID_W
    row_ids = jnp.repeat(jnp.arange(rows, dtype=jnp.float32), GRID_W)
    col_ids = jnp.tile(jnp.arange(GRID_W, dtype=jnp.float32), rows)
    n = rot_dim // 4
    freqs = ROPE_BASE ** (-jnp.arange(n, dtype=jnp.float32) / n)
    ang = jnp.concatenate([row_ids[:, None] * freqs, col_ids[:, None] * freqs], axis=-1)
    return jnp.cos(ang), jnp.sin(ang)


def _apply_rope(x, cos, sin):
    shp = x.shape
    xf = x.astype(jnp.float32).reshape(shp[:-1] + (shp[-1] // 2, 2))
    bshape = (1, cos.shape[0]) + (1,) * (x.ndim - 3) + (cos.shape[1],)
    c = cos.reshape(bshape)
    s = sin.reshape(bshape)
    x1, x2 = xf[..., 0], xf[..., 1]
    out = jnp.stack([x1 * c - x2 * s, x1 * s + x2 * c], axis=-1)
    return out.reshape(shp).astype(x.dtype)


def _attention(q, k, v, mix_w, scale):
    B, Tq, M, H, dk = q.shape
    nb = Tq // QBLOCK
    qb = jnp.moveaxis(q.reshape(B, nb, QBLOCK, M, H, dk), 1, 0)
    w = mix_w.astype(jnp.float32)

    def block(qi):
        s = jnp.einsum('bqmhd,bkmhd->bmhqk', qi, k).astype(jnp.float32) * scale
        p = jnp.einsum('m,bmhqk->bhqk', w, jax.nn.softmax(s, axis=-1))
        return jnp.einsum('bhqk,bkhd->bqhd', p.astype(v.dtype), v)

    o = lax.map(block, qb)
    return jnp.moveaxis(o, 0, 1).reshape(B, Tq, H, v.shape[-1])


def _centred_dwconv(x, w, b):
    T = x.shape[1]
    left = CONV_W // 2
    xp = jnp.pad(x, ((0, 0), (left, CONV_W - 1 - left), (0, 0)))
    y = b + xp[:, 0:T] * w[0]
    for j in range(1, CONV_W):
        y = y + xp[:, j:j + T] * w[j]
    return y


def _lru_coeffs(x, wa, ba, wi, bi, lam):
    B, T, W = x.shape
    xb = x.reshape(B, T, RNN_BLOCKS, RNN_BLOCK_W)
    gr = jnp.einsum('btnc,rncd->rbtnd', xb, wa).reshape(2, B, T, W) + ba[:, None, None, :]
    gi = jnp.einsum('btnc,rncd->rbtnd', xb, wi).reshape(2, B, T, W) + bi[:, None, None, :]
    r = jax.nn.sigmoid(gr.astype(jnp.float32))
    i = jax.nn.sigmoid(gi.astype(jnp.float32))
    log_a = -LRU_C * r * jax.nn.softplus(-lam.astype(jnp.float32))[:, None, None, :]
    a = jnp.exp(log_a)
    b = jnp.sqrt(-jnp.expm1(2.0 * log_a)) * i * x.astype(jnp.float32)
    return a, b


def _scan_combine(e1, e2):
    a1, b1 = e1
    a2, b2 = e2
    return a1 * a2, a2 * b1 + b2


def _linear_scan(a, b, reverse, h0=None):
    a_cum, h = lax.associative_scan(_scan_combine, (a, b), reverse=reverse, axis=1)
    if h0 is not None:
        h = h + a_cum * h0[:, None, :]
    return h


def _mla_q(cq, lp, rope):
    B, T, _ = cq.shape
    q = (_rmsnorm(cq, lp['mla_qn_g']) @ lp['mla_w_uq']).reshape(B, T, MLA_HEADS, MLA_NOPE + MLA_ROPE)
    q = _rmsnorm(q, lp['mla_q_g'])
    if rope is not None:
        q = jnp.concatenate([q[..., :MLA_NOPE], _apply_rope(q[..., MLA_NOPE:], *rope)], axis=-1)
    return q[:, :, None]


def _mla_kv(ckv, kr, lp, rope):
    B, T, _ = ckv.shape
    kv = (_rmsnorm(ckv, lp['mla_kvn_g']) @ lp['mla_w_ukv']).reshape(B, T, MLA_HEADS, MLA_NOPE + MLA_V)
    k = jnp.concatenate([kv[..., :MLA_NOPE],
                         jnp.broadcast_to(kr[:, :, None, :], (B, T, MLA_HEADS, MLA_ROPE))], axis=-1)
    k = _rmsnorm(k, lp['mla_k_g'])
    if rope is not None:
        k = jnp.concatenate([k[..., :MLA_NOPE], _apply_rope(k[..., MLA_NOPE:], *rope)], axis=-1)
    return k[:, :, None], kv[..., MLA_NOPE:]


def _diff_qk(t, g, rope):
    B, T, _ = t.shape
    u = jnp.moveaxis(t.reshape(B, T, DIFF_HEADS, 2, DIFF_HD), 3, 2)
    u = _rmsnorm(u, g)
    if rope is not None:
        u = _apply_rope(u, *rope)
    return u


def _merge(y_a, rg, o_b, o_c, mg, lp, lam_init):
    B, T, _ = rg.shape
    br_a = (y_a.astype(rg.dtype) * jax.nn.gelu(rg)) @ lp['w_br_a']
    br_b = o_b.reshape(B, T, MLA_HEADS * MLA_V) @ lp['w_br_b']
    oc = _rmsnorm(o_c, lp['diff_subln_g']) * (1.0 - lam_init)
    br_c = oc.reshape(B, T, DIFF_HEADS * DIFF_V) @ lp['w_br_c']
    ga, gb, gc = jnp.split(jax.nn.sigmoid(mg), N_BRANCH, axis=-1)
    return (ga * br_a + gb * br_b + gc * br_c) @ lp['w_out']


def _ffn(h, lp):
    gate, up = jnp.split(h @ lp['w_ffn_in'], 2, axis=-1)
    return (jax.nn.silu(gate) * up) @ lp['w_ffn_out']


def _layer(x, xc, mod, mod_c, lp, rope_mla, rope_diff, lam_init, need_ctx):
    sh1, sc1, g1, sh2, sc2, g2 = jnp.split(mod, 6, axis=-1)
    csh1, csc1, cg1, csh2, csc2, cg2 = jnp.split(mod_c, 6, axis=-1)
    h = _rmsnorm(x, lp['norm1_g']) * (1.0 + sc1) + sh1
    hc = _rmsnorm(xc, lp['norm1_g']) * (1.0 + csc1) + csh1
    rx, rg, cq, ckv, kr, dq, dk, dv, mg = _split_cols(h @ lp['w_in'], IN_SPLITS)
    rxc, rgc, cqc, ckvc, krc, dqc, dkc, dvc, mgc = _split_cols(hc @ lp['w_in'], IN_SPLITS)
    B, T, _ = x.shape
    C = xc.shape[1]

    a, b = _lru_coeffs(_centred_dwconv(rx, lp['conv_w'], lp['conv_b']),
                       lp['lru_wa'], lp['lru_ba'], lp['lru_wi'], lp['lru_bi'], lp['lru_lambda'])
    ac, bc = _lru_coeffs(_centred_dwconv(rxc, lp['conv_w'], lp['conv_b']),
                         lp['lru_wa'], lp['lru_ba'], lp['lru_wi'], lp['lru_bi'], lp['lru_lambda'])
    hcf = _linear_scan(ac[0], bc[0], False)
    hcb = _linear_scan(ac[1], bc[1], True)
    y_a = _linear_scan(a[0], b[0], False, hcf[:, -1]) + _linear_scan(a[1], b[1], True, hcb[:, 0])

    k_l, v_l = _mla_kv(ckv, kr, lp, rope_mla)
    k_c, v_c = _mla_kv(ckvc, krc, lp, None)
    ones1 = jnp.ones((1,), jnp.float32)
    o_b = _attention(_mla_q(cq, lp, rope_mla), jnp.concatenate([k_l, k_c], axis=1),
                     jnp.concatenate([v_l, v_c], axis=1), ones1, MLA_SCALE)

    dl = lp['diff_lambda'].astype(jnp.float32)
    lam = jnp.exp(jnp.sum(dl[0] * dl[1])) - jnp.exp(jnp.sum(dl[2] * dl[3])) + lam_init
    wc = jnp.stack([jnp.ones((), jnp.float32), -lam])
    kd_l = _diff_qk(dk, lp['diff_k_g'], rope_diff)
    kd_c = _diff_qk(dkc, lp['diff_k_g'], None)
    vd_l = dv.reshape(B, T, DIFF_HEADS, DIFF_V)
    vd_c = dvc.reshape(B, C, DIFF_HEADS, DIFF_V)
    o_c = _attention(_diff_qk(dq, lp['diff_q_g'], rope_diff), jnp.concatenate([kd_l, kd_c], axis=1),
                     jnp.concatenate([vd_l, vd_c], axis=1), wc, DIFF_SCALE)

    x = x + g1 * _merge(y_a, rg, o_b, o_c, mg, lp, lam_init)
    x = x + g2 * _ffn(_rmsnorm(x, lp['norm2_g']) * (1.0 + sc2) + sh2, lp)

    if need_ctx:
        o_bc = _attention(_mla_q(cqc, lp, None), k_c, v_c, ones1, MLA_SCALE)
        o_cc = _attention(_diff_qk(dqc, lp['diff_q_g'], None), kd_c, vd_c, wc, DIFF_SCALE)
        xc = xc + cg1 * _merge(hcf + hcb, rgc, o_bc, o_cc, mgc, lp, lam_init)
        xc = xc + cg2 * _ffn(_rmsnorm(xc, lp['norm2_g']) * (1.0 + csc2) + csh2, lp)
    return x, xc


def setup_inputs(seed: int = 0) -> dict:
    key = jax.random.key(seed)
    ks = iter(jax.random.split(key, 40))
    L = DEPTH
    f32 = jnp.float32

    def nrm(shape, fan_in):
        return jax.random.normal(next(ks), shape, f32) * fan_in ** -0.5

    def gain(shape):
        return 1.0 + 0.02 * jax.random.normal(next(ks), shape, f32)

    def small(shape):
        return 0.01 * jax.random.normal(next(ks), shape, f32)

    u = jax.random.uniform(next(ks), (L, 2, RNN_WIDTH), f32, 0.9, 0.999)
    a0 = u ** (1.0 / LRU_C)
    lru_lambda = jnp.log(a0) - jnp.log1p(-a0)
    return {
        'x': jax.random.normal(next(ks), (BATCH, SEQ, D_MODEL), f32),
        'c': jax.random.normal(next(ks), (BATCH, D_MODEL), f32),
        'ctx': jax.random.normal(next(ks), (BATCH, CTX_LEN, D_MODEL), f32),
        'c_ctx': jax.random.normal(next(ks), (D_MODEL,), f32),
        'w_mod': nrm((L, D_MODEL, 6 * D_MODEL), D_MODEL),
        'b_mod': small((L, 6 * D_MODEL)),
        'norm1_g': gain((L, D_MODEL)),
        'norm2_g': gain((L, D_MODEL)),
        'w_in': nrm((L, D_MODEL, IN_COLS), D_MODEL),
        'conv_w': nrm((L, CONV_W, RNN_WIDTH), CONV_W),
        'conv_b': small((L, RNN_WIDTH)),
        'lru_wa': nrm((L, 2, RNN_BLOCKS, RNN_BLOCK_W, RNN_BLOCK_W), RNN_BLOCK_W),
        'lru_ba': small((L, 2, RNN_WIDTH)),
        'lru_wi': nrm((L, 2, RNN_BLOCKS, RNN_BLOCK_W, RNN_BLOCK_W), RNN_BLOCK_W),
        'lru_bi': small((L, 2, RNN_WIDTH)),
        'lru_lambda': lru_lambda,
        'mla_qn_g': gain((L, MLA_Q_RANK)),
        'mla_w_uq': nrm((L, MLA_Q_RANK, MLA_HEADS * (MLA_NOPE + MLA_ROPE)), MLA_Q_RANK),
        'mla_kvn_g': gain((L, MLA_KV_RANK)),
        'mla_w_ukv': nrm((L, MLA_KV_RANK, MLA_HEADS * (MLA_NOPE + MLA_V)), MLA_KV_RANK),
        'mla_q_g': gain((L, MLA_NOPE + MLA_ROPE)),
        'mla_k_g': gain((L, MLA_NOPE + MLA_ROPE)),
        'diff_q_g': gain((L, DIFF_HD)),
        'diff_k_g': gain((L, DIFF_HD)),
        'diff_lambda': 0.1 * jax.random.normal(next(ks), (L, 4, DIFF_HD), f32),
        'diff_subln_g': gain((L, DIFF_V)),
        'w_br_a': nrm((L, RNN_WIDTH, D_MODEL), RNN_WIDTH),
        'w_br_b': nrm((L, MLA_HEADS * MLA_V, D_MODEL), MLA_HEADS * MLA_V),
        'w_br_c': nrm((L, DIFF_HEADS * DIFF_V, D_MODEL), DIFF_HEADS * DIFF_V),
        'w_out': nrm((L, D_MODEL, D_MODEL), D_MODEL),
        'w_ffn_in': nrm((L, D_MODEL, 2 * FFN_HIDDEN), D_MODEL),
        'w_ffn_out': nrm((L, FFN_HIDDEN, D_MODEL), FFN_HIDDEN),
    }


def reference(x, c, ctx, c_ctx, w_mod, b_mod, norm1_g, norm2_g, w_in, conv_w, conv_b,
              lru_wa, lru_ba, lru_wi, lru_bi, lru_lambda, mla_qn_g, mla_w_uq, mla_kvn_g,
              mla_w_ukv, mla_q_g, mla_k_g, diff_q_g, diff_k_g, diff_lambda, diff_subln_g,
              w_br_a, w_br_b, w_br_c, w_out, w_ffn_in, w_ffn_out):
    T = x.shape[1]
    rope_mla = _axial_rope_tables(T, MLA_ROPE)
    rope_diff = _axial_rope_tables(T, DIFF_HD)
    xc = ctx
    sc = jax.nn.silu(c)
    scc = jax.nn.silu(c_ctx)
    for l in range(DEPTH):
        lp = dict(norm1_g=norm1_g[l], norm2_g=norm2_g[l], w_in=w_in[l], conv_w=conv_w[l],
                  conv_b=conv_b[l], lru_wa=lru_wa[l], lru_ba=lru_ba[l], lru_wi=lru_wi[l],
                  lru_bi=lru_bi[l], lru_lambda=lru_lambda[l], mla_qn_g=mla_qn_g[l],
                  mla_w_uq=mla_w_uq[l], mla_kvn_g=mla_kvn_g[l], mla_w_ukv=mla_w_ukv[l],
                  mla_q_g=mla_q_g[l], mla_k_g=mla_k_g[l], diff_q_g=diff_q_g[l],
                  diff_k_g=diff_k_g[l], diff_lambda=diff_lambda[l], diff_subln_g=diff_subln_g[l],
                  w_br_a=w_br_a[l], w_br_b=w_br_b[l], w_br_c=w_br_c[l], w_out=w_out[l],
                  w_ffn_in=w_ffn_in[l], w_ffn_out=w_ffn_out[l])
        mod = (sc @ w_mod[l] + b_mod[l])[:, None, :]
        mod_c = scc @ w_mod[l] + b_mod[l]
        lam_init = 0.8 - 0.6 * math.exp(-0.3 * l)
        x, xc = _layer(x, xc, mod, mod_c, lp, rope_mla, rope_diff, lam_init, l < DEPTH - 1)
    return x
```

```cpp
#include <hip/hip_runtime.h>
#include <hip/hip_cooperative_groups.h>
#include <cstdio>
#include <cstdint>
namespace cg = cooperative_groups;

#ifndef ONE_LAUNCH
#define ONE_LAUNCH 1
#endif

typedef unsigned short bf16_t;
typedef short bf16x8 __attribute__((ext_vector_type(8)));
typedef float f32x4 __attribute__((ext_vector_type(4)));
typedef float f32x16 __attribute__((ext_vector_type(16)));
#define DI __device__ __forceinline__

constexpr int D = 1024, T = 2048, CT = 256, HB = 4;
constexpr int ML = HB * T;
constexpr int MC = HB * CT;
constexpr int MH = ML + MC;
constexpr int NKEY = T + CT;
constexpr int N1 = 5888;
constexpr int FH = 2816;
constexpr int INC = 8864;
constexpr float EPS = 1e-6f;
constexpr float LOG2E = 1.4426950408889634f;

constexpr size_t al(size_t x) { return (x + 255) & ~(size_t)255; }
constexpr size_t OFF_MOD = 0;
constexpr size_t OFF_RM = al(OFF_MOD + 2 * 9 * 6144 * 4);
constexpr size_t OFF_RD = al(OFF_RM + 2 * 2048 * 16 * 4);
constexpr size_t OFF_LAM = al(OFF_RD + 2 * 2048 * 32 * 4);
constexpr size_t OFF_BAR = al(OFF_LAM + 256);
constexpr size_t OFF_CTR = OFF_BAR + 3456 * 4;
constexpr size_t OFF_CARRY = al(OFF_CTR + 2048);
constexpr size_t OFF_XC = al(OFF_CARRY + (size_t)HB * 2 * 18 * 1024 * 8);
constexpr size_t OFF_WIN = al(OFF_XC + (size_t)2048 * 1024 * 4);
constexpr size_t OFF_WMG = al(OFF_WIN + (size_t)N1 * 1024 * 2);
constexpr size_t OFF_WUQ = al(OFF_WMG + (size_t)3072 * 1024 * 2);
constexpr size_t OFF_WUKV = al(OFF_WUQ + (size_t)1536 * 384 * 2);
constexpr size_t OFF_WLRU = al(OFF_WUKV + (size_t)2048 * 256 * 2);
constexpr size_t OFF_WBRA = al(OFF_WLRU + (size_t)4096 * 128 * 2);
constexpr size_t OFF_WBRB = al(OFF_WBRA + (size_t)1024 * 1024 * 2);
constexpr size_t OFF_WBRC = al(OFF_WBRB + (size_t)1024 * 1024 * 2);
constexpr size_t OFF_WOUT = al(OFF_WBRC + (size_t)1024 * 1024 * 2);
constexpr size_t OFF_WFI = al(OFF_WOUT + (size_t)1024 * 1024 * 2);
constexpr size_t OFF_WFO = al(OFF_WFI + (size_t)5632 * 1024 * 2);
constexpr size_t OFF_HBF = al(OFF_WFO + (size_t)1024 * FH * 2);
constexpr size_t SZ1K = (size_t)MH * 1024 * 2;
constexpr size_t OFF_RX = al(OFF_HBF + SZ1K);
constexpr size_t OFF_GRG = al(OFF_RX + SZ1K);
constexpr size_t OFF_CQKV = al(OFF_GRG + SZ1K);
constexpr size_t OFF_DQ = al(OFF_CQKV + (size_t)MH * 768 * 2);
constexpr size_t OFF_DK = al(OFF_DQ + SZ1K);
constexpr size_t OFF_DVT = al(OFF_DK + SZ1K);
constexpr size_t OFF_KM = al(OFF_DVT + SZ1K);
constexpr size_t OFF_VMT = al(OFF_KM + (size_t)MH * 1536 * 2);
constexpr size_t OFF_QM = al(OFF_VMT + SZ1K);
constexpr size_t OFF_OB = al(OFF_QM + (size_t)MH * 1536 * 2);
constexpr size_t OFF_XCV = al(OFF_OB + SZ1K);
constexpr size_t WS_NEED = al(OFF_XCV + SZ1K);
static_assert(OFF_DK == OFF_DQ + SZ1K && OFF_DVT == OFF_DK + SZ1K, "HH alias needs contiguous DQ/DK/DVT");
static_assert((size_t)MH * FH * 2 <= 3 * SZ1K, "HH alias size");

constexpr int LDS_BYTES = 73728 + 1024 + 3072 + 32;
constexpr int LDS_BAR = 73728 + 1024 + 3072;
constexpr int LDS_RS = 73728, LDS_SEG = 73728 + 1024;

struct Params {
  const float *x, *c, *ctx, *c_ctx, *w_mod, *b_mod, *norm1_g, *norm2_g, *w_in, *conv_w, *conv_b, *lru_wa, *lru_ba, *lru_wi, *lru_bi,
      *lru_lambda, *mla_qn_g, *mla_w_uq, *mla_kvn_g, *mla_w_ukv, *mla_q_g, *mla_k_g, *diff_q_g, *diff_k_g, *diff_lambda, *diff_subln_g,
      *w_br_a, *w_br_b, *w_br_c, *w_out, *w_ffn_in, *w_ffn_out;
  float* out;
  char* ws;
};

DI int tidx() { int t = __builtin_amdgcn_workitem_id_x(); asm volatile("" : "+v"(t)); return t; }
DI float bf2f(unsigned short u) { return __uint_as_float(((unsigned)u) << 16); }
DI unsigned short f2bf(float x) { unsigned u = __float_as_uint(x); u += 0x7fffu + ((u >> 16) & 1u); return (unsigned short)(u >> 16); }
typedef __bf16 bf16n2 __attribute__((ext_vector_type(2)));
typedef float f32x2n __attribute__((ext_vector_type(2)));
DI unsigned pack2(float lo, float hi) { const f32x2n v = {lo, hi}; return __builtin_bit_cast(unsigned, __builtin_convertvector(v, bf16n2)); }
DI float lo2f(unsigned u) { return __uint_as_float(u << 16); }
DI float hi2f(unsigned u) { return __uint_as_float(u & 0xffff0000u); }
DI float sigmoidf_(float x) { return 1.0f / (1.0f + __expf(-x)); }
DI float siluf_(float x) { return x * sigmoidf_(x); }
DI float geluf_(float x) { const float u = 0.7978845608028654f * (x + 0.044715f * x * x * x); return 0.5f * x * (1.0f + tanhf(u)); }
DI int perm16(int o) { return (o & 3) | ((o & 4) << 1) | ((o & 8) >> 1); }
DI int keypos(int kk) { return (kk & ~15) | perm16(kk & 15); }
struct RowInfo { int bl, t, isctx; };
DI RowInfo rowinfo(int lr) { RowInfo r; if (lr < ML) { r.bl = lr >> 11; r.t = lr & 2047; r.isctx = 0; } else { const int q = lr - ML; r.bl = q >> 8; r.t = q & 255; r.isctx = 1; } return r; }
DI float* resid_ptr(const Params& P, int half, int lr) {
  return lr < ML ? P.out + ((size_t)half * ML + lr) * D : (float*)(P.ws + OFF_XC) + ((size_t)half * MC + (lr - ML)) * D;
}
DI const float* input_ptr(const Params& P, int half, int lr) {
  return lr < ML ? P.x + ((size_t)half * ML + lr) * D : P.ctx + ((size_t)half * MC + (lr - ML)) * D;
}
DI float lam_init_of(int l) { return l == 0 ? 0.2f : 0.35550906f; }

typedef __attribute__((address_space(3))) unsigned lds_u32_t;
#define GLDS16(gsrc, ldst) __builtin_amdgcn_global_load_lds((const unsigned*)(gsrc), (lds_u32_t*)(ldst), 16, 0, 0)
DI void gemm_core_ring2(f32x4 (&acc)[4][2], const bf16_t* __restrict__ A, int lda, const bf16_t* __restrict__ W, int ldw, int K, char* lds) {
  constexpr int NT = 2, STAGE = 24576;
  const int tid = tidx(), lane = tid & 63, wid = tid >> 6, wr = wid >> 1, wc = wid & 1, fr = lane & 15, fq = lane >> 4;
  const int crow = tid >> 3, csrc = (tid & 7) ^ ((crow >> 1) & 7);
  const int nk = K >> 6;
  const bf16_t* ap = A + (size_t)crow * lda + csrc * 8;
  const bf16_t* wp = W + (size_t)crow * ldw + csrc * 8;
  const int sw = (fr >> 1) & 7;
  const int wbase = __builtin_amdgcn_readfirstlane(wid) * 1024;
#define RING_STAGE(KT, BUF) do { char* a_ = lds + (BUF) * STAGE + wbase; char* w_ = a_ + 16384; \
    _Pragma("unroll") for (int i = 0; i < 4; ++i) GLDS16(ap + (size_t)(32 * i) * lda + (KT) * 64, a_ + i * 4096); \
    _Pragma("unroll") for (int i = 0; i < NT; ++i) GLDS16(wp + (size_t)(32 * i) * ldw + (KT) * 64, w_ + i * 4096); } while (0)
  RING_STAGE(0, 0); RING_STAGE(1, 1);
  int buf = 0, nbuf = 2;
  for (int j = 0; j < nk; ++j) {
    if (j + 1 < nk) asm volatile("s_waitcnt vmcnt(6)" ::: "memory"); else asm volatile("s_waitcnt vmcnt(0)" ::: "memory");
    asm volatile("s_waitcnt lgkmcnt(0)" ::: "memory");
    __builtin_amdgcn_s_barrier();
    asm volatile("" ::: "memory");
    if (j + 2 < nk) RING_STAGE(j + 2, nbuf);
    {
      const char* a = lds + buf * STAGE; const char* w = a + 16384;
      bf16x8 bf0[4], af0[NT], bf1[4], af1[NT];
      { const int co = ((0 * 4 + fq) ^ sw) * 16;
#pragma unroll
        for (int mi = 0; mi < 4; ++mi) bf0[mi] = *(const bf16x8*)(a + (wr * 64 + mi * 16 + fr) * 128 + co);
#pragma unroll
        for (int ni = 0; ni < NT; ++ni) af0[ni] = *(const bf16x8*)(w + (wc * NT * 16 + ni * 16 + fr) * 128 + co); }
      { const int co = ((1 * 4 + fq) ^ sw) * 16;
#pragma unroll
        for (int mi = 0; mi < 4; ++mi) bf1[mi] = *(const bf16x8*)(a + (wr * 64 + mi * 16 + fr) * 128 + co);
#pragma unroll
        for (int ni = 0; ni < NT; ++ni) af1[ni] = *(const bf16x8*)(w + (wc * NT * 16 + ni * 16 + fr) * 128 + co); }
#pragma unroll
      for (int mi = 0; mi < 4; ++mi)
#pragma unroll
        for (int ni = 0; ni < NT; ++ni) acc[mi][ni] = __builtin_amdgcn_mfma_f32_16x16x32_bf16(af0[ni], bf0[mi], acc[mi][ni], 0, 0, 0);
#pragma unroll
      for (int mi = 0; mi < 4; ++mi)
#pragma unroll
        for (int ni = 0; ni < NT; ++ni) acc[mi][ni] = __builtin_amdgcn_mfma_f32_16x16x32_bf16(af1[ni], bf1[mi], acc[mi][ni], 0, 0, 0);
    }
    buf = (buf == 2) ? 0 : buf + 1; nbuf = (nbuf == 2) ? 0 : nbuf + 1;
  }
  __syncthreads();
#undef RING_STAGE
}
template <int NT>
DI void gemm_core(f32x4 (&acc)[4][NT], const bf16_t* __restrict__ A, int lda, const bf16_t* __restrict__ W, int ldw, int K, char* lds) {
  if constexpr (NT == 2) { gemm_core_ring2(acc, A, lda, W, ldw, K, lds); return; }
  constexpr int STAGE = 32768;
  const int tid = tidx(), lane = tid & 63, wid = tid >> 6, wr = wid >> 1, wc = wid & 1, fr = lane & 15, fq = lane >> 4;
  const int crow = tid >> 3, csrc = (tid & 7) ^ ((crow >> 1) & 7);
  const int nk = K >> 6;
  const bf16_t* ap = A + (size_t)crow * lda + csrc * 8;
  const bf16_t* wp = W + (size_t)crow * ldw + csrc * 8;
  const int sw = (fr >> 1) & 7;
  const int wbase = __builtin_amdgcn_readfirstlane(wid) * 1024;
#define GEMM_STAGE(KT, BUF) do { char* a_ = lds + (BUF) * STAGE + wbase; char* w_ = a_ + 16384; \
    _Pragma("unroll") for (int i = 0; i < 4; ++i) GLDS16(ap + (size_t)(32 * i) * lda + (KT) * 64, a_ + i * 4096); \
    _Pragma("unroll") for (int i = 0; i < NT; ++i) GLDS16(wp + (size_t)(32 * i) * ldw + (KT) * 64, w_ + i * 4096); } while (0)
#define GEMM_LDFR(BUF, KS, BF, AF) do { const char* a = lds + (BUF) * STAGE; const char* w = a + 16384; const int co = (((KS) * 4 + fq) ^ sw) * 16; \
      _Pragma("unroll") for (int mi = 0; mi < 4; ++mi) BF[mi] = *(const bf16x8*)(a + (wr * 64 + mi * 16 + fr) * 128 + co); \
      _Pragma("unroll") for (int ni = 0; ni < NT; ++ni) AF[ni] = *(const bf16x8*)(w + (wc * NT * 16 + ni * 16 + fr) * 128 + co); } while (0)
#define GEMM_MMA(BF, AF) do { \
      _Pragma("unroll") for (int mi = 0; mi < 4; ++mi) \
        _Pragma("unroll") for (int ni = 0; ni < NT; ++ni) acc[mi][ni] = __builtin_amdgcn_mfma_f32_16x16x32_bf16(AF[ni], BF[mi], acc[mi][ni], 0, 0, 0); } while (0)
#define GEMM_COMPUTE(BUF) do { bf16x8 bf0[4], af0[NT], bf1[4], af1[NT]; \
    GEMM_LDFR(BUF, 0, bf0, af0); \
    __builtin_amdgcn_sched_barrier(0); \
    GEMM_LDFR(BUF, 1, bf1, af1); \
    GEMM_MMA(bf0, af0); \
    __builtin_amdgcn_sched_barrier(0); \
    GEMM_MMA(bf1, af1); } while (0)
  GEMM_STAGE(0, 0);
  __syncthreads();
  for (int kt = 0; kt + 1 < nk; ++kt) {
    GEMM_STAGE(kt + 1, (kt + 1) & 1);
    GEMM_COMPUTE(kt & 1);
    __syncthreads();
  }
  GEMM_COMPUTE((nk - 1) & 1);
  __syncthreads();
#undef GEMM_COMPUTE
#undef GEMM_MMA
#undef GEMM_LDFR
#undef GEMM_STAGE
}
template <int NT> DI void zero_acc(f32x4 (&acc)[4][NT]) {
#pragma unroll
  for (int mi = 0; mi < 4; ++mi)
#pragma unroll
    for (int ni = 0; ni < NT; ++ni) acc[mi][ni] = (f32x4){0.f, 0.f, 0.f, 0.f};
}
DI float ssq8(uint4 v) { const float a = lo2f(v.x), b = hi2f(v.x), c = lo2f(v.y), d = hi2f(v.y), e = lo2f(v.z), f = hi2f(v.z), g = lo2f(v.w), h = hi2f(v.w); return a * a + b * b + c * c + d * d + e * e + f * f + g * g + h * h; }
DI void store4bf(bf16_t* p, f32x4 v) { uint2 w; w.x = pack2(v[0], v[1]); w.y = pack2(v[2], v[3]); *(uint2*)p = w; }

template <int K>
DI void row_rstd_table(const bf16_t* A, int lda, char* lds) {
  const int tid = tidx(), row = tid >> 1, hf = tid & 1;
  const bf16_t* p = A + (size_t)row * lda + hf * (K >> 1);
  float ss = 0.f;
#pragma unroll
  for (int i0 = 0; i0 < (K >> 4); i0 += 8) {
    uint4 v[8];
#pragma unroll
    for (int i = 0; i < 8; ++i) v[i] = *(const uint4*)(p + (i0 + i) * 8);
#pragma unroll
    for (int i = 0; i < 8; ++i) ss += ssq8(v[i]);
  }
  ss += __shfl_xor(ss, 1);
  if (hf == 0) ((float*)(lds + LDS_RS))[row] = rsqrtf(ss / (float)K + EPS);
}

DI void phase0(const Params& P, char* lds) {
  const int tid = tidx(), lane = tid & 63, wid = tid >> 6;
  float* sil = (float*)lds;
  float* part = (float*)(lds + 9 * 1024 * 4);
  float* MOD = (float*)(P.ws + OFF_MOD);
  for (int u = blockIdx.x; u < 192 + 384 + 1; u += gridDim.x) {
    if (u < 192) {
      const int l = u / 96, cg_ = u % 96;
      __syncthreads();
      for (int i = tid; i < 9 * 1024; i += 256) { const int r = i >> 10, k = i & 1023; const float v = r < 8 ? P.c[r * 1024 + k] : P.c_ctx[k]; sil[i] = siluf_(v); }
      __syncthreads();
      float acc[9];
#pragma unroll
      for (int r = 0; r < 9; ++r) acc[r] = 0.f;
      const float* wm = P.w_mod + (size_t)l * 1024 * 6144 + cg_ * 64 + lane;
      for (int k = wid * 256; k < wid * 256 + 256; k += 8) {
        float w[8];
#pragma unroll
        for (int e = 0; e < 8; ++e) w[e] = wm[(size_t)(k + e) * 6144];
#pragma unroll
        for (int e = 0; e < 8; ++e)
#pragma unroll
          for (int r = 0; r < 9; ++r) acc[r] += sil[r * 1024 + k + e] * w[e];
      }
#pragma unroll
      for (int r = 0; r < 9; ++r) part[(wid * 9 + r) * 64 + lane] = acc[r];
      __syncthreads();
      for (int i = tid; i < 9 * 64; i += 256) {
        const int r = i >> 6, cc = i & 63;
        const float s = part[(0 * 9 + r) * 64 + cc] + part[(1 * 9 + r) * 64 + cc] + part[(2 * 9 + r) * 64 + cc] + part[(3 * 9 + r) * 64 + cc];
        MOD[((size_t)l * 9 + r) * 6144 + cg_ * 64 + cc] = s + P.b_mod[l * 6144 + cg_ * 64 + cc];
      }
    } else if (u < 192 + 384) {
      const int i = (u - 192) * 256 + tid;
      const int t = i / 48, e = i % 48;
      const float rowid = (float)(t >> 6), colid = (float)(t & 63);
      if (e < 16) {
        const int fi = e & 7; const float fr_ = powf(10000.0f, -(float)fi / 8.0f);
        const float ang = (e < 8 ? rowid : colid) * fr_;
        ((float*)(P.ws + OFF_RM))[t * 16 + e] = cosf(ang);
        ((float*)(P.ws + OFF_RM))[2048 * 16 + t * 16 + e] = sinf(ang);
      } else {
        const int e2 = e - 16, fi = e2 & 15; const float fr_ = powf(10000.0f, -(float)fi / 16.0f);
        const float ang = (e2 < 16 ? rowid : colid) * fr_;
        ((float*)(P.ws + OFF_RD))[t * 32 + e2] = cosf(ang);
        ((float*)(P.ws + OFF_RD))[2048 * 32 + t * 32 + e2] = sinf(ang);
      }
    } else {
      if (tid < 2) {
        const float* dl = P.diff_lambda + tid * 256;
        float s1 = 0.f, s2 = 0.f;
        for (int i = 0; i < 64; ++i) { s1 += dl[i] * dl[64 + i]; s2 += dl[128 + i] * dl[192 + i]; }
        ((float*)(P.ws + OFF_LAM))[tid] = expf(s1) - expf(s2) + lam_init_of(tid);
      }
    }
  }
}

constexpr int CT_WIN = (N1 / 64) * 16, CT_WMG = CT_WIN + 48 * 16, CT_WUQ = CT_WMG + 24 * 6, CT_WUKV = CT_WUQ + 32 * 4, CT_WLRU = CT_WUKV + 64 * 2,
              CT_WBR = CT_WLRU + 4 * 16 * 16, CT_WFI = CT_WBR + 88 * 16, CT_WFO = CT_WFI + 16 * 44;
DI void convert_weights(const Params& P, int l, char* lds) {
  const int tid = tidx();
  bf16_t* tl = (bf16_t*)lds;
  for (int t = blockIdx.x; t < CT_WFO; t += gridDim.x) {
    int m, lt, NTl, K; bf16_t* dst; const float* sbase; int sstride; const float* kscale = nullptr;
    if (t < CT_WIN) { m = 0; lt = t; NTl = N1 / 64; K = 1024; dst = (bf16_t*)(P.ws + OFF_WIN); sbase = P.w_in + (size_t)l * 1024 * INC; sstride = INC; }
    else if (t < CT_WMG) { m = 1; lt = t - CT_WIN; NTl = 48; K = 1024; dst = (bf16_t*)(P.ws + OFF_WMG); sbase = P.w_in + (size_t)l * 1024 * INC; sstride = INC; }
    else if (t < CT_WUQ) { m = 2; lt = t - CT_WMG; NTl = 24; K = 384; dst = (bf16_t*)(P.ws + OFF_WUQ); sbase = P.mla_w_uq + (size_t)l * 384 * 1536; sstride = 1536; kscale = P.mla_qn_g + l * 384; }
    else if (t < CT_WUKV) { m = 3; lt = t - CT_WUQ; NTl = 32; K = 256; dst = (bf16_t*)(P.ws + OFF_WUKV); sbase = P.mla_w_ukv + (size_t)l * 256 * 2048; sstride = 2048; kscale = P.mla_kvn_g + l * 256; }
    else if (t < CT_WLRU) { m = 4; lt = t - CT_WUKV; NTl = 64; K = 128; dst = (bf16_t*)(P.ws + OFF_WLRU); sbase = nullptr; sstride = 128; }
    else if (t < CT_WBR) { const int q = t - CT_WLRU; const int mm = q >> 8; m = 5; lt = q & 255; NTl = 16; K = 1024; dst = (bf16_t*)(P.ws + OFF_WBRA + (size_t)mm * (OFF_WBRB - OFF_WBRA));
      sbase = (mm == 0 ? P.w_br_a : mm == 1 ? P.w_br_b : mm == 2 ? P.w_br_c : P.w_out) + (size_t)l * 1024 * 1024; sstride = 1024; }
    else if (t < CT_WFI) { m = 6; lt = t - CT_WBR; NTl = 88; K = 1024; dst = (bf16_t*)(P.ws + OFF_WFI); sbase = P.w_ffn_in + (size_t)l * 1024 * 5632; sstride = 5632; }
    else { m = 7; lt = t - CT_WFI; NTl = 16; K = FH; dst = (bf16_t*)(P.ws + OFF_WFO); sbase = P.w_ffn_out + (size_t)l * FH * 1024; sstride = 1024; }
    const int tn = lt % NTl, tk = lt / NTl;
    const int n = tn * 64 + (tid & 15) * 4;
    int sc = n; const float* sb = sbase;
    if (m == 0) { if (n < 2048) sc = n; else if (n < 2816) { const int j = n - 2048; sc = j < 672 ? 2048 + j : -1; } else sc = 2720 + (n - 2816); }
    else if (m == 1) sc = 5792 + n;
    else if (m == 4) { const int blk = n >> 9, r = (n >> 8) & 1, q4 = (n >> 6) & 3, g32 = (n >> 5) & 1, gate = (n >> 4) & 1, cc = n & 15;
      sb = (gate ? P.lru_wi : P.lru_wa) + (((size_t)l * 2 + r) * 8 + blk) * 128 * 128; sc = q4 * 32 + g32 * 16 + cc; }
    else if (m == 6) { const int tn2 = n >> 7, c16 = (n >> 5) & 3, gate = (n >> 4) & 1, cc = n & 15; sc = gate * FH + tn2 * 64 + c16 * 16 + cc; }
    __syncthreads();
#pragma unroll
    for (int p = 0; p < 4; ++p) {
      const int kl = (tid >> 4) + 16 * p, k = tk * 64 + kl;
      f32x4 v = {0.f, 0.f, 0.f, 0.f};
      if (sc >= 0) v = *(const f32x4*)(sb + (size_t)k * sstride + sc);
      if (kscale) v = v * kscale[k];
      const int nl = (tid & 15) * 4;
      tl[(nl + 0) * 72 + kl] = f2bf(v[0]); tl[(nl + 1) * 72 + kl] = f2bf(v[1]); tl[(nl + 2) * 72 + kl] = f2bf(v[2]); tl[(nl + 3) * 72 + kl] = f2bf(v[3]);
    }
    __syncthreads();
    {
      const int nl = tid >> 2, kc = (tid & 3) * 16;
      const uint4 a = *(const uint4*)(tl + nl * 72 + kc), b2 = *(const uint4*)(tl + nl * 72 + kc + 8);
      bf16_t* d = dst + (size_t)(tn * 64 + nl) * K + tk * 64 + kc;
      *(uint4*)d = a; *(uint4*)(d + 8) = b2;
    }
  }
}
static_assert(OFF_WBRC - OFF_WBRB == OFF_WBRB - OFF_WBRA && OFF_WOUT - OFF_WBRC == OFF_WBRB - OFF_WBRA, "br weights equally spaced");

DI void norm_phase(const Params& P, int l, int half_, int which  , int nrows, int rph = 0  ) {
  const int lane = tidx() & 63, wid = tidx() >> 6;
  const float* g = (which == 0 ? P.norm1_g : P.norm2_g) + l * 1024;
  const float* MOD = (const float*)(P.ws + OFF_MOD) + (size_t)l * 9 * 6144;
  bf16_t* H = (bf16_t*)(P.ws + OFF_HBF);
  for (int grow = blockIdx.x * 4 + wid; grow < nrows; grow += gridDim.x * 4) {
    const int half = rph ? grow / rph : half_, row = rph ? grow % rph : grow;
    const RowInfo ri = rowinfo(row);
    const float* src = (which == 0 && l == 0) ? input_ptr(P, half, row) : resid_ptr(P, half, row);
    const float* md = MOD + (size_t)(ri.isctx ? 8 : half * HB + ri.bl) * 6144 + (which == 0 ? 0 : 3072);
    f32x4 v[4]; float ss = 0.f;
#pragma unroll
    for (int i = 0; i < 4; ++i) { v[i] = *(const f32x4*)(src + i * 256 + lane * 4); ss += v[i][0] * v[i][0] + v[i][1] * v[i][1] + v[i][2] * v[i][2] + v[i][3] * v[i][3]; }
#pragma unroll
    for (int o = 1; o < 64; o <<= 1) ss += __shfl_xor(ss, o);
    const float rstd = rsqrtf(ss * (1.0f / 1024.0f) + EPS);
#pragma unroll
    for (int i = 0; i < 4; ++i) {
      const int c0 = i * 256 + lane * 4;
      const f32x4 gg = *(const f32x4*)(g + c0), sh = *(const f32x4*)(md + c0), sc = *(const f32x4*)(md + 1024 + c0);
      f32x4 o;
#pragma unroll
      for (int j = 0; j < 4; ++j) o[j] = v[i][j] * rstd * gg[j] * (1.0f + sc[j]) + sh[j];
      store4bf(H + (size_t)grow * 1024 + c0, o);
    }
  }
}

DI void g1_phase(const Params& P, int l, int half, char* lds) {
  const int tid = tidx(), lane = tid & 63, wid = tid >> 6, wr = wid >> 1, wc = wid & 1, fr = lane & 15, fq = lane >> 4;
  const bf16_t* H = (const bf16_t*)(P.ws + OFF_HBF);
  const bf16_t* W = (const bf16_t*)(P.ws + OFF_WIN);
  const float* RDc = (const float*)(P.ws + OFF_RD); const float* RDs = RDc + 2048 * 32;
  constexpr int MT = MH / 128, NTL = N1 / 128;
  for (int u = blockIdx.x; u < MT * NTL; u += gridDim.x) {
    const int tn = u / MT, tm = u % MT;
    f32x4 acc[4][4]; zero_acc<4>(acc);
    gemm_core<4>(acc, H + (size_t)tm * 128 * 1024, 1024, W + (size_t)tn * 128 * 1024, 1024, 1024, lds);
    const int rowb = tm * 128 + wr * 64 + fr;
    if (tn < 8) {
      bf16_t* O = (bf16_t*)(P.ws + OFF_RX);
#pragma unroll
      for (int mi = 0; mi < 4; ++mi)
#pragma unroll
        for (int ni = 0; ni < 4; ++ni) store4bf(O + (size_t)(rowb + mi * 16) * 1024 + tn * 128 + wc * 64 + ni * 16 + fq * 4, acc[mi][ni]);
    } else if (tn < 16) {
      bf16_t* O = (bf16_t*)(P.ws + OFF_GRG);
#pragma unroll
      for (int mi = 0; mi < 4; ++mi)
#pragma unroll
        for (int ni = 0; ni < 4; ++ni) { f32x4 v = acc[mi][ni];
#pragma unroll
          for (int j = 0; j < 4; ++j) v[j] = geluf_(v[j]);
          store4bf(O + (size_t)(rowb + mi * 16) * 1024 + (tn - 8) * 128 + wc * 64 + ni * 16 + fq * 4, v); }
    } else if (tn < 22) {
      bf16_t* O = (bf16_t*)(P.ws + OFF_CQKV);
#pragma unroll
      for (int mi = 0; mi < 4; ++mi)
#pragma unroll
        for (int ni = 0; ni < 4; ++ni) store4bf(O + (size_t)(rowb + mi * 16) * 768 + (tn - 16) * 128 + wc * 64 + ni * 16 + fq * 4, acc[mi][ni]);
    } else if (tn < 38) {
      const int isk = tn >= 30; const int tl = isk ? tn - 30 : tn - 22;
      bf16_t* O = (bf16_t*)(P.ws + (isk ? OFF_DK : OFF_DQ));
      const float* g = (isk ? P.diff_k_g : P.diff_q_g) + l * 64;
#pragma unroll
      for (int mi = 0; mi < 4; ++mi) {
        const int row = rowb + mi * 16; const RowInfo ri = rowinfo(row);
        float ss = 0.f;
#pragma unroll
        for (int ni = 0; ni < 4; ++ni)
#pragma unroll
          for (int j = 0; j < 4; ++j) ss += acc[mi][ni][j] * acc[mi][ni][j];
        ss += __shfl_xor(ss, 16); ss += __shfl_xor(ss, 32);
        const float rstd = rsqrtf(ss * (1.0f / 64.0f) + EPS);
#pragma unroll
        for (int ni = 0; ni < 4; ++ni) {
          const int d0 = ni * 16 + fq * 4;
          const f32x4 gg = *(const f32x4*)(g + d0);
          f32x4 y;
#pragma unroll
          for (int j = 0; j < 4; ++j) y[j] = acc[mi][ni][j] * rstd * gg[j];
          if (!ri.isctx) {
            const int pi = d0 >> 1;
            const float c0 = RDc[ri.t * 32 + pi], s0 = RDs[ri.t * 32 + pi], c1 = RDc[ri.t * 32 + pi + 1], s1 = RDs[ri.t * 32 + pi + 1];
            const float a0 = y[0] * c0 - y[1] * s0, a1 = y[0] * s0 + y[1] * c0, a2 = y[2] * c1 - y[3] * s1, a3 = y[2] * s1 + y[3] * c1;
            y = (f32x4){a0, a1, a2, a3};
          }
          store4bf(O + (size_t)row * 1024 + tl * 128 + wc * 64 + d0, y);
        }
      }
    } else {
      bf16_t* O = (bf16_t*)(P.ws + OFF_DVT);
      const int h = tn - 38;
#pragma unroll
      for (int mi = 0; mi < 4; ++mi) {
        const int row = rowb + mi * 16; const RowInfo ri = rowinfo(row);
        const int pos = keypos(ri.isctx ? 2048 + ri.t : ri.t);
        bf16_t* ob = O + ((size_t)(ri.bl * 8 + h) * 128) * NKEY + pos;
#pragma unroll
        for (int ni = 0; ni < 4; ++ni)
#pragma unroll
          for (int j = 0; j < 4; ++j) ob[(size_t)(wc * 64 + ni * 16 + fq * 4 + j) * NKEY] = f2bf(acc[mi][ni][j]);
      }
    }
  }
}

template <int CTRL> DI float dppf(float old, float v) { return __int_as_float(__builtin_amdgcn_update_dpp(__float_as_int(old), __float_as_int(v), CTRL, 0xf, 0xf, false)); }
template <int R> DI void row_scan(float& a, float& b) {
  constexpr int B0 = R == 0 ? 0x110 : 0x100;
  { const float ap = dppf<B0 + 1>(1.0f, a), bp = dppf<B0 + 1>(0.0f, b); b = a * bp + b; a = a * ap; }
  { const float ap = dppf<B0 + 2>(1.0f, a), bp = dppf<B0 + 2>(0.0f, b); b = a * bp + b; a = a * ap; }
  { const float ap = dppf<B0 + 4>(1.0f, a), bp = dppf<B0 + 4>(0.0f, b); b = a * bp + b; a = a * ap; }
  { const float ap = dppf<B0 + 8>(1.0f, a), bp = dppf<B0 + 8>(0.0f, b); b = a * bp + b; a = a * ap; }
}
DI void conv_items(const Params& P, int l, int item0, int nitems) {
  const bf16_t* RX = (const bf16_t*)(P.ws + OFF_RX);
  bf16_t* XV = (bf16_t*)(P.ws + OFF_XCV);
  const int it = item0 + tidx();
  if (it >= nitems) return;
  const int row0 = (it >> 7) * 8, ch = (it & 127) * 8;
  const RowInfo ri = rowinfo(row0); const int Tseq = ri.isctx ? 256 : 2048;
  uint4 tv[11];
#pragma unroll
  for (int i = 0; i < 11; ++i) {
    const int tt = ri.t + i - 2; const bool ok = tt >= 0 && tt < Tseq;
    const uint4 v = *(const uint4*)(RX + (size_t)(row0 + (ok ? i - 2 : 0)) * 1024 + ch);
    tv[i] = ok ? v : make_uint4(0u, 0u, 0u, 0u);
  }
  float cwf[4][8], bias[8];
#pragma unroll
  for (int e = 0; e < 8; ++e) bias[e] = P.conv_b[l * 1024 + ch + e];
#pragma unroll
  for (int j = 0; j < 4; ++j)
#pragma unroll
    for (int e = 0; e < 8; ++e) cwf[j][e] = P.conv_w[((size_t)l * 4 + j) * 1024 + ch + e];
#pragma unroll
  for (int o = 0; o < 8; ++o) {
    float a8[8];
#pragma unroll
    for (int e = 0; e < 8; ++e) a8[e] = bias[e];
#pragma unroll
    for (int j = 0; j < 4; ++j) {
      const unsigned w[4] = {tv[o + j].x, tv[o + j].y, tv[o + j].z, tv[o + j].w};
#pragma unroll
      for (int e = 0; e < 4; ++e) { a8[2 * e] += lo2f(w[e]) * cwf[j][2 * e]; a8[2 * e + 1] += hi2f(w[e]) * cwf[j][2 * e + 1]; }
    }
    uint4 ov; ov.x = pack2(a8[0], a8[1]); ov.y = pack2(a8[2], a8[3]); ov.z = pack2(a8[4], a8[5]); ov.w = pack2(a8[6], a8[7]);
    *(uint4*)(XV + (size_t)(row0 + o) * 1024 + ch) = ov;
  }
}

template <int R>
DI void lru_seq_step(const Params& P, int l, int row0, int blk, int q4, bool need_out, float (&hcar)[4], const char* As, const char* Wsb, char* lds, int next_row0, bool has_next) {
  const int tid = tidx(), lane = tid & 63, wid = tid >> 6, wr = wid >> 1, wc = wid & 1, fr = lane & 15, fq = lane >> 4;
  float2* XW = (float2*)(lds + LDS_SEG);
  const int chq = wc * 16 + fq * 4, chg = blk * 128 + q4 * 32 + chq;
  bf16_t* TMP = (bf16_t*)(P.ws + OFF_RX);
  bf16_t* GRG = (bf16_t*)(P.ws + OFF_GRG);
  uint2 pf[4], pg[4];
  if (R == 1 && need_out) {
#pragma unroll
    for (int mi = 0; mi < 4; ++mi) { const size_t o = (size_t)(row0 + wr * 64 + mi * 16 + fr) * 1024 + chg; pf[mi] = *(const uint2*)(TMP + o); pg[mi] = *(const uint2*)(GRG + o); }
  }
  asm volatile("s_waitcnt vmcnt(0)" ::: "memory");
  __syncthreads();
  f32x4 acc[4][2]; zero_acc<2>(acc);
#pragma unroll
  for (int ks = 0; ks < 4; ++ks) {
    bf16x8 bfr[4], afr[2];
#pragma unroll
    for (int mi = 0; mi < 4; ++mi) bfr[mi] = *(const bf16x8*)(As + (wr * 64 + mi * 16 + fr) * 256 + (((ks * 4 + fq) ^ fr) * 16));
#pragma unroll
    for (int ni = 0; ni < 2; ++ni) afr[ni] = *(const bf16x8*)(Wsb + (wc * 32 + ni * 16 + fr) * 256 + (((ks * 4 + fq) ^ fr) * 16));
#pragma unroll
    for (int mi = 0; mi < 4; ++mi)
#pragma unroll
      for (int ni = 0; ni < 2; ++ni) acc[mi][ni] = __builtin_amdgcn_mfma_f32_16x16x32_bf16(afr[ni], bfr[mi], acc[mi][ni], 0, 0, 0);
  }
  float xcv[4][4];
#pragma unroll
  for (int mi = 0; mi < 4; ++mi) {
    const int tok = wr * 64 + mi * 16 + fr;
    const uint2 x2 = *(const uint2*)(As + tok * 256 + (((q4 * 4 + wc * 2 + (fq >> 1)) ^ fr) * 16) + (fq & 1) * 8);
    xcv[mi][0] = lo2f(x2.x); xcv[mi][1] = hi2f(x2.x); xcv[mi][2] = lo2f(x2.y); xcv[mi][3] = hi2f(x2.y);
  }
  float spl[4], bav[4], biv[4];
  {
    const f32x4* PRM = (const f32x4*)(lds + LDS_SEG + 1024);
#pragma unroll
    for (int j = 0; j < 4; ++j) { const f32x4 pv = PRM[R * 32 + chq + j]; spl[j] = pv[0]; bav[j] = pv[1]; biv[j] = pv[2]; }
  }
  asm volatile("s_waitcnt lgkmcnt(0)" ::: "memory");
  __syncthreads();
  if (has_next) {
    const bf16_t* XV = (const bf16_t*)(P.ws + OFF_XCV);
    const int wbase = __builtin_amdgcn_readfirstlane(wid) * 1024;
    const int xrow = tid >> 4, xsrc = (tid & 15) ^ (xrow & 15);
#pragma unroll
    for (int i = 0; i < 8; ++i) GLDS16(XV + (size_t)(next_row0 + xrow + 16 * i) * 1024 + blk * 128 + xsrc * 8, (char*)As + wbase + i * 4096);
  }
  float av[4][4], bv[4][4];
#pragma unroll
  for (int mi = 0; mi < 4; ++mi)
#pragma unroll
    for (int j = 0; j < 4; ++j) {
      const float sr = __builtin_amdgcn_rcpf(1.0f + __expf(-(acc[mi][0][j] + bav[j]))), si = __builtin_amdgcn_rcpf(1.0f + __expf(-(acc[mi][1][j] + biv[j])));
      const float la = -8.0f * sr * spl[j];
      const float a = __expf(la);
      av[mi][j] = a; bv[mi][j] = __builtin_amdgcn_sqrtf(fmaxf(0.f, 1.0f - a * a)) * si * xcv[mi][j];
    }
  const int endlane = (lane & ~15) | (R == 0 ? 15 : 0);
  float Ac[4][4], Bc[4][4], Aw[4], Bw[4];
#pragma unroll
  for (int j = 0; j < 4; ++j) { Aw[j] = 1.f; Bw[j] = 0.f; }
#pragma unroll
  for (int m = 0; m < 4; ++m) {
    const int mi = R == 0 ? m : 3 - m;
#pragma unroll
    for (int j = 0; j < 4; ++j) {
      row_scan<R>(av[mi][j], bv[mi][j]);
      const float At = __shfl(av[mi][j], endlane), Bt = __shfl(bv[mi][j], endlane);
      Ac[mi][j] = Aw[j]; Bc[mi][j] = Bw[j];
      Bw[j] = At * Bw[j] + Bt; Aw[j] = At * Aw[j];
    }
  }
  if (fr == 0) {
#pragma unroll
    for (int j = 0; j < 4; ++j) XW[wr * 32 + chq + j] = make_float2(Aw[j], Bw[j]);
  }
  asm volatile("s_waitcnt lgkmcnt(0)" ::: "memory");
  __builtin_amdgcn_s_barrier();
  asm volatile("" ::: "memory");
  const int first = R == 0 ? 0 : 1;
#pragma unroll
  for (int j = 0; j < 4; ++j) {
    const float2 e0 = XW[first * 32 + chq + j], e1 = XW[(1 - first) * 32 + chq + j];
    const float hw = (wr == first) ? hcar[j] : e0.x * hcar[j] + e0.y;
    float hout[4];
#pragma unroll
    for (int mi = 0; mi < 4; ++mi) { const float hb = Ac[mi][j] * hw + Bc[mi][j]; hout[mi] = av[mi][j] * hb + bv[mi][j]; }
#pragma unroll
    for (int mi = 0; mi < 4; ++mi) av[mi][j] = hout[mi];
    hcar[j] = e1.x * (e0.x * hcar[j] + e0.y) + e1.y;
  }
  if (need_out) {
#pragma unroll
    for (int mi = 0; mi < 4; ++mi) {
      const size_t o = (size_t)(row0 + wr * 64 + mi * 16 + fr) * 1024 + chg;
      if (R == 0) { store4bf(TMP + o, (f32x4){av[mi][0], av[mi][1], av[mi][2], av[mi][3]}); }
      else {
        const f32x4 y = {(av[mi][0] + lo2f(pf[mi].x)) * lo2f(pg[mi].x), (av[mi][1] + hi2f(pf[mi].x)) * hi2f(pg[mi].x),
                         (av[mi][2] + lo2f(pf[mi].y)) * lo2f(pg[mi].y), (av[mi][3] + hi2f(pf[mi].y)) * hi2f(pg[mi].y)};
        store4bf(GRG + o, y);
      }
    }
  }
}
DI void lru_seq_unit(const Params& P, int l, int u, char* lds) {
  const int tid = tidx(), wid = tid >> 6;
  const int bl = u >> 5, blk = (u >> 2) & 7, q4 = u & 3;
  const bf16_t* WL = (const bf16_t*)(P.ws + OFF_WLRU);
  const bf16_t* XV = (const bf16_t*)(P.ws + OFF_XCV);
  char* As = lds;
  char* Wb = lds + 32768;
  __syncthreads();
  const int wbase = __builtin_amdgcn_readfirstlane(wid) * 1024;
  {
    const int wrow = tid >> 4, wsrc = (tid & 15) ^ (wrow & 15);
#pragma unroll
    for (int r = 0; r < 2; ++r) {
      const bf16_t* ws_ = WL + (size_t)(blk * 512 + r * 256 + q4 * 64 + wrow) * 128 + wsrc * 8;
#pragma unroll
      for (int i = 0; i < 4; ++i) GLDS16(ws_ + (size_t)(16 * i) * 128, Wb + r * 16384 + wbase + i * 4096);
    }
    if (tid < 64) {
      const int r = tid >> 5, c = tid & 31, ch = blk * 128 + q4 * 32 + c;
      const float lm = P.lru_lambda[(l * 2 + r) * 1024 + ch];
      const float sp_ = (lm > 15.f) ? __expf(-lm) : log1pf(__expf(-lm));
      ((f32x4*)(lds + LDS_SEG + 1024))[tid] = (f32x4){sp_, P.lru_ba[(l * 2 + r) * 1024 + ch], P.lru_bi[(l * 2 + r) * 1024 + ch], 0.f};
    }
    const int xrow = tid >> 4, xsrc = (tid & 15) ^ (xrow & 15);
    const int r0 = ML + bl * 256;
#pragma unroll
    for (int i = 0; i < 8; ++i) GLDS16(XV + (size_t)(r0 + xrow + 16 * i) * 1024 + blk * 128 + xsrc * 8, As + wbase + i * 4096);
  }
  const bool ctx_out = (l == 0);
  float hcar[4] = {0.f, 0.f, 0.f, 0.f};
  for (int s = 0; s < 18; ++s) {
    const int row0 = s < 2 ? ML + bl * 256 + s * 128 : bl * 2048 + (s - 2) * 128;
    const int sn = s + 1;
    const int nrow0 = sn < 18 ? (sn < 2 ? ML + bl * 256 + sn * 128 : bl * 2048 + (sn - 2) * 128) : ML + bl * 256 + 128;
    lru_seq_step<0>(P, l, row0, blk, q4, s >= 2 || ctx_out, hcar, As, Wb, lds, nrow0, true);
  }
#pragma unroll
  for (int j = 0; j < 4; ++j) hcar[j] = 0.f;
  for (int s = 0; s < 18; ++s) {
    const int row0 = s < 2 ? ML + bl * 256 + (1 - s) * 128 : bl * 2048 + (15 - (s - 2)) * 128;
    const int sn = s + 1;
    const int nrow0 = sn < 2 ? ML + bl * 256 + (1 - sn) * 128 : bl * 2048 + (15 - (sn - 2)) * 128;
    lru_seq_step<1>(P, l, row0, blk, q4, s >= 2 || ctx_out, hcar, As, Wb + 16384, lds, nrow0, sn < 18);
  }
  asm volatile("s_waitcnt vmcnt(0)" ::: "memory");
  __syncthreads();
}

DI void pc_phase(const Params& P, int l, int half, char* lds) {
  const int tid = tidx(), lane = tid & 63, wid = tid >> 6, wr = wid >> 1, wc = wid & 1, fr = lane & 15, fq = lane >> 4;
  constexpr int MT = MH / 128;
  constexpr int NU_LRU = (MH / 8) * 128 / 256, NU_UQ = MT * 12, NU_UKV = MT * 16;
  const bf16_t* CQKV = (const bf16_t*)(P.ws + OFF_CQKV);
  const float* rs = (const float*)(lds + LDS_RS);
  const float* RMc = (const float*)(P.ws + OFF_RM); const float* RMs = RMc + 2048 * 16;
  for (int u = blockIdx.x; u < NU_LRU + NU_UQ + NU_UKV; u += gridDim.x) {
    if (u < NU_LRU) { conv_items(P, l, u * 256, (MH / 8) * 128); continue; }
    if (u < NU_LRU + NU_UQ) {
      const int v = u - NU_LRU, tn = v / MT, tm = v % MT;
      const bf16_t* A = CQKV + (size_t)tm * 128 * 768;
      __syncthreads();
      row_rstd_table<384>(A, 768, lds);
      f32x4 acc[4][4]; zero_acc<4>(acc);
      gemm_core<4>(acc, A, 768, (const bf16_t*)(P.ws + OFF_WUQ) + (size_t)tn * 128 * 384, 384, 384, lds);
      bf16_t* O = (bf16_t*)(P.ws + OFF_QM);
#pragma unroll
      for (int mi = 0; mi < 4; ++mi) {
        const int rl = wr * 64 + mi * 16 + fr; const float s = rs[rl];
#pragma unroll
        for (int ni = 0; ni < 4; ++ni) store4bf(O + (size_t)(tm * 128 + rl) * 1536 + tn * 128 + wc * 64 + ni * 16 + fq * 4, acc[mi][ni] * s);
      }
    } else {
      const int v = u - NU_LRU - NU_UQ, h = v / MT, tm = v % MT;
      const bf16_t* A = CQKV + (size_t)tm * 128 * 768 + 384;
      __syncthreads();
      row_rstd_table<256>(A, 768, lds);
      f32x4 acc[4][4]; zero_acc<4>(acc);
      gemm_core<4>(acc, A, 768, (const bf16_t*)(P.ws + OFF_WUKV) + (size_t)h * 128 * 256, 256, 256, lds);
      if (wc == 0) {
        bf16_t* O = (bf16_t*)(P.ws + OFF_KM);
        const float* kg = P.mla_k_g + l * 96;
#pragma unroll
        for (int mi = 0; mi < 4; ++mi) {
          const int rl = wr * 64 + mi * 16 + fr, row = tm * 128 + rl; const float s = rs[rl]; const RowInfo ri = rowinfo(row);
          const uint4 kr = *(const uint4*)(CQKV + (size_t)row * 768 + 640 + fq * 8);
          float k8[8] = {lo2f(kr.x), hi2f(kr.x), lo2f(kr.y), hi2f(kr.y), lo2f(kr.z), hi2f(kr.z), lo2f(kr.w), hi2f(kr.w)};
          float ss = 0.f;
#pragma unroll
          for (int e = 0; e < 8; ++e) ss += k8[e] * k8[e];
          f32x4 vv[4];
#pragma unroll
          for (int ni = 0; ni < 4; ++ni) { vv[ni] = acc[mi][ni] * s;
#pragma unroll
            for (int j = 0; j < 4; ++j) ss += vv[ni][j] * vv[ni][j]; }
          ss += __shfl_xor(ss, 16); ss += __shfl_xor(ss, 32);
          const float rstd = rsqrtf(ss * (1.0f / 96.0f) + EPS);
          bf16_t* orow = O + (size_t)row * 1536 + h * 96;
#pragma unroll
          for (int ni = 0; ni < 4; ++ni) { const int d0 = ni * 16 + fq * 4; const f32x4 gg = *(const f32x4*)(kg + d0); store4bf(orow + d0, vv[ni] * rstd * gg); }
#pragma unroll
          for (int e = 0; e < 8; ++e) k8[e] *= rstd * kg[64 + fq * 8 + e];
          if (!ri.isctx) {
#pragma unroll
            for (int e = 0; e < 4; ++e) {
              const int pi = fq * 4 + e; const float c = RMc[ri.t * 16 + pi], sn = RMs[ri.t * 16 + pi];
              const float x1 = k8[2 * e], x2 = k8[2 * e + 1]; k8[2 * e] = x1 * c - x2 * sn; k8[2 * e + 1] = x1 * sn + x2 * c;
            }
          }
          uint4 o; o.x = pack2(k8[0], k8[1]); o.y = pack2(k8[2], k8[3]); o.z = pack2(k8[4], k8[5]); o.w = pack2(k8[6], k8[7]);
          *(uint4*)(orow + 64 + fq * 8) = o;
        }
      } else {
        bf16_t* O = (bf16_t*)(P.ws + OFF_VMT);
#pragma unroll
        for (int mi = 0; mi < 4; ++mi) {
          const int rl = wr * 64 + mi * 16 + fr, row = tm * 128 + rl; const float s = rs[rl]; const RowInfo ri = rowinfo(row);
          const int pos = keypos(ri.isctx ? 2048 + ri.t : ri.t);
          bf16_t* ob = O + ((size_t)(ri.bl * 16 + h) * 64) * NKEY + pos;
#pragma unroll
          for (int ni = 0; ni < 4; ++ni)
#pragma unroll
            for (int j = 0; j < 4; ++j) ob[(size_t)(ni * 16 + fq * 4 + j) * NKEY] = f2bf(acc[mi][ni][j] * s);
        }
      }
    }
  }
}

struct QFrag { bf16x8 f0, f1, f2, f3, f4, f5; };
template <int KS> DI bf16x8 mla_qfrag(uint4 v, float rstd, const float* qg, int hh, int isctx, int t, const float* RMc, const float* RMs, float qscale) {
  float q[8] = {lo2f(v.x), hi2f(v.x), lo2f(v.y), hi2f(v.y), lo2f(v.z), hi2f(v.z), lo2f(v.w), hi2f(v.w)};
#pragma unroll
  for (int e = 0; e < 8; ++e) q[e] *= rstd * qg[KS * 16 + hh * 8 + e];
  if constexpr (KS >= 4) {
#pragma unroll
    for (int e = 0; e < 4; ++e) {
      const int pi = (KS - 4) * 8 + hh * 4 + e; const float c = isctx ? 1.0f : RMc[t * 16 + pi], sn = isctx ? 0.0f : RMs[t * 16 + pi];
      const float x1 = q[2 * e], x2 = q[2 * e + 1]; q[2 * e] = x1 * c - x2 * sn; q[2 * e + 1] = x1 * sn + x2 * c;
    }
  }
  uint4 w; w.x = pack2(q[0] * qscale, q[1] * qscale); w.y = pack2(q[2] * qscale, q[3] * qscale); w.z = pack2(q[4] * qscale, q[5] * qscale); w.w = pack2(q[6] * qscale, q[7] * qscale);
  return __builtin_bit_cast(bf16x8, w);
}
DI bf16x8 scale_qfrag(uint4 v, float qscale) {
  uint4 w; w.x = pack2(lo2f(v.x) * qscale, hi2f(v.x) * qscale); w.y = pack2(lo2f(v.y) * qscale, hi2f(v.y) * qscale);
  w.z = pack2(lo2f(v.z) * qscale, hi2f(v.z) * qscale); w.w = pack2(lo2f(v.w) * qscale, hi2f(v.w) * qscale);
  return __builtin_bit_cast(bf16x8, w);
}
template <int DK, int DV>
DI void attn_stream(f32x16 (&O)[DV / 32], float& lsum, const QFrag& qf, const bf16_t* __restrict__ Kb, int kstride, const bf16_t* __restrict__ Vt,
                    int bl, int kt0, int kt1, char* lds) {
  constexpr int KROW = (DK == 96) ? 256 : 128;
  constexpr int STG = 64 * KROW + DV * 128;
  const int tid = tidx(), lane = tid & 63, r = lane & 31, hh = lane >> 5;
  const int wbase = __builtin_amdgcn_readfirstlane(tid >> 6) * 1024;
  const int vrow = tid >> 3, vsrc = (tid & 7) ^ ((vrow >> 1) & 7);
  const int krow = (DK == 96) ? (tid >> 4) : (tid >> 3);
  const int ksrc = (DK == 96) ? ((tid & 15) ^ (krow & 15)) : ((tid & 7) ^ ((krow >> 1) & 7));
#define ATT_STAGE(KT, BUF) do { const int kt_ = (KT); const int keyrow0 = kt_ < 32 ? bl * 2048 + kt_ * 64 : ML + bl * 256 + (kt_ - 32) * 64; \
    char* kd_ = lds + (BUF) * STG + wbase; char* vd_ = kd_ + 64 * KROW; \
    if (DK == 96) { if (ksrc < 12) { _Pragma("unroll") for (int i = 0; i < 4; ++i) GLDS16(Kb + (size_t)(keyrow0 + krow + 16 * i) * kstride + ksrc * 8, kd_ + i * 4096); } } \
    else { _Pragma("unroll") for (int i = 0; i < 2; ++i) GLDS16(Kb + (size_t)(keyrow0 + krow + 32 * i) * kstride + ksrc * 8, kd_ + i * 4096); } \
    _Pragma("unroll") for (int i = 0; i < DV / 32; ++i) GLDS16(Vt + (size_t)(vrow + 32 * i) * NKEY + kt_ * 64 + vsrc * 8, vd_ + i * 4096); } while (0)
  float mrun = -1e30f; lsum = 0.f;
#pragma unroll
  for (int b = 0; b < DV / 32; ++b)
#pragma unroll
    for (int i = 0; i < 16; ++i) O[b][i] = 0.f;
  __syncthreads();
  ATT_STAGE(kt0, 0); ATT_STAGE(kt0 + 1, 1);
  int buf = 0, nbuf = 2;
  for (int kt = kt0; kt < kt1; ++kt) {
    if (kt + 1 < kt1) asm volatile("s_waitcnt vmcnt(6)" ::: "memory"); else asm volatile("s_waitcnt vmcnt(0)" ::: "memory");
    asm volatile("s_waitcnt lgkmcnt(0)" ::: "memory");
    __builtin_amdgcn_s_barrier();
    asm volatile("" ::: "memory");
    if (kt + 2 < kt1) ATT_STAGE(kt + 2, nbuf);
    const char* ks_ = lds + buf * STG; const char* vs_ = ks_ + 64 * KROW;
    f32x16 S[2];
    {
      const char* kp0 = ks_ + r * KROW; const char* kp1 = kp0 + 32 * KROW;
      const int ksw = (DK == 96) ? (r & 15) : ((r >> 1) & 7);
      constexpr int NKS = DK / 16;
      bf16x8 ka[NKS], kc[NKS];
#pragma unroll
      for (int i = 0; i < NKS; ++i) { const int co = ((i * 2 + hh) ^ ksw) * 16; ka[i] = *(const bf16x8*)(kp0 + co); kc[i] = *(const bf16x8*)(kp1 + co); }
      f32x16 zc;
#pragma unroll
      for (int i = 0; i < 16; ++i) zc[i] = 0.f;
      S[0] = __builtin_amdgcn_mfma_f32_32x32x16_bf16(ka[0], qf.f0, zc, 0, 0, 0);
      S[1] = __builtin_amdgcn_mfma_f32_32x32x16_bf16(kc[0], qf.f0, zc, 0, 0, 0);
#define QK_STEP(i) S[0] = __builtin_amdgcn_mfma_f32_32x32x16_bf16(ka[i], qf.f##i, S[0], 0, 0, 0); S[1] = __builtin_amdgcn_mfma_f32_32x32x16_bf16(kc[i], qf.f##i, S[1], 0, 0, 0)
      QK_STEP(1); QK_STEP(2); QK_STEP(3);
      if constexpr (DK == 96) { QK_STEP(4); QK_STEP(5); }
#undef QK_STEP
    }
    bf16x8 vpre[DV / 32][2];
#pragma unroll
    for (int b = 0; b < DV / 32; ++b)
#pragma unroll
      for (int s = 0; s < 2; ++s) vpre[b][s] = *(const bf16x8*)(vs_ + (b * 32 + r) * 128 + (((0 * 4 + s * 2 + hh) ^ ((r >> 1) & 7)) * 16));
    float mx = S[0][0];
#pragma unroll
    for (int kb = 0; kb < 2; ++kb)
#pragma unroll
      for (int i = 0; i < 16; ++i) mx = fmaxf(mx, S[kb][i]);
    { const auto sw_ = __builtin_amdgcn_permlane32_swap(__float_as_uint(mx), __float_as_uint(mx), false, false); mx = fmaxf(__uint_as_float(sw_[0]), __uint_as_float(sw_[1])); }
    const float mnew = fmaxf(mrun, mx);
    const float alpha = __builtin_amdgcn_exp2f(mrun - mnew);
    mrun = mnew;
    f32x2n psa = {0.f, 0.f}, psb = {0.f, 0.f};
    const f32x2n m2 = {mnew, mnew};
#pragma unroll
    for (int kb = 0; kb < 2; ++kb)
#pragma unroll
      for (int i = 0; i < 16; i += 4) {
        const f32x2n d0 = (f32x2n){S[kb][i], S[kb][i + 1]} - m2, d1 = (f32x2n){S[kb][i + 2], S[kb][i + 3]} - m2;
        const f32x2n e0 = {__builtin_amdgcn_exp2f(d0[0]), __builtin_amdgcn_exp2f(d0[1])}, e1 = {__builtin_amdgcn_exp2f(d1[0]), __builtin_amdgcn_exp2f(d1[1])};
        S[kb][i] = e0[0]; S[kb][i + 1] = e0[1]; S[kb][i + 2] = e1[0]; S[kb][i + 3] = e1[1];
        psa += e0; psb += e1;
      }
    lsum = lsum * alpha + ((psa[0] + psa[1]) + (psb[0] + psb[1]));
#pragma unroll
    for (int b = 0; b < DV / 32; ++b) O[b] = O[b] * alpha;
#pragma unroll
    for (int kb = 0; kb < 2; ++kb)
#pragma unroll
      for (int s = 0; s < 2; ++s) {
        uint4 pw; pw.x = pack2(S[kb][8 * s], S[kb][8 * s + 1]); pw.y = pack2(S[kb][8 * s + 2], S[kb][8 * s + 3]);
        pw.z = pack2(S[kb][8 * s + 4], S[kb][8 * s + 5]); pw.w = pack2(S[kb][8 * s + 6], S[kb][8 * s + 7]);
        const bf16x8 pf = __builtin_bit_cast(bf16x8, pw);
#pragma unroll
        for (int b = 0; b < DV / 32; ++b) {
          const bf16x8 vf = (kb == 0) ? vpre[b][s] : *(const bf16x8*)(vs_ + (b * 32 + r) * 128 + (((kb * 4 + s * 2 + hh) ^ ((r >> 1) & 7)) * 16));
          O[b] = __builtin_amdgcn_mfma_f32_32x32x16_bf16(vf, pf, O[b], 0, 0, 0);
        }
      }
    buf = (buf == 2) ? 0 : buf + 1; nbuf = (nbuf == 2) ? 0 : nbuf + 1;
  }
  __syncthreads();
}

DI void mla_unit(const Params& P, int l, int bl, int h, int qt, char* lds) {
  const int lane = tidx() & 63, wid = tidx() >> 6, r = lane & 31, hh = lane >> 5;
  const int isctx = qt >= 16;
  const int row = (isctx ? ML + bl * 256 + (qt - 16) * 128 : bl * 2048 + qt * 128) + wid * 32 + r;
  const int t = isctx ? 0 : qt * 128 + wid * 32 + r;
  const bf16_t* qp = (const bf16_t*)(P.ws + OFF_QM) + (size_t)row * 1536 + h * 96;
  const float* qg = P.mla_q_g + l * 96;
  const float* RMc = (const float*)(P.ws + OFF_RM); const float* RMs = RMc + 2048 * 16;
  const uint4 r0 = *(const uint4*)(qp + 0 * 16 + hh * 8), r1 = *(const uint4*)(qp + 1 * 16 + hh * 8), r2 = *(const uint4*)(qp + 2 * 16 + hh * 8),
              r3 = *(const uint4*)(qp + 3 * 16 + hh * 8), r4 = *(const uint4*)(qp + 4 * 16 + hh * 8), r5 = *(const uint4*)(qp + 5 * 16 + hh * 8);
  float ss = ssq8(r0) + ssq8(r1) + ssq8(r2) + ssq8(r3) + ssq8(r4) + ssq8(r5);
  ss += __shfl_xor(ss, 32);
  const float rstd = rsqrtf(ss * (1.0f / 96.0f) + EPS);
  const float qscale = 0.10206207261596577f * LOG2E;
  QFrag qf;
  qf.f0 = mla_qfrag<0>(r0, rstd, qg, hh, isctx, t, RMc, RMs, qscale); qf.f1 = mla_qfrag<1>(r1, rstd, qg, hh, isctx, t, RMc, RMs, qscale);
  qf.f2 = mla_qfrag<2>(r2, rstd, qg, hh, isctx, t, RMc, RMs, qscale); qf.f3 = mla_qfrag<3>(r3, rstd, qg, hh, isctx, t, RMc, RMs, qscale);
  qf.f4 = mla_qfrag<4>(r4, rstd, qg, hh, isctx, t, RMc, RMs, qscale); qf.f5 = mla_qfrag<5>(r5, rstd, qg, hh, isctx, t, RMc, RMs, qscale);
  f32x16 O[2]; float lsum;
  attn_stream<96, 64>(O, lsum, qf, (const bf16_t*)(P.ws + OFF_KM) + h * 96, 1536, (const bf16_t*)(P.ws + OFF_VMT) + ((size_t)(bl * 16 + h) * 64) * NKEY, bl, isctx ? 32 : 0, 36, lds);
  lsum += __shfl_xor(lsum, 32);
  const float inv = 1.0f / lsum;
  bf16_t* op = (bf16_t*)(P.ws + OFF_OB) + (size_t)row * 1024 + h * 64;
#pragma unroll
  for (int b = 0; b < 2; ++b)
#pragma unroll
    for (int g = 0; g < 4; ++g) {
      const f32x4 v = {O[b][4 * g] * inv, O[b][4 * g + 1] * inv, O[b][4 * g + 2] * inv, O[b][4 * g + 3] * inv};
      store4bf(op + b * 32 + 8 * g + 4 * hh, v);
    }
}

DI void diff_unit(const Params& P, int l, int bl, int h, int qt, char* lds) {
  const int lane = tidx() & 63, wid = tidx() >> 6, r = lane & 31, hh = lane >> 5;
  const int isctx = qt >= 16;
  const int row = (isctx ? ML + bl * 256 + (qt - 16) * 128 : bl * 2048 + qt * 128) + wid * 32 + r;
  bf16_t* qp = (bf16_t*)(P.ws + OFF_DQ) + (size_t)row * 1024 + h * 128;
  const bf16_t* Vt = (const bf16_t*)(P.ws + OFF_DVT) + ((size_t)(bl * 8 + h) * 128) * NKEY;
  const float qscale = 0.125f * LOG2E;
  const float lam = ((const float*)(P.ws + OFF_LAM))[l];
  f32x16 O[4]; float lsum;
  QFrag qa, qb;
  qa.f0 = scale_qfrag(*(const uint4*)(qp + 0 * 16 + hh * 8), qscale); qa.f1 = scale_qfrag(*(const uint4*)(qp + 1 * 16 + hh * 8), qscale);
  qa.f2 = scale_qfrag(*(const uint4*)(qp + 2 * 16 + hh * 8), qscale); qa.f3 = scale_qfrag(*(const uint4*)(qp + 3 * 16 + hh * 8), qscale);
  qa.f4 = qa.f0; qa.f5 = qa.f0;
  qb.f0 = scale_qfrag(*(const uint4*)(qp + 64 + 0 * 16 + hh * 8), qscale); qb.f1 = scale_qfrag(*(const uint4*)(qp + 64 + 1 * 16 + hh * 8), qscale);
  qb.f2 = scale_qfrag(*(const uint4*)(qp + 64 + 2 * 16 + hh * 8), qscale); qb.f3 = scale_qfrag(*(const uint4*)(qp + 64 + 3 * 16 + hh * 8), qscale);
  qb.f4 = qb.f0; qb.f5 = qb.f0;
  attn_stream<64, 128>(O, lsum, qa, (const bf16_t*)(P.ws + OFF_DK) + h * 128, 1024, Vt, bl, isctx ? 32 : 0, 36, lds);
  lsum += __shfl_xor(lsum, 32);
  {
    const float inv = 1.0f / lsum;
#pragma unroll
    for (int b = 0; b < 4; ++b)
#pragma unroll
      for (int g = 0; g < 4; ++g) {
        const f32x4 v = {O[b][4 * g] * inv, O[b][4 * g + 1] * inv, O[b][4 * g + 2] * inv, O[b][4 * g + 3] * inv};
        store4bf(qp + b * 32 + 8 * g + 4 * hh, v);
      }
  }
  attn_stream<64, 128>(O, lsum, qb, (const bf16_t*)(P.ws + OFF_DK) + h * 128 + 64, 1024, Vt, bl, isctx ? 32 : 0, 36, lds);
  lsum += __shfl_xor(lsum, 32);
  {
    const float inv = lam / lsum;
    float ss = 0.f;
#pragma unroll
    for (int b = 0; b < 4; ++b)
#pragma unroll
      for (int g = 0; g < 4; ++g) {
        const uint2 w = *(const uint2*)(qp + b * 32 + 8 * g + 4 * hh);
        const float a0 = lo2f(w.x) - O[b][4 * g] * inv, a1 = hi2f(w.x) - O[b][4 * g + 1] * inv, a2 = lo2f(w.y) - O[b][4 * g + 2] * inv, a3 = hi2f(w.y) - O[b][4 * g + 3] * inv;
        O[b][4 * g] = a0; O[b][4 * g + 1] = a1; O[b][4 * g + 2] = a2; O[b][4 * g + 3] = a3;
        ss += a0 * a0 + a1 * a1 + a2 * a2 + a3 * a3;
      }
    ss += __shfl_xor(ss, 32);
    const float rstd = rsqrtf(ss * (1.0f / 128.0f) + EPS) * (1.0f - lam_init_of(l));
    const float* sg = P.diff_subln_g + l * 128;
#pragma unroll
    for (int b = 0; b < 4; ++b)
#pragma unroll
      for (int g = 0; g < 4; ++g) {
        const int dv0 = b * 32 + 8 * g + 4 * hh;
        const f32x4 gg = *(const f32x4*)(sg + dv0);
        const f32x4 v = {O[b][4 * g] * rstd * gg[0], O[b][4 * g + 1] * rstd * gg[1], O[b][4 * g + 2] * rstd * gg[2], O[b][4 * g + 3] * rstd * gg[3]};
        store4bf(qp + dv0, v);
      }
  }
}

DI void pd_phase(const Params& P, int l, int half, int ph, char* lds) {
  const int nq_ctx = (l == 0) ? 2 : 0;
  const int n_dl = HB * 8 * 16, n_lru = HB * 8 * 4, n_ml = HB * 16 * 16, n_dc = HB * 8 * nq_ctx, n_mc = HB * 16 * nq_ctx;
  const int tot = n_dl + n_lru + n_ml + n_dc + n_mc;
  unsigned* ctr = (unsigned*)(P.ws + OFF_CTR) + ph * 8;
  volatile int* slot = (volatile int*)(lds + LDS_BAR + 8);
  const int myx = (int)((unsigned)__builtin_amdgcn_s_getreg((3 << 11) | 20) & 7u);
  for (;;) {
    __syncthreads();
    if (threadIdx.x == 0) {
      int got = -1;
      for (int y = 0; y < 8 && got < 0; ++y) {
        const int xx = (myx + y) & 7;
        const int i = (int)__hip_atomic_fetch_add(ctr + xx, 1u, __ATOMIC_RELAXED, __HIP_MEMORY_SCOPE_AGENT);
        const int uu = i * 8 + xx;
        if (uu < tot) got = uu;
      }
      *slot = got;
    }
    __syncthreads();
    const int u = *slot;
    if (u < 0) break;
    int v = u, kind, bl = 0, h = 0, qt = 0;
    if (v < n_dl) { kind = 0; const int x = v & 7, s = (v >> 3) & 63, rnd = v >> 9; const int g = x + 8 * ((s >> 4) + 4 * rnd); qt = s & 15; bl = g >> 3; h = g & 7; }
    else if ((v -= n_dl) < n_lru) { kind = 2; }
    else if ((v -= n_lru) < n_ml) { kind = 1; const int x = v & 7, s = (v >> 3) & 63, rnd = v >> 9; const int g = x + 8 * ((s >> 4) + 4 * rnd); qt = s & 15; bl = g >> 4; h = g & 15; }
    else if ((v -= n_ml) < n_dc) { kind = 0; bl = v >> 4; h = (v >> 1) & 7; qt = 16 + (v & 1); }
    else { v -= n_dc; kind = 1; bl = v >> 5; h = (v >> 1) & 15; qt = 16 + (v & 1); }
#ifndef NO_DIFF
    if (kind == 0) diff_unit(P, l, bl, h, qt, lds);
#endif
#ifndef NO_MLA
    if (kind == 1) mla_unit(P, l, bl, h, qt, lds);
#endif
#ifndef NO_LRUF
    if (kind == 2) lru_seq_unit(P, l, v, lds);
#endif
  }
}

DI void merge_phase(const Params& P, int l, int half, int MT, char* lds) {
  const int tid = tidx(), lane = tid & 63, wid = tid >> 6, wr = wid >> 1, wc = wid & 1, fr = lane & 15, fq = lane >> 4;
  const bf16_t* H = (const bf16_t*)(P.ws + OFF_HBF);
  bf16_t* Z = (bf16_t*)(P.ws + OFF_RX);
  for (int u = blockIdx.x; u < MT * 16; u += gridDim.x) {
    const int tn = u / MT, tm = u % MT, n0 = tn * 64;
    f32x4 z[4][2]; zero_acc<2>(z);
#pragma unroll 1
    for (int br = 0; br < 3; ++br) {
      const bf16_t* Ab = (const bf16_t*)(P.ws + (br == 0 ? OFF_GRG : br == 1 ? OFF_OB : OFF_DQ));
      const bf16_t* Wb = (const bf16_t*)(P.ws + OFF_WBRA + (size_t)br * (OFF_WBRB - OFF_WBRA));
      f32x4 g[4][2]; zero_acc<2>(g);
      gemm_core<2>(g, H + (size_t)tm * 128 * 1024, 1024, (const bf16_t*)(P.ws + OFF_WMG) + (size_t)(br * 1024 + n0) * 1024, 1024, 1024, lds);
#pragma unroll
      for (int mi = 0; mi < 4; ++mi)
#pragma unroll
        for (int ni = 0; ni < 2; ++ni)
#pragma unroll
          for (int j = 0; j < 4; ++j) g[mi][ni][j] = sigmoidf_(g[mi][ni][j]);
      f32x4 v[4][2]; zero_acc<2>(v);
      gemm_core<2>(v, Ab + (size_t)tm * 128 * 1024, 1024, Wb + (size_t)n0 * 1024, 1024, 1024, lds);
#pragma unroll
      for (int mi = 0; mi < 4; ++mi)
#pragma unroll
        for (int ni = 0; ni < 2; ++ni) z[mi][ni] += g[mi][ni] * v[mi][ni];
    }
#pragma unroll
    for (int mi = 0; mi < 4; ++mi)
#pragma unroll
      for (int ni = 0; ni < 2; ++ni) store4bf(Z + (size_t)(tm * 128 + wr * 64 + mi * 16 + fr) * 1024 + n0 + wc * 32 + ni * 16 + fq * 4, z[mi][ni]);
  }
}

DI void resid_gemm_phase(const Params& P, int l, int half_, int MT, const bf16_t* A, int K, const bf16_t* W, int goff, bool src_is_input, char* lds, int rph = 0) {
  const int tid = tidx(), lane = tid & 63, wid = tid >> 6, wr = wid >> 1, wc = wid & 1, fr = lane & 15, fq = lane >> 4;
  const float* MOD = (const float*)(P.ws + OFF_MOD) + (size_t)l * 9 * 6144 + goff;
  for (int u = blockIdx.x; u < MT * 16; u += gridDim.x) {
    const int tn = u / MT, tm = u % MT, n0 = tn * 64;
    f32x4 acc[4][2]; zero_acc<2>(acc);
    gemm_core<2>(acc, A + (size_t)tm * 128 * K, K, W + (size_t)n0 * K, K, K, lds);
#pragma unroll
    for (int mi = 0; mi < 4; ++mi) {
      const int grow = tm * 128 + wr * 64 + mi * 16 + fr;
      const int half = rph ? grow / rph : half_, row = rph ? grow % rph : grow; const RowInfo ri = rowinfo(row);
      const float* md = MOD + (size_t)(ri.isctx ? 8 : half * HB + ri.bl) * 6144;
      float* dst = resid_ptr(P, half, row);
      const float* src = src_is_input ? input_ptr(P, half, row) : dst;
#pragma unroll
      for (int ni = 0; ni < 2; ++ni) {
        const int c0 = n0 + wc * 32 + ni * 16 + fq * 4;
        const f32x4 gt = *(const f32x4*)(md + c0), sv = *(const f32x4*)(src + c0);
        *(f32x4*)(dst + c0) = sv + gt * acc[mi][ni];
      }
    }
  }
}

DI void ffn_in_phase(const Params& P, int l, int half, int MT, char* lds) {
  const int tid = tidx(), lane = tid & 63, wid = tid >> 6, wr = wid >> 1, wc = wid & 1, fr = lane & 15, fq = lane >> 4;
  const bf16_t* H = (const bf16_t*)(P.ws + OFF_HBF);
  bf16_t* HH = (bf16_t*)(P.ws + OFF_DQ);
  for (int u = blockIdx.x; u < MT * 44; u += gridDim.x) {
    const int tn = u / MT, tm = u % MT;
    f32x4 acc[4][4]; zero_acc<4>(acc);
    gemm_core<4>(acc, H + (size_t)tm * 128 * 1024, 1024, (const bf16_t*)(P.ws + OFF_WFI) + (size_t)tn * 128 * 1024, 1024, 1024, lds);
#pragma unroll
    for (int mi = 0; mi < 4; ++mi) {
      const int row = tm * 128 + wr * 64 + mi * 16 + fr;
#pragma unroll
      for (int q = 0; q < 2; ++q) {
        f32x4 v;
#pragma unroll
        for (int j = 0; j < 4; ++j) v[j] = siluf_(acc[mi][2 * q][j]) * acc[mi][2 * q + 1][j];
        store4bf(HH + (size_t)row * FH + tn * 64 + (wc * 2 + q) * 16 + fq * 4, v);
      }
    }
  }
}

#define XB_TMO      128
#define XB_XCNT(j)  (256  + 64 * (j))
#define XB_XSUB(j)  (1280 + 64 * (j))
#define XB_XGEN(j)  (2304 + 64 * (j))
#define XB_TOP      3328
#define XB_TOPGEN   3392
#define XCD_BAR_WORDS 3456
#define XB_SPIN_CAP (1u << 20)
#define LAS __attribute__((address_space(3)))
DI unsigned xb_ld(unsigned* p) { return __hip_atomic_load(p, __ATOMIC_RELAXED, __HIP_MEMORY_SCOPE_AGENT); }
DI unsigned xb_add(unsigned* p, unsigned v) { return __hip_atomic_fetch_add(p, v, __ATOMIC_RELAXED, __HIP_MEMORY_SCOPE_AGENT); }
DI unsigned xb_xcc_id() { return (unsigned)__builtin_amdgcn_s_getreg((3 << 11) | 20) & 0xFu; }
#define XB_SPIN(cond, bar) do { unsigned _sp = 0; while (cond) { __builtin_amdgcn_s_sleep(1); \
    if ((++_sp & 255u) == 0u) { if (xb_ld(&(bar)[XB_TMO])) break; if (_sp > XB_SPIN_CAP) { atomicAdd(&(bar)[XB_TMO], 1u); break; } } } } while (0)
struct XcdBarrier { unsigned* bar; unsigned x; volatile LAS unsigned* st; };
DI XcdBarrier xcd_barrier_post(unsigned* bar, volatile LAS unsigned* st) {
  XcdBarrier b; b.bar = bar; b.x = xb_xcc_id(); b.st = st;
  if (threadIdx.x == 0) (void)xb_add(&bar[XB_XCNT(b.x)], 1u);
  return b;
}
DI void xcd_barrier_complete(unsigned* bar, unsigned x, unsigned& nloc, unsigned& nx) {
  const unsigned G = gridDim.x * gridDim.y * gridDim.z;
  unsigned sum, cnt, mine, sp = 0u;
  for (;;) {
    sum = 0u; cnt = 0u; mine = 0u;
#pragma unroll
    for (unsigned j = 0; j < 16; ++j) { const unsigned c = xb_ld(&bar[XB_XCNT(j)]); sum += c; cnt += (c > 0u) ? 1u : 0u; mine = (j == x) ? c : mine; }
    if (sum == G) break;
    __builtin_amdgcn_s_sleep(1);
    if ((++sp & 255u) == 0u) { if (xb_ld(&bar[XB_TMO])) break; if (sp > XB_SPIN_CAP) { atomicAdd(&bar[XB_TMO], 1u); break; } }
  }
  nloc = mine > 0u ? mine : 1u; nx = cnt > 0u ? cnt : 1u;
}
DI void xcd_barrier(const XcdBarrier& b) {
  asm volatile("s_waitcnt vmcnt(0)" ::: "memory");
  __syncthreads();
  if (threadIdx.x == 0) {
    unsigned* bar = b.bar;
    __builtin_amdgcn_s_waitcnt(0);
    unsigned nloc = b.st[0], nx = b.st[1];
    if (nloc == 0u) { xcd_barrier_complete(bar, b.x, nloc, nx); b.st[0] = nloc; b.st[1] = nx; }
    const unsigned old = xb_add(&bar[XB_XSUB(b.x)], 1u);
    const unsigned gen = old / nloc;
    if (old + 1u == (gen + 1u) * nloc) {
      __builtin_amdgcn_fence(__ATOMIC_RELEASE, "agent");
      asm volatile("s_waitcnt vmcnt(0)" ::: "memory");
      const unsigned og = xb_add(&bar[XB_TOP], 1u);
      const unsigned tg = og / nx;
      if (og + 1u == (tg + 1u) * nx) xb_add(&bar[XB_TOPGEN], 1u);
      else XB_SPIN(xb_ld(&bar[XB_TOPGEN]) == tg, bar);
      __builtin_amdgcn_fence(__ATOMIC_ACQUIRE, "agent");
      xb_add(&bar[XB_XGEN(b.x)], 1u);
      asm volatile("s_waitcnt vmcnt(0)" ::: "memory");
    } else {
      XB_SPIN(xb_ld(&bar[XB_XGEN(b.x)]) == gen, bar);
      __builtin_amdgcn_fence(__ATOMIC_ACQUIRE, "agent");
      asm volatile("s_waitcnt vmcnt(0)" ::: "memory");
    }
  }
  __syncthreads();
}

constexpr int NPHASE = 1 + 2 * 15;
static_assert(OFF_RX == OFF_HBF + SZ1K, "joint HBF2 spans HBF + RX");
static_assert(OFF_QM - OFF_DQ >= (size_t)2 * MH * FH * 2, "joint HH spans DQ..VMT");
DI void run_phase(const Params& P, int ph, char* lds) {
  if (ph == 0) { phase0(P, lds); return; }
  const int q = ph - 1, l = q / 15, r = q % 15;
  const int MTl = (l == 0) ? MH / 128 : ML / 128;
  if (r >= 12) {
    const int rph = MTl * 128;
    if (r == 12) norm_phase(P, l, 0, 1, 2 * rph, rph);
    else if (r == 13) ffn_in_phase(P, l, 0, 2 * MTl, lds);
    else resid_gemm_phase(P, l, 0, 2 * MTl, (const bf16_t*)(P.ws + OFF_DQ), FH, (const bf16_t*)(P.ws + OFF_WFO), 5120, false, lds, rph);
    return;
  }
  const int half = r / 6, k = r % 6;
  switch (k) {
    case 0: if (half == 0) convert_weights(P, l, lds); norm_phase(P, l, half, 0, MH); break;
    case 1: g1_phase(P, l, half, lds); break;
    case 2: pc_phase(P, l, half, lds); break;
    case 3: pd_phase(P, l, half, ph, lds); break;
    case 4: merge_phase(P, l, half, MTl, lds); break;
    default: resid_gemm_phase(P, l, half, MTl, (const bf16_t*)(P.ws + OFF_RX), 1024, (const bf16_t*)(P.ws + OFF_WOUT), 2048, l == 0, lds); break;
  }
}

__global__ void __launch_bounds__(256, 2) fwd_kernel(Params P, int ph0, int ph1) {
  extern __shared__ __attribute__((aligned(16))) char smem[];
  volatile LAS unsigned* st = (volatile LAS unsigned*)(smem + LDS_BAR);
  if (threadIdx.x < 2) st[threadIdx.x] = 0u;
  __syncthreads();
  const XcdBarrier xb = xcd_barrier_post((unsigned*)(P.ws + OFF_BAR), st);
  for (int ph = ph0; ph < ph1; ++ph) {
    run_phase(P, ph, smem);
    if (ph + 1 < ph1) { if (ph == 0) cg::this_grid().sync(); else xcd_barrier(xb); }
  }
}

extern "C" void kernel_launch(void* const* d_in, const int* in_sizes, int n_in, void* d_out, int out_size, void* d_ws, size_t ws_size, hipStream_t stream) {
  static int grid_blocks = 0;
  if (!grid_blocks) {
    hipFuncSetAttribute((const void*)fwd_kernel, hipFuncAttributeMaxDynamicSharedMemorySize, LDS_BYTES);
    int dev = 0, cus = 0, per_cu = 0;
    hipGetDevice(&dev);
    hipDeviceGetAttribute(&cus, hipDeviceAttributeMultiprocessorCount, dev);
    hipOccupancyMaxActiveBlocksPerMultiprocessor(&per_cu, fwd_kernel, 256, LDS_BYTES);
    if (per_cu > 2) per_cu = 2;
    grid_blocks = cus * per_cu;
    if (grid_blocks <= 0) grid_blocks = 256;
  }
  if (ws_size < WS_NEED) { fprintf(stderr, "workspace too small: %zu < %zu\n", ws_size, (size_t)WS_NEED); return; }
  hipMemsetAsync((char*)d_ws + OFF_BAR, 0, XCD_BAR_WORDS * 4 + 2048, stream);
  Params p{};
  const float** f = (const float**)&p;
  for (int i = 0; i < 32; ++i) f[i] = (const float*)d_in[i];
  p.out = (float*)d_out; p.ws = (char*)d_ws;
#if ONE_LAUNCH
  int ph0 = 0, ph1 = NPHASE;
  void* args[] = {&p, &ph0, &ph1};
  hipError_t e = hipLaunchCooperativeKernel((const void*)fwd_kernel, dim3(grid_blocks), dim3(256), args, LDS_BYTES, stream);
  if (e != hipSuccess) fprintf(stderr, "cooperative launch failed: %s (grid %d)\n", hipGetErrorString(e), grid_blocks);
#else
  for (int ph = 0; ph < NPHASE; ++ph) fwd_kernel<<<grid_blocks, 256, LDS_BYTES, stream>>>(p, ph, ph + 1);
#endif
}
```

```cpp
#include <hip/hip_runtime.h>
#include <hip/hip_cooperative_groups.h>
#include <cstdio>
#include <cstdint>
namespace cg = cooperative_groups;

#ifndef ONE_LAUNCH
#define ONE_LAUNCH 1
#endif

typedef unsigned short bf16_t;
typedef short bf16x8 __attribute__((ext_vector_type(8)));
typedef float f32x4 __attribute__((ext_vector_type(4)));
typedef float f32x16 __attribute__((ext_vector_type(16)));
#define DI __device__ __forceinline__

constexpr int D = 1024, T = 2048, CT = 256, HB = 4;
constexpr int ML = HB * T;
constexpr int MC = HB * CT;
constexpr int MH = ML + MC;
constexpr int NKEY = T + CT;
constexpr int N1 = 5888;
constexpr int FH = 2816;
constexpr int INC = 8864;
constexpr float EPS = 1e-6f;
constexpr float LOG2E = 1.4426950408889634f;

constexpr size_t al(size_t x) { return (x + 255) & ~(size_t)255; }
constexpr size_t OFF_MOD = 0;
constexpr size_t OFF_RM = al(OFF_MOD + 2 * 9 * 6144 * 4);
constexpr size_t OFF_RD = al(OFF_RM + 2 * 2048 * 16 * 4);
constexpr size_t OFF_LAM = al(OFF_RD + 2 * 2048 * 32 * 4);
constexpr size_t OFF_BAR = al(OFF_LAM + 256);
constexpr size_t OFF_CTR = OFF_BAR + 3456 * 4;
constexpr size_t OFF_CARRY = al(OFF_CTR + 2048);
constexpr size_t OFF_XC = al(OFF_CARRY + (size_t)HB * 2 * 18 * 1024 * 8);
constexpr size_t OFF_WIN = al(OFF_XC + (size_t)2048 * 1024 * 4);
constexpr size_t OFF_WMG = al(OFF_WIN + (size_t)N1 * 1024 * 2);
constexpr size_t OFF_WUQ = al(OFF_WMG + (size_t)3072 * 1024 * 2);
constexpr size_t OFF_WUKV = al(OFF_WUQ + (size_t)1536 * 384 * 2);
constexpr size_t OFF_WLRU = al(OFF_WUKV + (size_t)2048 * 256 * 2);
constexpr size_t OFF_WBRA = al(OFF_WLRU + (size_t)4096 * 128 * 2);
constexpr size_t OFF_WBRB = al(OFF_WBRA + (size_t)1024 * 1024 * 2);
constexpr size_t OFF_WBRC = al(OFF_WBRB + (size_t)1024 * 1024 * 2);
constexpr size_t OFF_WOUT = al(OFF_WBRC + (size_t)1024 * 1024 * 2);
constexpr size_t OFF_WFI = al(OFF_WOUT + (size_t)1024 * 1024 * 2);
constexpr size_t OFF_WFO = al(OFF_WFI + (size_t)5632 * 1024 * 2);
constexpr size_t OFF_HBF = al(OFF_WFO + (size_t)1024 * FH * 2);
constexpr size_t SZ1K = (size_t)MH * 1024 * 2;
constexpr size_t OFF_RX = al(OFF_HBF + SZ1K);
constexpr size_t OFF_GRG = al(OFF_RX + SZ1K);
constexpr size_t OFF_CQKV = al(OFF_GRG + SZ1K);
constexpr size_t OFF_DQ = al(OFF_CQKV + (size_t)MH * 768 * 2);
constexpr size_t OFF_DK = al(OFF_DQ + SZ1K);
constexpr size_t OFF_DVT = al(OFF_DK + SZ1K);
constexpr size_t OFF_KM = al(OFF_DVT + SZ1K);
constexpr size_t OFF_VMT = al(OFF_KM + (size_t)MH * 1536 * 2);
constexpr size_t OFF_QM = al(OFF_VMT + SZ1K);
constexpr size_t OFF_OB = al(OFF_QM + (size_t)MH * 1536 * 2);
constexpr size_t OFF_XCV = al(OFF_OB + SZ1K);
constexpr size_t WS_NEED = al(OFF_XCV + SZ1K);
static_assert(OFF_DK == OFF_DQ + SZ1K && OFF_DVT == OFF_DK + SZ1K, "HH alias needs contiguous DQ/DK/DVT");
static_assert((size_t)MH * FH * 2 <= 3 * SZ1K, "HH alias size");

constexpr int LDS_BYTES = 73728 + 1024 + 3072 + 32;
constexpr int LDS_BAR = 73728 + 1024 + 3072;
constexpr int LDS_RS = 73728, LDS_SEG = 73728 + 1024;

struct Params {
  const float *x, *c, *ctx, *c_ctx, *w_mod, *b_mod, *norm1_g, *norm2_g, *w_in, *conv_w, *conv_b, *lru_wa, *lru_ba, *lru_wi, *lru_bi,
      *lru_lambda, *mla_qn_g, *mla_w_uq, *mla_kvn_g, *mla_w_ukv, *mla_q_g, *mla_k_g, *diff_q_g, *diff_k_g, *diff_lambda, *diff_subln_g,
      *w_br_a, *w_br_b, *w_br_c, *w_out, *w_ffn_in, *w_ffn_out;
  float* out;
  char* ws;
};

DI int tidx() { int t = __builtin_amdgcn_workitem_id_x(); asm volatile("" : "+v"(t)); return t; }
DI float bf2f(unsigned short u) { return __uint_as_float(((unsigned)u) << 16); }
DI unsigned short f2bf(float x) { unsigned u = __float_as_uint(x); u += 0x7fffu + ((u >> 16) & 1u); return (unsigned short)(u >> 16); }
typedef __bf16 bf16n2 __attribute__((ext_vector_type(2)));
typedef float f32x2n __attribute__((ext_vector_type(2)));
DI unsigned pack2(float lo, float hi) { const f32x2n v = {lo, hi}; return __builtin_bit_cast(unsigned, __builtin_convertvector(v, bf16n2)); }
DI float lo2f(unsigned u) { return __uint_as_float(u << 16); }
DI float hi2f(unsigned u) { return __uint_as_float(u & 0xffff0000u); }
DI float sigmoidf_(float x) { return 1.0f / (1.0f + __expf(-x)); }
DI float siluf_(float x) { return x * sigmoidf_(x); }
DI float geluf_(float x) { const float u = 0.7978845608028654f * (x + 0.044715f * x * x * x); return 0.5f * x * (1.0f + tanhf(u)); }
DI int perm16(int o) { return (o & 3) | ((o & 4) << 1) | ((o & 8) >> 1); }
DI int keypos(int kk) { return (kk & ~15) | perm16(kk & 15); }
struct RowInfo { int bl, t, isctx; };
DI RowInfo rowinfo(int lr) { RowInfo r; if (lr < ML) { r.bl = lr >> 11; r.t = lr & 2047; r.isctx = 0; } else { const int q = lr - ML; r.bl = q >> 8; r.t = q & 255; r.isctx = 1; } return r; }
DI float* resid_ptr(const Params& P, int half, int lr) {
  return lr < ML ? P.out + ((size_t)half * ML + lr) * D : (float*)(P.ws + OFF_XC) + ((size_t)half * MC + (lr - ML)) * D;
}
DI const float* input_ptr(const Params& P, int half, int lr) {
  return lr < ML ? P.x + ((size_t)half * ML + lr) * D : P.ctx + ((size_t)half * MC + (lr - ML)) * D;
}
DI float lam_init_of(int l) { return l == 0 ? 0.2f : 0.35550906f; }

typedef __attribute__((address_space(3))) unsigned lds_u32_t;
#define GLDS16(gsrc, ldst) __builtin_amdgcn_global_load_lds((const unsigned*)(gsrc), (lds_u32_t*)(ldst), 16, 0, 0)
DI void gemm_core_ring2(f32x4 (&acc)[4][2], const bf16_t* __restrict__ A, int lda, const bf16_t* __restrict__ W, int ldw, int K, char* lds) {
  constexpr int NT = 2, STAGE = 24576;
  const int tid = tidx(), lane = tid & 63, wid = tid >> 6, wr = wid >> 1, wc = wid & 1, fr = lane & 15, fq = lane >> 4;
  const int crow = tid >> 3, csrc = (tid & 7) ^ ((crow >> 1) & 7);
  const int nk = K >> 6;
  const bf16_t* ap = A + (size_t)crow * lda + csrc * 8;
  const bf16_t* wp = W + (size_t)crow * ldw + csrc * 8;
  const int sw = (fr >> 1) & 7;
  const int wbase = __builtin_amdgcn_readfirstlane(wid) * 1024;
#define RING_STAGE(KT, BUF) do { char* a_ = lds + (BUF) * STAGE + wbase; char* w_ = a_ + 16384; \
    _Pragma("unroll") for (int i = 0; i < 4; ++i) GLDS16(ap + (size_t)(32 * i) * lda + (KT) * 64, a_ + i * 4096); \
    _Pragma("unroll") for (int i = 0; i < NT; ++i) GLDS16(wp + (size_t)(32 * i) * ldw + (KT) * 64, w_ + i * 4096); } while (0)
  RING_STAGE(0, 0); RING_STAGE(1, 1);
  int buf = 0, nbuf = 2;
  for (int j = 0; j < nk; ++j) {
    if (j + 1 < nk) asm volatile("s_waitcnt vmcnt(6)" ::: "memory"); else asm volatile("s_waitcnt vmcnt(0)" ::: "memory");
    asm volatile("s_waitcnt lgkmcnt(0)" ::: "memory");
    __builtin_amdgcn_s_barrier();
    asm volatile("" ::: "memory");
    if (j + 2 < nk) RING_STAGE(j + 2, nbuf);
    {
      const char* a = lds + buf * STAGE; const char* w = a + 16384;
      bf16x8 bf0[4], af0[NT], bf1[4], af1[NT];
      { const int co = ((0 * 4 + fq) ^ sw) * 16;
#pragma unroll
        for (int mi = 0; mi < 4; ++mi) bf0[mi] = *(const bf16x8*)(a + (wr * 64 + mi * 16 + fr) * 128 + co);
#pragma unroll
        for (int ni = 0; ni < NT; ++ni) af0[ni] = *(const bf16x8*)(w + (wc * NT * 16 + ni * 16 + fr) * 128 + co); }
      { const int co = ((1 * 4 + fq) ^ sw) * 16;
#pragma unroll
        for (int mi = 0; mi < 4; ++mi) bf1[mi] = *(const bf16x8*)(a + (wr * 64 + mi * 16 + fr) * 128 + co);
#pragma unroll
        for (int ni = 0; ni < NT; ++ni) af1[ni] = *(const bf16x8*)(w + (wc * NT * 16 + ni * 16 + fr) * 128 + co); }
#pragma unroll
      for (int mi = 0; mi < 4; ++mi)
#pragma unroll
        for (int ni = 0; ni < NT; ++ni) acc[mi][ni] = __builtin_amdgcn_mfma_f32_16x16x32_bf16(af0[ni], bf0[mi], acc[mi][ni], 0, 0, 0);
#pragma unroll
      for (int mi = 0; mi < 4; ++mi)
#pragma unroll
        for (int ni = 0; ni < NT; ++ni) acc[mi][ni] = __builtin_amdgcn_mfma_f32_16x16x32_bf16(af1[ni], bf1[mi], acc[mi][ni], 0, 0, 0);
    }
    buf = (buf == 2) ? 0 : buf + 1; nbuf = (nbuf == 2) ? 0 : nbuf + 1;
  }
  __syncthreads();
#undef RING_STAGE
}
template <int K_> DI void row_rstd_table(const bf16_t* A, int lda, char* lds);
template <int NT, int RSK = 0>
DI void gemm_core(f32x4 (&acc)[4][NT], const bf16_t* __restrict__ A, int lda, const bf16_t* __restrict__ W, int ldw, int K, char* lds) {
  if constexpr (NT == 2) { gemm_core_ring2(acc, A, lda, W, ldw, K, lds); return; }
  constexpr int STAGE = 32768;
  const int tid = tidx(), lane = tid & 63, wid = tid >> 6, wr = wid >> 1, wc = wid & 1, fr = lane & 15, fq = lane >> 4;
  const int crow = tid >> 3, csrc = (tid & 7) ^ ((crow >> 1) & 7);
  const int nk = K >> 6;
  const bf16_t* ap = A + (size_t)crow * lda + csrc * 8;
  const bf16_t* wp = W + (size_t)crow * ldw + csrc * 8;
  const int sw = (fr >> 1) & 7;
  const int wbase = __builtin_amdgcn_readfirstlane(wid) * 1024;
#define GEMM_STAGE(KT, BUF) do { char* a_ = lds + (BUF) * STAGE + wbase; char* w_ = a_ + 16384; \
    _Pragma("unroll") for (int i = 0; i < 4; ++i) GLDS16(ap + (size_t)(32 * i) * lda + (KT) * 64, a_ + i * 4096); \
    _Pragma("unroll") for (int i = 0; i < NT; ++i) GLDS16(wp + (size_t)(32 * i) * ldw + (KT) * 64, w_ + i * 4096); } while (0)
#define GEMM_LDFR(BUF, KS, BF, AF) do { const char* a = lds + (BUF) * STAGE; const char* w = a + 16384; const int co = (((KS) * 4 + fq) ^ sw) * 16; \
      _Pragma("unroll") for (int mi = 0; mi < 4; ++mi) BF[mi] = *(const bf16x8*)(a + (wr * 64 + mi * 16 + fr) * 128 + co); \
      _Pragma("unroll") for (int ni = 0; ni < NT; ++ni) AF[ni] = *(const bf16x8*)(w + (wc * NT * 16 + ni * 16 + fr) * 128 + co); } while (0)
#define GEMM_MMA(BF, AF) do { \
      _Pragma("unroll") for (int mi = 0; mi < 4; ++mi) \
        _Pragma("unroll") for (int ni = 0; ni < NT; ++ni) acc[mi][ni] = __builtin_amdgcn_mfma_f32_16x16x32_bf16(AF[ni], BF[mi], acc[mi][ni], 0, 0, 0); } while (0)
#define GEMM_COMPUTE(BUF) do { bf16x8 bf0[4], af0[NT], bf1[4], af1[NT]; \
    GEMM_LDFR(BUF, 0, bf0, af0); \
    __builtin_amdgcn_sched_barrier(0); \
    GEMM_LDFR(BUF, 1, bf1, af1); \
    GEMM_MMA(bf0, af0); \
    __builtin_amdgcn_sched_barrier(0); \
    GEMM_MMA(bf1, af1); } while (0)
  GEMM_STAGE(0, 0);
  if constexpr (RSK != 0) row_rstd_table<RSK>(A, lda, lds);
  __syncthreads();
  for (int kt = 0; kt + 1 < nk; ++kt) {
    GEMM_STAGE(kt + 1, (kt + 1) & 1);
    GEMM_COMPUTE(kt & 1);
    __syncthreads();
  }
  GEMM_COMPUTE((nk - 1) & 1);
  __syncthreads();
#undef GEMM_COMPUTE
#undef GEMM_MMA
#undef GEMM_LDFR
#undef GEMM_STAGE
}
template <int NT> DI void zero_acc(f32x4 (&acc)[4][NT]) {
#pragma unroll
  for (int mi = 0; mi < 4; ++mi)
#pragma unroll
    for (int ni = 0; ni < NT; ++ni) acc[mi][ni] = (f32x4){0.f, 0.f, 0.f, 0.f};
}
DI float ssq8(uint4 v) { const float a = lo2f(v.x), b = hi2f(v.x), c = lo2f(v.y), d = hi2f(v.y), e = lo2f(v.z), f = hi2f(v.z), g = lo2f(v.w), h = hi2f(v.w); return a * a + b * b + c * c + d * d + e * e + f * f + g * g + h * h; }
DI void store4bf(bf16_t* p, f32x4 v) { uint2 w; w.x = pack2(v[0], v[1]); w.y = pack2(v[2], v[3]); *(uint2*)p = w; }

template <int K>
DI void row_rstd_table(const bf16_t* A, int lda, char* lds) {
  const int tid = tidx(), row = tid >> 1, hf = tid & 1;
  const bf16_t* p = A + (size_t)row * lda + hf * (K >> 1);
  float ss = 0.f;
#pragma unroll
  for (int i0 = 0; i0 < (K >> 4); i0 += 8) {
    uint4 v[8];
#pragma unroll
    for (int i = 0; i < 8; ++i) v[i] = *(const uint4*)(p + (i0 + i) * 8);
#pragma unroll
    for (int i = 0; i < 8; ++i) ss += ssq8(v[i]);
  }
  ss += __shfl_xor(ss, 1);
  if (hf == 0) ((float*)(lds + LDS_RS))[row] = rsqrtf(ss / (float)K + EPS);
}

DI void phase0(const Params& P, char* lds) {
  const int tid = tidx(), lane = tid & 63, wid = tid >> 6;
  float* sil = (float*)lds;
  float* part = (float*)(lds + 9 * 1024 * 4);
  float* MOD = (float*)(P.ws + OFF_MOD);
  for (int u = blockIdx.x; u < 192 + 384 + 1; u += gridDim.x) {
    if (u < 192) {
      const int l = u / 96, cg_ = u % 96;
      __syncthreads();
      for (int i = tid; i < 9 * 1024; i += 256) { const int r = i >> 10, k = i & 1023; const float v = r < 8 ? P.c[r * 1024 + k] : P.c_ctx[k]; sil[i] = siluf_(v); }
      __syncthreads();
      float acc[9];
#pragma unroll
      for (int r = 0; r < 9; ++r) acc[r] = 0.f;
      const float* wm = P.w_mod + (size_t)l * 1024 * 6144 + cg_ * 64 + lane;
      for (int k = wid * 256; k < wid * 256 + 256; k += 8) {
        float w[8];
#pragma unroll
        for (int e = 0; e < 8; ++e) w[e] = wm[(size_t)(k + e) * 6144];
#pragma unroll
        for (int e = 0; e < 8; ++e)
#pragma unroll
          for (int r = 0; r < 9; ++r) acc[r] += sil[r * 1024 + k + e] * w[e];
      }
#pragma unroll
      for (int r = 0; r < 9; ++r) part[(wid * 9 + r) * 64 + lane] = acc[r];
      __syncthreads();
      for (int i = tid; i < 9 * 64; i += 256) {
        const int r = i >> 6, cc = i & 63;
        const float s = part[(0 * 9 + r) * 64 + cc] + part[(1 * 9 + r) * 64 + cc] + part[(2 * 9 + r) * 64 + cc] + part[(3 * 9 + r) * 64 + cc];
        MOD[((size_t)l * 9 + r) * 6144 + cg_ * 64 + cc] = s + P.b_mod[l * 6144 + cg_ * 64 + cc];
      }
    } else if (u < 192 + 384) {
      const int i = (u - 192) * 256 + tid;
      const int t = i / 48, e = i % 48;
      const float rowid = (float)(t >> 6), colid = (float)(t & 63);
      if (e < 16) {
        const int fi = e & 7; const float fr_ = powf(10000.0f, -(float)fi / 8.0f);
        const float ang = (e < 8 ? rowid : colid) * fr_;
        ((float*)(P.ws + OFF_RM))[t * 16 + e] = cosf(ang);
        ((float*)(P.ws + OFF_RM))[2048 * 16 + t * 16 + e] = sinf(ang);
      } else {
        const int e2 = e - 16, fi = e2 & 15; const float fr_ = powf(10000.0f, -(float)fi / 16.0f);
        const float ang = (e2 < 16 ? rowid : colid) * fr_;
        ((float*)(P.ws + OFF_RD))[t * 32 + e2] = cosf(ang);
        ((float*)(P.ws + OFF_RD))[2048 * 32 + t * 32 + e2] = sinf(ang);
      }
    } else {
      if (tid < 2) {
        const float* dl = P.diff_lambda + tid * 256;
        float s1 = 0.f, s2 = 0.f;
        for (int i = 0; i < 64; ++i) { s1 += dl[i] * dl[64 + i]; s2 += dl[128 + i] * dl[192 + i]; }
        ((float*)(P.ws + OFF_LAM))[tid] = expf(s1) - expf(s2) + lam_init_of(tid);
      }
    }
  }
}

constexpr int CT_WIN = (N1 / 64) * 16, CT_WMG = CT_WIN + 48 * 16, CT_WUQ = CT_WMG + 24 * 6, CT_WUKV = CT_WUQ + 32 * 4, CT_WLRU = CT_WUKV + 64 * 2,
              CT_WBR = CT_WLRU + 4 * 16 * 16, CT_WFI = CT_WBR + 88 * 16, CT_WFO = CT_WFI + 16 * 44;
DI void convert_weights(const Params& P, int l, char* lds) {
  const int tid = tidx();
  bf16_t* tl = (bf16_t*)lds;
  for (int t = blockIdx.x; t < CT_WFO; t += gridDim.x) {
    int m, lt, NTl, K; bf16_t* dst; const float* sbase; int sstride; const float* kscale = nullptr;
    if (t < CT_WIN) { m = 0; lt = t; NTl = N1 / 64; K = 1024; dst = (bf16_t*)(P.ws + OFF_WIN); sbase = P.w_in + (size_t)l * 1024 * INC; sstride = INC; }
    else if (t < CT_WMG) { m = 1; lt = t - CT_WIN; NTl = 48; K = 1024; dst = (bf16_t*)(P.ws + OFF_WMG); sbase = P.w_in + (size_t)l * 1024 * INC; sstride = INC; }
    else if (t < CT_WUQ) { m = 2; lt = t - CT_WMG; NTl = 24; K = 384; dst = (bf16_t*)(P.ws + OFF_WUQ); sbase = P.mla_w_uq + (size_t)l * 384 * 1536; sstride = 1536; kscale = P.mla_qn_g + l * 384; }
    else if (t < CT_WUKV) { m = 3; lt = t - CT_WUQ; NTl = 32; K = 256; dst = (bf16_t*)(P.ws + OFF_WUKV); sbase = P.mla_w_ukv + (size_t)l * 256 * 2048; sstride = 2048; kscale = P.mla_kvn_g + l * 256; }
    else if (t < CT_WLRU) { m = 4; lt = t - CT_WUKV; NTl = 64; K = 128; dst = (bf16_t*)(P.ws + OFF_WLRU); sbase = nullptr; sstride = 128; }
    else if (t < CT_WBR) { const int q = t - CT_WLRU; const int mm = q >> 8; m = 5; lt = q & 255; NTl = 16; K = 1024; dst = (bf16_t*)(P.ws + OFF_WBRA + (size_t)mm * (OFF_WBRB - OFF_WBRA));
      sbase = (mm == 0 ? P.w_br_a : mm == 1 ? P.w_br_b : mm == 2 ? P.w_br_c : P.w_out) + (size_t)l * 1024 * 1024; sstride = 1024; }
    else if (t < CT_WFI) { m = 6; lt = t - CT_WBR; NTl = 88; K = 1024; dst = (bf16_t*)(P.ws + OFF_WFI); sbase = P.w_ffn_in + (size_t)l * 1024 * 5632; sstride = 5632; }
    else { m = 7; lt = t - CT_WFI; NTl = 16; K = FH; dst = (bf16_t*)(P.ws + OFF_WFO); sbase = P.w_ffn_out + (size_t)l * FH * 1024; sstride = 1024; }
    const int tn = lt % NTl, tk = lt / NTl;
    const int n = tn * 64 + (tid & 15) * 4;
    int sc = n; const float* sb = sbase;
    if (m == 0) { if (n < 2048) sc = n; else if (n < 2816) { const int j = n - 2048; sc = j < 672 ? 2048 + j : -1; } else sc = 2720 + (n - 2816); }
    else if (m == 1) sc = 5792 + n;
    else if (m == 4) { const int blk = n >> 9, r = (n >> 8) & 1, q4 = (n >> 6) & 3, g32 = (n >> 5) & 1, gate = (n >> 4) & 1, cc = n & 15;
      sb = (gate ? P.lru_wi : P.lru_wa) + (((size_t)l * 2 + r) * 8 + blk) * 128 * 128; sc = q4 * 32 + g32 * 16 + cc; }
    else if (m == 6) { const int tn2 = n >> 7, c16 = (n >> 5) & 3, gate = (n >> 4) & 1, cc = n & 15; sc = gate * FH + tn2 * 64 + c16 * 16 + cc; }
    __syncthreads();
#pragma unroll
    for (int p = 0; p < 4; ++p) {
      const int kl = (tid >> 4) + 16 * p, k = tk * 64 + kl;
      f32x4 v = {0.f, 0.f, 0.f, 0.f};
      if (sc >= 0) v = *(const f32x4*)(sb + (size_t)k * sstride + sc);
      if (kscale) v = v * kscale[k];
      const int nl = (tid & 15) * 4;
      tl[(nl + 0) * 72 + kl] = f2bf(v[0]); tl[(nl + 1) * 72 + kl] = f2bf(v[1]); tl[(nl + 2) * 72 + kl] = f2bf(v[2]); tl[(nl + 3) * 72 + kl] = f2bf(v[3]);
    }
    __syncthreads();
    {
      const int nl = tid >> 2, kc = (tid & 3) * 16;
      const uint4 a = *(const uint4*)(tl + nl * 72 + kc), b2 = *(const uint4*)(tl + nl * 72 + kc + 8);
      bf16_t* d = dst + (size_t)(tn * 64 + nl) * K + tk * 64 + kc;
      *(uint4*)d = a; *(uint4*)(d + 8) = b2;
    }
  }
}
static_assert(OFF_WBRC - OFF_WBRB == OFF_WBRB - OFF_WBRA && OFF_WOUT - OFF_WBRC == OFF_WBRB - OFF_WBRA, "br weights equally spaced");

DI void norm_phase(const Params& P, int l, int half_, int which  , int nrows, int rph = 0  ) {
  const int lane = tidx() & 63, wid = tidx() >> 6;
  const float* g = (which == 0 ? P.norm1_g : P.norm2_g) + l * 1024;
  const float* MOD = (const float*)(P.ws + OFF_MOD) + (size_t)l * 9 * 6144;
  bf16_t* H = (bf16_t*)(P.ws + OFF_HBF);
  for (int grow = blockIdx.x * 4 + wid; grow < nrows; grow += gridDim.x * 4) {
    const int half = rph ? grow / rph : half_, row = rph ? grow % rph : grow;
    const RowInfo ri = rowinfo(row);
    const float* src = (which == 0 && l == 0) ? input_ptr(P, half, row) : resid_ptr(P, half, row);
    const float* md = MOD + (size_t)(ri.isctx ? 8 : half * HB + ri.bl) * 6144 + (which == 0 ? 0 : 3072);
    f32x4 v[4]; float ss = 0.f;
#pragma unroll
    for (int i = 0; i < 4; ++i) { v[i] = *(const f32x4*)(src + i * 256 + lane * 4); ss += v[i][0] * v[i][0] + v[i][1] * v[i][1] + v[i][2] * v[i][2] + v[i][3] * v[i][3]; }
#pragma unroll
    for (int o = 1; o < 64; o <<= 1) ss += __shfl_xor(ss, o);
    const float rstd = rsqrtf(ss * (1.0f / 1024.0f) + EPS);
#pragma unroll
    for (int i = 0; i < 4; ++i) {
      const int c0 = i * 256 + lane * 4;
      const f32x4 gg = *(const f32x4*)(g + c0), sh = *(const f32x4*)(md + c0), sc = *(const f32x4*)(md + 1024 + c0);
      f32x4 o;
#pragma unroll
      for (int j = 0; j < 4; ++j) o[j] = v[i][j] * rstd * gg[j] * (1.0f + sc[j]) + sh[j];
      store4bf(H + (size_t)grow * 1024 + c0, o);
    }
  }
}

DI void g1_phase(const Params& P, int l, int half, char* lds) {
  const int tid = tidx(), lane = tid & 63, wid = tid >> 6, wr = wid >> 1, wc = wid & 1, fr = lane & 15, fq = lane >> 4;
  const bf16_t* H = (const bf16_t*)(P.ws + OFF_HBF);
  const bf16_t* W = (const bf16_t*)(P.ws + OFF_WIN);
  const float* RDc = (const float*)(P.ws + OFF_RD); const float* RDs = RDc + 2048 * 32;
  constexpr int MT = MH / 128, NTL = N1 / 128;
  for (int u = blockIdx.x; u < MT * NTL; u += gridDim.x) {
    const int tn = u / MT, tm = u % MT;
    f32x4 acc[4][4]; zero_acc<4>(acc);
    gemm_core<4>(acc, H + (size_t)tm * 128 * 1024, 1024, W + (size_t)tn * 128 * 1024, 1024, 1024, lds);
    const int rowb = tm * 128 + wr * 64 + fr;
    if (tn < 8) {
      bf16_t* O = (bf16_t*)(P.ws + OFF_RX);
#pragma unroll
      for (int mi = 0; mi < 4; ++mi)
#pragma unroll
        for (int ni = 0; ni < 4; ++ni) store4bf(O + (size_t)(rowb + mi * 16) * 1024 + tn * 128 + wc * 64 + ni * 16 + fq * 4, acc[mi][ni]);
    } else if (tn < 16) {
      bf16_t* O = (bf16_t*)(P.ws + OFF_GRG);
#pragma unroll
      for (int mi = 0; mi < 4; ++mi)
#pragma unroll
        for (int ni = 0; ni < 4; ++ni) { f32x4 v = acc[mi][ni];
#pragma unroll
          for (int j = 0; j < 4; ++j) v[j] = geluf_(v[j]);
          store4bf(O + (size_t)(rowb + mi * 16) * 1024 + (tn - 8) * 128 + wc * 64 + ni * 16 + fq * 4, v); }
    } else if (tn < 22) {
      bf16_t* O = (bf16_t*)(P.ws + OFF_CQKV);
#pragma unroll
      for (int mi = 0; mi < 4; ++mi)
#pragma unroll
        for (int ni = 0; ni < 4; ++ni) store4bf(O + (size_t)(rowb + mi * 16) * 768 + (tn - 16) * 128 + wc * 64 + ni * 16 + fq * 4, acc[mi][ni]);
    } else if (tn < 38) {
      const int isk = tn >= 30; const int tl = isk ? tn - 30 : tn - 22;
      bf16_t* O = (bf16_t*)(P.ws + (isk ? OFF_DK : OFF_DQ));
      const float* g = (isk ? P.diff_k_g : P.diff_q_g) + l * 64;
#pragma unroll
      for (int mi = 0; mi < 4; ++mi) {
        const int row = rowb + mi * 16; const RowInfo ri = rowinfo(row);
        float ss = 0.f;
#pragma unroll
        for (int ni = 0; ni < 4; ++ni)
#pragma unroll
          for (int j = 0; j < 4; ++j) ss += acc[mi][ni][j] * acc[mi][ni][j];
        ss += __shfl_xor(ss, 16); ss += __shfl_xor(ss, 32);
        const float rstd = rsqrtf(ss * (1.0f / 64.0f) + EPS);
#pragma unroll
        for (int ni = 0; ni < 4; ++ni) {
          const int d0 = ni * 16 + fq * 4;
          const f32x4 gg = *(const f32x4*)(g + d0);
          f32x4 y;
#pragma unroll
          for (int j = 0; j < 4; ++j) y[j] = acc[mi][ni][j] * rstd * gg[j];
          if (!ri.isctx) {
            const int pi = d0 >> 1;
            const float c0 = RDc[ri.t * 32 + pi], s0 = RDs[ri.t * 32 + pi], c1 = RDc[ri.t * 32 + pi + 1], s1 = RDs[ri.t * 32 + pi + 1];
            const float a0 = y[0] * c0 - y[1] * s0, a1 = y[0] * s0 + y[1] * c0, a2 = y[2] * c1 - y[3] * s1, a3 = y[2] * s1 + y[3] * c1;
            y = (f32x4){a0, a1, a2, a3};
          }
          store4bf(O + (size_t)row * 1024 + tl * 128 + wc * 64 + d0, y);
        }
      }
    } else {
      bf16_t* O = (bf16_t*)(P.ws + OFF_DVT);
      const int h = tn - 38;
#pragma unroll
      for (int mi = 0; mi < 4; ++mi) {
        const int row = rowb + mi * 16; const RowInfo ri = rowinfo(row);
        const int pos = keypos(ri.isctx ? 2048 + ri.t : ri.t);
        bf16_t* ob = O + ((size_t)(ri.bl * 8 + h) * 128) * NKEY + pos;
#pragma unroll
        for (int ni = 0; ni < 4; ++ni)
#pragma unroll
          for (int j = 0; j < 4; ++j) ob[(size_t)(wc * 64 + ni * 16 + fq * 4 + j) * NKEY] = f2bf(acc[mi][ni][j]);
      }
    }
  }
}

template <int CTRL> DI float dppf(float old, float v) { return __int_as_float(__builtin_amdgcn_update_dpp(__float_as_int(old), __float_as_int(v), CTRL, 0xf, 0xf, false)); }
template <int R> DI void row_scan(float& a, float& b) {
  constexpr int B0 = R == 0 ? 0x110 : 0x100;
  { const float ap = dppf<B0 + 1>(1.0f, a), bp = dppf<B0 + 1>(0.0f, b); b = a * bp + b; a = a * ap; }
  { const float ap = dppf<B0 + 2>(1.0f, a), bp = dppf<B0 + 2>(0.0f, b); b = a * bp + b; a = a * ap; }
  { const float ap = dppf<B0 + 4>(1.0f, a), bp = dppf<B0 + 4>(0.0f, b); b = a * bp + b; a = a * ap; }
  { const float ap = dppf<B0 + 8>(1.0f, a), bp = dppf<B0 + 8>(0.0f, b); b = a * bp + b; a = a * ap; }
}
DI void conv_items(const Params& P, int l, int item0, int nitems) {
  const bf16_t* RX = (const bf16_t*)(P.ws + OFF_RX);
  bf16_t* XV = (bf16_t*)(P.ws + OFF_XCV);
  const int it = item0 + tidx();
  if (it >= nitems) return;
  const int row0 = (it >> 7) * 8, ch = (it & 127) * 8;
  const RowInfo ri = rowinfo(row0); const int Tseq = ri.isctx ? 256 : 2048;
  uint4 tv[11];
#pragma unroll
  for (int i = 0; i < 11; ++i) {
    const int tt = ri.t + i - 2; const bool ok = tt >= 0 && tt < Tseq;
    const uint4 v = *(const uint4*)(RX + (size_t)(row0 + (ok ? i - 2 : 0)) * 1024 + ch);
    tv[i] = ok ? v : make_uint4(0u, 0u, 0u, 0u);
  }
  float cwf[4][8], bias[8];
#pragma unroll
  for (int e = 0; e < 8; ++e) bias[e] = P.conv_b[l * 1024 + ch + e];
#pragma unroll
  for (int j = 0; j < 4; ++j)
#pragma unroll
    for (int e = 0; e < 8; ++e) cwf[j][e] = P.conv_w[((size_t)l * 4 + j) * 1024 + ch + e];
#pragma unroll
  for (int o = 0; o < 8; ++o) {
    float a8[8];
#pragma unroll
    for (int e = 0; e < 8; ++e) a8[e] = bias[e];
#pragma unroll
    for (int j = 0; j < 4; ++j) {
      const unsigned w[4] = {tv[o + j].x, tv[o + j].y, tv[o + j].z, tv[o + j].w};
#pragma unroll
      for (int e = 0; e < 4; ++e) { a8[2 * e] += lo2f(w[e]) * cwf[j][2 * e]; a8[2 * e + 1] += hi2f(w[e]) * cwf[j][2 * e + 1]; }
    }
    uint4 ov; ov.x = pack2(a8[0], a8[1]); ov.y = pack2(a8[2], a8[3]); ov.z = pack2(a8[4], a8[5]); ov.w = pack2(a8[6], a8[7]);
    *(uint4*)(XV + (size_t)(row0 + o) * 1024 + ch) = ov;
  }
}

template <int R>
DI void lru_seq_step(const Params& P, int l, int row0, int blk, int q4, bool need_out, float (&hcar)[4], const char* As, const char* Wsb, char* lds, int next_row0, bool has_next) {
  const int tid = tidx(), lane = tid & 63, wid = tid >> 6, wr = wid >> 1, wc = wid & 1, fr = lane & 15, fq = lane >> 4;
  float2* XW = (float2*)(lds + LDS_SEG);
  const int chq = wc * 16 + fq * 4, chg = blk * 128 + q4 * 32 + chq;
  bf16_t* TMP = (bf16_t*)(P.ws + OFF_RX);
  bf16_t* GRG = (bf16_t*)(P.ws + OFF_GRG);
  uint2 pf[4], pg[4];
  if (R == 1 && need_out) {
#pragma unroll
    for (int mi = 0; mi < 4; ++mi) { const size_t o = (size_t)(row0 + wr * 64 + mi * 16 + fr) * 1024 + chg; pf[mi] = *(const uint2*)(TMP + o); pg[mi] = *(const uint2*)(GRG + o); }
  }
  asm volatile("s_waitcnt vmcnt(0)" ::: "memory");
  __syncthreads();
  f32x4 acc[4][2]; zero_acc<2>(acc);
#pragma unroll
  for (int ks = 0; ks < 4; ++ks) {
    bf16x8 bfr[4], afr[2];
#pragma unroll
    for (int mi = 0; mi < 4; ++mi) bfr[mi] = *(const bf16x8*)(As + (wr * 64 + mi * 16 + fr) * 256 + (((ks * 4 + fq) ^ fr) * 16));
#pragma unroll
    for (int ni = 0; ni < 2; ++ni) afr[ni] = *(const bf16x8*)(Wsb + (wc * 32 + ni * 16 + fr) * 256 + (((ks * 4 + fq) ^ fr) * 16));
#pragma unroll
    for (int mi = 0; mi < 4; ++mi)
#pragma unroll
      for (int ni = 0; ni < 2; ++ni) acc[mi][ni] = __builtin_amdgcn_mfma_f32_16x16x32_bf16(afr[ni], bfr[mi], acc[mi][ni], 0, 0, 0);
  }
  float xcv[4][4];
#pragma unroll
  for (int mi = 0; mi < 4; ++mi) {
    const int tok = wr * 64 + mi * 16 + fr;
    const uint2 x2 = *(const uint2*)(As + tok * 256 + (((q4 * 4 + wc * 2 + (fq >> 1)) ^ fr) * 16) + (fq & 1) * 8);
    xcv[mi][0] = lo2f(x2.x); xcv[mi][1] = hi2f(x2.x); xcv[mi][2] = lo2f(x2.y); xcv[mi][3] = hi2f(x2.y);
  }
  float spl[4], bav[4], biv[4];
  {
    const f32x4* PRM = (const f32x4*)(lds + LDS_SEG + 1024);
#pragma unroll
    for (int j = 0; j < 4; ++j) { const f32x4 pv = PRM[R * 32 + chq + j]; spl[j] = pv[0]; bav[j] = pv[1]; biv[j] = pv[2]; }
  }
  asm volatile("s_waitcnt lgkmcnt(0)" ::: "memory");
  __syncthreads();
  if (has_next) {
    const bf16_t* XV = (const bf16_t*)(P.ws + OFF_XCV);
    const int wbase = __builtin_amdgcn_readfirstlane(wid) * 1024;
    const int xrow = tid >> 4, xsrc = (tid & 15) ^ (xrow & 15);
#pragma unroll
    for (int i = 0; i < 8; ++i) GLDS16(XV + (size_t)(next_row0 + xrow + 16 * i) * 1024 + blk * 128 + xsrc * 8, (char*)As + wbase + i * 4096);
  }
  float av[4][4], bv[4][4];
#pragma unroll
  for (int mi = 0; mi < 4; ++mi)
#pragma unroll
    for (int j = 0; j < 4; ++j) {
      const float sr = __builtin_amdgcn_rcpf(1.0f + __expf(-(acc[mi][0][j] + bav[j]))), si = __builtin_amdgcn_rcpf(1.0f + __expf(-(acc[mi][1][j] + biv[j])));
      const float la = -8.0f * sr * spl[j];
      const float a = __expf(la);
      av[mi][j] = a; bv[mi][j] = __builtin_amdgcn_sqrtf(fmaxf(0.f, 1.0f - a * a)) * si * xcv[mi][j];
    }
  const int endlane = (lane & ~15) | (R == 0 ? 15 : 0);
  float Ac[4][4], Bc[4][4], Aw[4], Bw[4];
#pragma unroll
  for (int j = 0; j < 4; ++j) { Aw[j] = 1.f; Bw[j] = 0.f; }
#pragma unroll
  for (int m = 0; m < 4; ++m) {
    const int mi = R == 0 ? m : 3 - m;
#pragma unroll
    for (int j = 0; j < 4; ++j) {
      row_scan<R>(av[mi][j], bv[mi][j]);
      const float At = __shfl(av[mi][j], endlane), Bt = __shfl(bv[mi][j], endlane);
      Ac[mi][j] = Aw[j]; Bc[mi][j] = Bw[j];
      Bw[j] = At * Bw[j] + Bt; Aw[j] = At * Aw[j];
    }
  }
  if (fr == 0) {
#pragma unroll
    for (int j = 0; j < 4; ++j) XW[wr * 32 + chq + j] = make_float2(Aw[j], Bw[j]);
  }
  asm volatile("s_waitcnt lgkmcnt(0)" ::: "memory");
  __builtin_amdgcn_s_barrier();
  asm volatile("" ::: "memory");
  const int first = R == 0 ? 0 : 1;
#pragma unroll
  for (int j = 0; j < 4; ++j) {
    const float2 e0 = XW[first * 32 + chq + j], e1 = XW[(1 - first) * 32 + chq + j];
    const float hw = (wr == first) ? hcar[j] : e0.x * hcar[j] + e0.y;
    float hout[4];
#pragma unroll
    for (int mi = 0; mi < 4; ++mi) { const float hb = Ac[mi][j] * hw + Bc[mi][j]; hout[mi] = av[mi][j] * hb + bv[mi][j]; }
#pragma unroll
    for (int mi = 0; mi < 4; ++mi) av[mi][j] = hout[mi];
    hcar[j] = e1.x * (e0.x * hcar[j] + e0.y) + e1.y;
  }
  if (need_out) {
#pragma unroll
    for (int mi = 0; mi < 4; ++mi) {
      const size_t o = (size_t)(row0 + wr * 64 + mi * 16 + fr) * 1024 + chg;
      if (R == 0) { store4bf(TMP + o, (f32x4){av[mi][0], av[mi][1], av[mi][2], av[mi][3]}); }
      else {
        const f32x4 y = {(av[mi][0] + lo2f(pf[mi].x)) * lo2f(pg[mi].x), (av[mi][1] + hi2f(pf[mi].x)) * hi2f(pg[mi].x),
                         (av[mi][2] + lo2f(pf[mi].y)) * lo2f(pg[mi].y), (av[mi][3] + hi2f(pf[mi].y)) * hi2f(pg[mi].y)};
        store4bf(GRG + o, y);
      }
    }
  }
}
DI void lru_seq_unit(const Params& P, int l, int u, char* lds) {
  const int tid = tidx(), wid = tid >> 6;
  const int bl = u >> 5, blk = (u >> 2) & 7, q4 = u & 3;
  const bf16_t* WL = (const bf16_t*)(P.ws + OFF_WLRU);
  const bf16_t* XV = (const bf16_t*)(P.ws + OFF_XCV);
  char* As = lds;
  char* Wb = lds + 32768;
  __syncthreads();
  const int wbase = __builtin_amdgcn_readfirstlane(wid) * 1024;
  {
    const int wrow = tid >> 4, wsrc = (tid & 15) ^ (wrow & 15);
#pragma unroll
    for (int r = 0; r < 2; ++r) {
      const bf16_t* ws_ = WL + (size_t)(blk * 512 + r * 256 + q4 * 64 + wrow) * 128 + wsrc * 8;
#pragma unroll
      for (int i = 0; i < 4; ++i) GLDS16(ws_ + (size_t)(16 * i) * 128, Wb + r * 16384 + wbase + i * 4096);
    }
    if (tid < 64) {
      const int r = tid >> 5, c = tid & 31, ch = blk * 128 + q4 * 32 + c;
      const float lm = P.lru_lambda[(l * 2 + r) * 1024 + ch];
      const float sp_ = (lm > 15.f) ? __expf(-lm) : log1pf(__expf(-lm));
      ((f32x4*)(lds + LDS_SEG + 1024))[tid] = (f32x4){sp_, P.lru_ba[(l * 2 + r) * 1024 + ch], P.lru_bi[(l * 2 + r) * 1024 + ch], 0.f};
    }
    const int xrow = tid >> 4, xsrc = (tid & 15) ^ (xrow & 15);
    const int r0 = ML + bl * 256;
#pragma unroll
    for (int i = 0; i < 8; ++i) GLDS16(XV + (size_t)(r0 + xrow + 16 * i) * 1024 + blk * 128 + xsrc * 8, As + wbase + i * 4096);
  }
  const bool ctx_out = (l == 0);
  float hcar[4] = {0.f, 0.f, 0.f, 0.f};
  for (int s = 0; s < 18; ++s) {
    const int row0 = s < 2 ? ML + bl * 256 + s * 128 : bl * 2048 + (s - 2) * 128;
    const int sn = s + 1;
    const int nrow0 = sn < 18 ? (sn < 2 ? ML + bl * 256 + sn * 128 : bl * 2048 + (sn - 2) * 128) : ML + bl * 256 + 128;
    lru_seq_step<0>(P, l, row0, blk, q4, s >= 2 || ctx_out, hcar, As, Wb, lds, nrow0, true);
  }
#pragma unroll
  for (int j = 0; j < 4; ++j) hcar[j] = 0.f;
  for (int s = 0; s < 18; ++s) {
    const int row0 = s < 2 ? ML + bl * 256 + (1 - s) * 128 : bl * 2048 + (15 - (s - 2)) * 128;
    const int sn = s + 1;
    const int nrow0 = sn < 2 ? ML + bl * 256 + (1 - sn) * 128 : bl * 2048 + (15 - (sn - 2)) * 128;
    lru_seq_step<1>(P, l, row0, blk, q4, s >= 2 || ctx_out, hcar, As, Wb + 16384, lds, nrow0, sn < 18);
  }
  asm volatile("s_waitcnt vmcnt(0)" ::: "memory");
  __syncthreads();
}

DI void pc_phase(const Params& P, int l, int half, char* lds) {
  const int tid = tidx(), lane = tid & 63, wid = tid >> 6, wr = wid >> 1, wc = wid & 1, fr = lane & 15, fq = lane >> 4;
  constexpr int MT = MH / 128;
  constexpr int NU_LRU = (MH / 8) * 128 / 256, NU_UQ = MT * 12, NU_UKV = MT * 16;
  const bf16_t* CQKV = (const bf16_t*)(P.ws + OFF_CQKV);
  const float* rs = (const float*)(lds + LDS_RS);
  const float* RMc = (const float*)(P.ws + OFF_RM); const float* RMs = RMc + 2048 * 16;
  for (int u = blockIdx.x; u < NU_LRU + NU_UQ + NU_UKV; u += gridDim.x) {
    if (u < NU_LRU) { conv_items(P, l, u * 256, (MH / 8) * 128); continue; }
    if (u < NU_LRU + NU_UQ) {
      const int v = u - NU_LRU, tn = v / MT, tm = v % MT;
      const bf16_t* A = CQKV + (size_t)tm * 128 * 768;
      __syncthreads();
      f32x4 acc[4][4]; zero_acc<4>(acc);
      gemm_core<4, 384>(acc, A, 768, (const bf16_t*)(P.ws + OFF_WUQ) + (size_t)tn * 128 * 384, 384, 384, lds);
      bf16_t* O = (bf16_t*)(P.ws + OFF_QM);
#pragma unroll
      for (int mi = 0; mi < 4; ++mi) {
        const int rl = wr * 64 + mi * 16 + fr; const float s = rs[rl];
#pragma unroll
        for (int ni = 0; ni < 4; ++ni) store4bf(O + (size_t)(tm * 128 + rl) * 1536 + tn * 128 + wc * 64 + ni * 16 + fq * 4, acc[mi][ni] * s);
      }
    } else {
      const int v = u - NU_LRU - NU_UQ, h = v / MT, tm = v % MT;
      const bf16_t* A = CQKV + (size_t)tm * 128 * 768 + 384;
      __syncthreads();
      f32x4 acc[4][4]; zero_acc<4>(acc);
      gemm_core<4, 256>(acc, A, 768, (const bf16_t*)(P.ws + OFF_WUKV) + (size_t)h * 128 * 256, 256, 256, lds);
      if (wc == 0) {
        bf16_t* O = (bf16_t*)(P.ws + OFF_KM);
        const float* kg = P.mla_k_g + l * 96;
#pragma unroll
        for (int mi = 0; mi < 4; ++mi) {
          const int rl = wr * 64 + mi * 16 + fr, row = tm * 128 + rl; const float s = rs[rl]; const RowInfo ri = rowinfo(row);
          const uint4 kr = *(const uint4*)(CQKV + (size_t)row * 768 + 640 + fq * 8);
          float k8[8] = {lo2f(kr.x), hi2f(kr.x), lo2f(kr.y), hi2f(kr.y), lo2f(kr.z), hi2f(kr.z), lo2f(kr.w), hi2f(kr.w)};
          float ss = 0.f;
#pragma unroll
          for (int e = 0; e < 8; ++e) ss += k8[e] * k8[e];
          f32x4 vv[4];
#pragma unroll
          for (int ni = 0; ni < 4; ++ni) { vv[ni] = acc[mi][ni] * s;
#pragma unroll
            for (int j = 0; j < 4; ++j) ss += vv[ni][j] * vv[ni][j]; }
          ss += __shfl_xor(ss, 16); ss += __shfl_xor(ss, 32);
          const float rstd = rsqrtf(ss * (1.0f / 96.0f) + EPS);
          bf16_t* orow = O + (size_t)row * 1536 + h * 96;
#pragma unroll
          for (int ni = 0; ni < 4; ++ni) { const int d0 = ni * 16 + fq * 4; const f32x4 gg = *(const f32x4*)(kg + d0); store4bf(orow + d0, vv[ni] * rstd * gg); }
#pragma unroll
          for (int e = 0; e < 8; ++e) k8[e] *= rstd * kg[64 + fq * 8 + e];
          if (!ri.isctx) {
#pragma unroll
            for (int e = 0; e < 4; ++e) {
              const int pi = fq * 4 + e; const float c = RMc[ri.t * 16 + pi], sn = RMs[ri.t * 16 + pi];
              const float x1 = k8[2 * e], x2 = k8[2 * e + 1]; k8[2 * e] = x1 * c - x2 * sn; k8[2 * e + 1] = x1 * sn + x2 * c;
            }
          }
          uint4 o; o.x = pack2(k8[0], k8[1]); o.y = pack2(k8[2], k8[3]); o.z = pack2(k8[4], k8[5]); o.w = pack2(k8[6], k8[7]);
          *(uint4*)(orow + 64 + fq * 8) = o;
        }
      } else {
        bf16_t* O = (bf16_t*)(P.ws + OFF_VMT);
#pragma unroll
        for (int mi = 0; mi < 4; ++mi) {
          const int rl = wr * 64 + mi * 16 + fr, row = tm * 128 + rl; const float s = rs[rl]; const RowInfo ri = rowinfo(row);
          const int pos = keypos(ri.isctx ? 2048 + ri.t : ri.t);
          bf16_t* ob = O + ((size_t)(ri.bl * 16 + h) * 64) * NKEY + pos;
#pragma unroll
          for (int ni = 0; ni < 4; ++ni)
#pragma unroll
            for (int j = 0; j < 4; ++j) ob[(size_t)(ni * 16 + fq * 4 + j) * NKEY] = f2bf(acc[mi][ni][j] * s);
        }
      }
    }
  }
}

struct QFrag { bf16x8 f0, f1, f2, f3, f4, f5; };
template <int KS> DI bf16x8 mla_qfrag(uint4 v, float rstd, const float* qg, int hh, int isctx, int t, const float* RMc, const float* RMs, float qscale) {
  float q[8] = {lo2f(v.x), hi2f(v.x), lo2f(v.y), hi2f(v.y), lo2f(v.z), hi2f(v.z), lo2f(v.w), hi2f(v.w)};
#pragma unroll
  for (int e = 0; e < 8; ++e) q[e] *= rstd * qg[KS * 16 + hh * 8 + e];
  if constexpr (KS >= 4) {
#pragma unroll
    for (int e = 0; e < 4; ++e) {
      const int pi = (KS - 4) * 8 + hh * 4 + e; const float c = isctx ? 1.0f : RMc[t * 16 + pi], sn = isctx ? 0.0f : RMs[t * 16 + pi];
      const float x1 = q[2 * e], x2 = q[2 * e + 1]; q[2 * e] = x1 * c - x2 * sn; q[2 * e + 1] = x1 * sn + x2 * c;
    }
  }
  uint4 w; w.x = pack2(q[0] * qscale, q[1] * qscale); w.y = pack2(q[2] * qscale, q[3] * qscale); w.z = pack2(q[4] * qscale, q[5] * qscale); w.w = pack2(q[6] * qscale, q[7] * qscale);
  return __builtin_bit_cast(bf16x8, w);
}
DI bf16x8 scale_qfrag(uint4 v, float qscale) {
  uint4 w; w.x = pack2(lo2f(v.x) * qscale, hi2f(v.x) * qscale); w.y = pack2(lo2f(v.y) * qscale, hi2f(v.y) * qscale);
  w.z = pack2(lo2f(v.z) * qscale, hi2f(v.z) * qscale); w.w = pack2(lo2f(v.w) * qscale, hi2f(v.w) * qscale);
  return __builtin_bit_cast(bf16x8, w);
}
template <int DK, int DV>
DI void attn_prestage(const bf16_t* __restrict__ Kb, int kstride, const bf16_t* __restrict__ Vt, int bl, int kt0, char* lds) {
  constexpr int KROW = (DK == 96) ? 256 : 128;
  constexpr int STG = 64 * KROW + DV * 128;
  const int tid = tidx();
  const int wbase = __builtin_amdgcn_readfirstlane(tid >> 6) * 1024;
  const int vrow = tid >> 3, vsrc = (tid & 7) ^ ((vrow >> 1) & 7);
  const int krow = (DK == 96) ? (tid >> 4) : (tid >> 3);
  const int ksrc = (DK == 96) ? ((tid & 15) ^ (krow & 15)) : ((tid & 7) ^ ((krow >> 1) & 7));
  __syncthreads();
#pragma unroll
  for (int s = 0; s < 2; ++s) {
    const int kt_ = kt0 + s; const int keyrow0 = kt_ < 32 ? bl * 2048 + kt_ * 64 : ML + bl * 256 + (kt_ - 32) * 64;
    char* kd_ = lds + s * STG + wbase; char* vd_ = kd_ + 64 * KROW;
    if (DK == 96) { if (ksrc < 12) {
#pragma unroll
        for (int i = 0; i < 4; ++i) GLDS16(Kb + (size_t)(keyrow0 + krow + 16 * i) * kstride + ksrc * 8, kd_ + i * 4096); } }
    else {
#pragma unroll
      for (int i = 0; i < 2; ++i) GLDS16(Kb + (size_t)(keyrow0 + krow + 32 * i) * kstride + ksrc * 8, kd_ + i * 4096); }
#pragma unroll
    for (int i = 0; i < DV / 32; ++i) GLDS16(Vt + (size_t)(vrow + 32 * i) * NKEY + kt_ * 64 + vsrc * 8, vd_ + i * 4096);
  }
}
template <int DK, int DV, bool PRE = false>
DI void attn_stream(f32x16 (&O)[DV / 32], float& lsum, const QFrag& qf, const bf16_t* __restrict__ Kb, int kstride, const bf16_t* __restrict__ Vt,
                    int bl, int kt0, int kt1, char* lds) {
  constexpr int KROW = (DK == 96) ? 256 : 128;
  constexpr int STG = 64 * KROW + DV * 128;
  const int tid = tidx(), lane = tid & 63, r = lane & 31, hh = lane >> 5;
  const int wbase = __builtin_amdgcn_readfirstlane(tid >> 6) * 1024;
  const int vrow = tid >> 3, vsrc = (tid & 7) ^ ((vrow >> 1) & 7);
  const int krow = (DK == 96) ? (tid >> 4) : (tid >> 3);
  const int ksrc = (DK == 96) ? ((tid & 15) ^ (krow & 15)) : ((tid & 7) ^ ((krow >> 1) & 7));
#define ATT_STAGE(KT, BUF) do { const int kt_ = (KT); const int keyrow0 = kt_ < 32 ? bl * 2048 + kt_ * 64 : ML + bl * 256 + (kt_ - 32) * 64; \
    char* kd_ = lds + (BUF) * STG + wbase; char* vd_ = kd_ + 64 * KROW; \
    if (DK == 96) { if (ksrc < 12) { _Pragma("unroll") for (int i = 0; i < 4; ++i) GLDS16(Kb + (size_t)(keyrow0 + krow + 16 * i) * kstride + ksrc * 8, kd_ + i * 4096); } } \
    else { _Pragma("unroll") for (int i = 0; i < 2; ++i) GLDS16(Kb + (size_t)(keyrow0 + krow + 32 * i) * kstride + ksrc * 8, kd_ + i * 4096); } \
    _Pragma("unroll") for (int i = 0; i < DV / 32; ++i) GLDS16(Vt + (size_t)(vrow + 32 * i) * NKEY + kt_ * 64 + vsrc * 8, vd_ + i * 4096); } while (0)
  float mrun = -1e30f; lsum = 0.f;
#pragma unroll
  for (int b = 0; b < DV / 32; ++b)
#pragma unroll
    for (int i = 0; i < 16; ++i) O[b][i] = 0.f;
  if (!PRE) { __syncthreads(); ATT_STAGE(kt0, 0); ATT_STAGE(kt0 + 1, 1); }
  int buf = 0, nbuf = 2;
  for (int kt = kt0; kt < kt1; ++kt) {
    if (kt + 1 < kt1) asm volatile("s_waitcnt vmcnt(6)" ::: "memory"); else asm volatile("s_waitcnt vmcnt(0)" ::: "memory");
    asm volatile("s_waitcnt lgkmcnt(0)" ::: "memory");
    __builtin_amdgcn_s_barrier();
    asm volatile("" ::: "memory");
    if (kt + 2 < kt1) ATT_STAGE(kt + 2, nbuf);
    const char* ks_ = lds + buf * STG; const char* vs_ = ks_ + 64 * KROW;
    f32x16 S[2];
    {
      const char* kp0 = ks_ + r * KROW; const char* kp1 = kp0 + 32 * KROW;
      const int ksw = (DK == 96) ? (r & 15) : ((r >> 1) & 7);
      constexpr int NKS = DK / 16;
      bf16x8 ka[NKS], kc[NKS];
#pragma unroll
      for (int i = 0; i < NKS; ++i) { const int co = ((i * 2 + hh) ^ ksw) * 16; ka[i] = *(const bf16x8*)(kp0 + co); kc[i] = *(const bf16x8*)(kp1 + co); }
      f32x16 zc;
#pragma unroll
      for (int i = 0; i < 16; ++i) zc[i] = 0.f;
      S[0] = __builtin_amdgcn_mfma_f32_32x32x16_bf16(ka[0], qf.f0, zc, 0, 0, 0);
      S[1] = __builtin_amdgcn_mfma_f32_32x32x16_bf16(kc[0], qf.f0, zc, 0, 0, 0);
#define QK_STEP(i) S[0] = __builtin_amdgcn_mfma_f32_32x32x16_bf16(ka[i], qf.f##i, S[0], 0, 0, 0); S[1] = __builtin_amdgcn_mfma_f32_32x32x16_bf16(kc[i], qf.f##i, S[1], 0, 0, 0)
      QK_STEP(1); QK_STEP(2); QK_STEP(3);
      if constexpr (DK == 96) { QK_STEP(4); QK_STEP(5); }
#undef QK_STEP
    }
    bf16x8 vpre[DV / 32][2];
#pragma unroll
    for (int b = 0; b < DV / 32; ++b)
#pragma unroll
      for (int s = 0; s < 2; ++s) vpre[b][s] = *(const bf16x8*)(vs_ + (b * 32 + r) * 128 + (((0 * 4 + s * 2 + hh) ^ ((r >> 1) & 7)) * 16));
    float mx = S[0][0];
#pragma unroll
    for (int kb = 0; kb < 2; ++kb)
#pragma unroll
      for (int i = 0; i < 16; ++i) mx = fmaxf(mx, S[kb][i]);
    { const auto sw_ = __builtin_amdgcn_permlane32_swap(__float_as_uint(mx), __float_as_uint(mx), false, false); mx = fmaxf(__uint_as_float(sw_[0]), __uint_as_float(sw_[1])); }
    const float mnew = fmaxf(mrun, mx);
    const float alpha = __builtin_amdgcn_exp2f(mrun - mnew);
    mrun = mnew;
    f32x2n psa = {0.f, 0.f}, psb = {0.f, 0.f};
    const f32x2n m2 = {mnew, mnew};
#pragma unroll
    for (int kb = 0; kb < 2; ++kb)
#pragma unroll
      for (int i = 0; i < 16; i += 4) {
        const f32x2n d0 = (f32x2n){S[kb][i], S[kb][i + 1]} - m2, d1 = (f32x2n){S[kb][i + 2], S[kb][i + 3]} - m2;
        const f32x2n e0 = {__builtin_amdgcn_exp2f(d0[0]), __builtin_amdgcn_exp2f(d0[1])}, e1 = {__builtin_amdgcn_exp2f(d1[0]), __builtin_amdgcn_exp2f(d1[1])};
        S[kb][i] = e0[0]; S[kb][i + 1] = e0[1]; S[kb][i + 2] = e1[0]; S[kb][i + 3] = e1[1];
        psa += e0; psb += e1;
      }
    lsum = lsum * alpha + ((psa[0] + psa[1]) + (psb[0] + psb[1]));
#pragma unroll
    for (int b = 0; b < DV / 32; ++b) O[b] = O[b] * alpha;
#pragma unroll
    for (int kb = 0; kb < 2; ++kb)
#pragma unroll
      for (int s = 0; s < 2; ++s) {
        uint4 pw; pw.x = pack2(S[kb][8 * s], S[kb][8 * s + 1]); pw.y = pack2(S[kb][8 * s + 2], S[kb][8 * s + 3]);
        pw.z = pack2(S[kb][8 * s + 4], S[kb][8 * s + 5]); pw.w = pack2(S[kb][8 * s + 6], S[kb][8 * s + 7]);
        const bf16x8 pf = __builtin_bit_cast(bf16x8, pw);
#pragma unroll
        for (int b = 0; b < DV / 32; ++b) {
          const bf16x8 vf = (kb == 0) ? vpre[b][s] : *(const bf16x8*)(vs_ + (b * 32 + r) * 128 + (((kb * 4 + s * 2 + hh) ^ ((r >> 1) & 7)) * 16));
          O[b] = __builtin_amdgcn_mfma_f32_32x32x16_bf16(vf, pf, O[b], 0, 0, 0);
        }
      }
    buf = (buf == 2) ? 0 : buf + 1; nbuf = (nbuf == 2) ? 0 : nbuf + 1;
  }
  __syncthreads();
}

DI void mla_unit(const Params& P, int l, int bl, int h, int qt, char* lds) {
  const int lane = tidx() & 63, wid = tidx() >> 6, r = lane & 31, hh = lane >> 5;
  const int isctx = qt >= 16;
  const int row = (isctx ? ML + bl * 256 + (qt - 16) * 128 : bl * 2048 + qt * 128) + wid * 32 + r;
  const int t = isctx ? 0 : qt * 128 + wid * 32 + r;
  attn_prestage<96, 64>((const bf16_t*)(P.ws + OFF_KM) + h * 96, 1536, (const bf16_t*)(P.ws + OFF_VMT) + ((size_t)(bl * 16 + h) * 64) * NKEY, bl, isctx ? 32 : 0, lds);
  const bf16_t* qp = (const bf16_t*)(P.ws + OFF_QM) + (size_t)row * 1536 + h * 96;
  const float* qg = P.mla_q_g + l * 96;
  const float* RMc = (const float*)(P.ws + OFF_RM); const float* RMs = RMc + 2048 * 16;
  const uint4 r0 = *(const uint4*)(qp + 0 * 16 + hh * 8), r1 = *(const uint4*)(qp + 1 * 16 + hh * 8), r2 = *(const uint4*)(qp + 2 * 16 + hh * 8),
              r3 = *(const uint4*)(qp + 3 * 16 + hh * 8), r4 = *(const uint4*)(qp + 4 * 16 + hh * 8), r5 = *(const uint4*)(qp + 5 * 16 + hh * 8);
  float ss = ssq8(r0) + ssq8(r1) + ssq8(r2) + ssq8(r3) + ssq8(r4) + ssq8(r5);
  ss += __shfl_xor(ss, 32);
  const float rstd = rsqrtf(ss * (1.0f / 96.0f) + EPS);
  const float qscale = 0.10206207261596577f * LOG2E;
  QFrag qf;
  qf.f0 = mla_qfrag<0>(r0, rstd, qg, hh, isctx, t, RMc, RMs, qscale); qf.f1 = mla_qfrag<1>(r1, rstd, qg, hh, isctx, t, RMc, RMs, qscale);
  qf.f2 = mla_qfrag<2>(r2, rstd, qg, hh, isctx, t, RMc, RMs, qscale); qf.f3 = mla_qfrag<3>(r3, rstd, qg, hh, isctx, t, RMc, RMs, qscale);
  qf.f4 = mla_qfrag<4>(r4, rstd, qg, hh, isctx, t, RMc, RMs, qscale); qf.f5 = mla_qfrag<5>(r5, rstd, qg, hh, isctx, t, RMc, RMs, qscale);
  f32x16 O[2]; float lsum;
  attn_stream<96, 64, true>(O, lsum, qf, (const bf16_t*)(P.ws + OFF_KM) + h * 96, 1536, (const bf16_t*)(P.ws + OFF_VMT) + ((size_t)(bl * 16 + h) * 64) * NKEY, bl, isctx ? 32 : 0, 36, lds);
  lsum += __shfl_xor(lsum, 32);
  const float inv = 1.0f / lsum;
  bf16_t* op = (bf16_t*)(P.ws + OFF_OB) + (size_t)row * 1024 + h * 64;
#pragma unroll
  for (int b = 0; b < 2; ++b)
#pragma unroll
    for (int g = 0; g < 4; ++g) {
      const f32x4 v = {O[b][4 * g] * inv, O[b][4 * g + 1] * inv, O[b][4 * g + 2] * inv, O[b][4 * g + 3] * inv};
      store4bf(op + b * 32 + 8 * g + 4 * hh, v);
    }
}

DI void diff_unit(const Params& P, int l, int bl, int h, int qt, char* lds) {
  const int lane = tidx() & 63, wid = tidx() >> 6, r = lane & 31, hh = lane >> 5;
  const int isctx = qt >= 16;
  const int row = (isctx ? ML + bl * 256 + (qt - 16) * 128 : bl * 2048 + qt * 128) + wid * 32 + r;
  bf16_t* qp = (bf16_t*)(P.ws + OFF_DQ) + (size_t)row * 1024 + h * 128;
  const bf16_t* Vt = (const bf16_t*)(P.ws + OFF_DVT) + ((size_t)(bl * 8 + h) * 128) * NKEY;
  const float qscale = 0.125f * LOG2E;
  const float lam = ((const float*)(P.ws + OFF_LAM))[l];
  f32x16 O[4]; float lsum;
  attn_prestage<64, 128>((const bf16_t*)(P.ws + OFF_DK) + h * 128, 1024, Vt, bl, isctx ? 32 : 0, lds);
  QFrag qa, qb;
  qa.f0 = scale_qfrag(*(const uint4*)(qp + 0 * 16 + hh * 8), qscale); qa.f1 = scale_qfrag(*(const uint4*)(qp + 1 * 16 + hh * 8), qscale);
  qa.f2 = scale_qfrag(*(const uint4*)(qp + 2 * 16 + hh * 8), qscale); qa.f3 = scale_qfrag(*(const uint4*)(qp + 3 * 16 + hh * 8), qscale);
  qa.f4 = qa.f0; qa.f5 = qa.f0;
  qb.f0 = scale_qfrag(*(const uint4*)(qp + 64 + 0 * 16 + hh * 8), qscale); qb.f1 = scale_qfrag(*(const uint4*)(qp + 64 + 1 * 16 + hh * 8), qscale);
  qb.f2 = scale_qfrag(*(const uint4*)(qp + 64 + 2 * 16 + hh * 8), qscale); qb.f3 = scale_qfrag(*(const uint4*)(qp + 64 + 3 * 16 + hh * 8), qscale);
  qb.f4 = qb.f0; qb.f5 = qb.f0;
  attn_stream<64, 128, true>(O, lsum, qa, (const bf16_t*)(P.ws + OFF_DK) + h * 128, 1024, Vt, bl, isctx ? 32 : 0, 36, lds);
  attn_prestage<64, 128>((const bf16_t*)(P.ws + OFF_DK) + h * 128 + 64, 1024, Vt, bl, isctx ? 32 : 0, lds);
  lsum += __shfl_xor(lsum, 32);
  {
    const float inv = 1.0f / lsum;
#pragma unroll
    for (int b = 0; b < 4; ++b)
#pragma unroll
      for (int g = 0; g < 4; ++g) {
        const f32x4 v = {O[b][4 * g] * inv, O[b][4 * g + 1] * inv, O[b][4 * g + 2] * inv, O[b][4 * g + 3] * inv};
        store4bf(qp + b * 32 + 8 * g + 4 * hh, v);
      }
  }
  attn_stream<64, 128, true>(O, lsum, qb, (const bf16_t*)(P.ws + OFF_DK) + h * 128 + 64, 1024, Vt, bl, isctx ? 32 : 0, 36, lds);
  lsum += __shfl_xor(lsum, 32);
  {
    const float inv = lam / lsum;
    float ss = 0.f;
#pragma unroll
    for (int b = 0; b < 4; ++b)
#pragma unroll
      for (int g = 0; g < 4; ++g) {
        const uint2 w = *(const uint2*)(qp + b * 32 + 8 * g + 4 * hh);
        const float a0 = lo2f(w.x) - O[b][4 * g] * inv, a1 = hi2f(w.x) - O[b][4 * g + 1] * inv, a2 = lo2f(w.y) - O[b][4 * g + 2] * inv, a3 = hi2f(w.y) - O[b][4 * g + 3] * inv;
        O[b][4 * g] = a0; O[b][4 * g + 1] = a1; O[b][4 * g + 2] = a2; O[b][4 * g + 3] = a3;
        ss += a0 * a0 + a1 * a1 + a2 * a2 + a3 * a3;
      }
    ss += __shfl_xor(ss, 32);
    const float rstd = rsqrtf(ss * (1.0f / 128.0f) + EPS) * (1.0f - lam_init_of(l));
    const float* sg = P.diff_subln_g + l * 128;
#pragma unroll
    for (int b = 0; b < 4; ++b)
#pragma unroll
      for (int g = 0; g < 4; ++g) {
        const int dv0 = b * 32 + 8 * g + 4 * hh;
        const f32x4 gg = *(const f32x4*)(sg + dv0);
        const f32x4 v = {O[b][4 * g] * rstd * gg[0], O[b][4 * g + 1] * rstd * gg[1], O[b][4 * g + 2] * rstd * gg[2], O[b][4 * g + 3] * rstd * gg[3]};
        store4bf(qp + dv0, v);
      }
  }
}

DI void pd_phase(const Params& P, int l, int half, int ph, char* lds) {
  const int nq_ctx = (l == 0) ? 2 : 0;
  const int n_dl = HB * 8 * 16, n_lru = HB * 8 * 4, n_ml = HB * 16 * 16, n_dc = HB * 8 * nq_ctx, n_mc = HB * 16 * nq_ctx;
  const int tot = n_dl + n_lru + n_ml + n_dc + n_mc;
  unsigned* ctr = (unsigned*)(P.ws + OFF_CTR) + ph * 8;
  volatile int* slot = (volatile int*)(lds + LDS_BAR + 8);
  const int myx = (int)((unsigned)__builtin_amdgcn_s_getreg((3 << 11) | 20) & 7u);
  for (;;) {
    __syncthreads();
    if (threadIdx.x == 0) {
      int got = -1;
      for (int y = 0; y < 8 && got < 0; ++y) {
        const int xx = (myx + y) & 7;
        const int i = (int)__hip_atomic_fetch_add(ctr + xx, 1u, __ATOMIC_RELAXED, __HIP_MEMORY_SCOPE_AGENT);
        const int uu = i * 8 + xx;
        if (uu < tot) got = uu;
      }
      *slot = got;
    }
    __syncthreads();
    const int u = *slot;
    if (u < 0) break;
    int v = u, kind, bl = 0, h = 0, qt = 0;
    if (v < n_dl) { kind = 0; const int x = v & 7, s = (v >> 3) & 63, rnd = v >> 9; const int g = x + 8 * ((s >> 4) + 4 * rnd); qt = s & 15; bl = g >> 3; h = g & 7; }
    else if ((v -= n_dl) < n_lru) { kind = 2; }
    else if ((v -= n_lru) < n_ml) { kind = 1; const int x = v & 7, s = (v >> 3) & 63, rnd = v >> 9; const int g = x + 8 * ((s >> 4) + 4 * rnd); qt = s & 15; bl = g >> 4; h = g & 15; }
    else if ((v -= n_ml) < n_dc) { kind = 0; bl = v >> 4; h = (v >> 1) & 7; qt = 16 + (v & 1); }
    else { v -= n_dc; kind = 1; bl = v >> 5; h = (v >> 1) & 15; qt = 16 + (v & 1); }
#ifndef NO_DIFF
    if (kind == 0) diff_unit(P, l, bl, h, qt, lds);
#endif
#ifndef NO_MLA
    if (kind == 1) mla_unit(P, l, bl, h, qt, lds);
#endif
#ifndef NO_LRUF
    if (kind == 2) lru_seq_unit(P, l, v, lds);
#endif
  }
}

DI void merge_phase(const Params& P, int l, int half, int MT, char* lds) {
  const int tid = tidx(), lane = tid & 63, wid = tid >> 6, wr = wid >> 1, wc = wid & 1, fr = lane & 15, fq = lane >> 4;
  const bf16_t* H = (const bf16_t*)(P.ws + OFF_HBF);
  bf16_t* Z = (bf16_t*)(P.ws + OFF_RX);
  for (int u = blockIdx.x; u < MT * 16; u += gridDim.x) {
    const int tn = u / MT, tm = u % MT, n0 = tn * 64;
    f32x4 z[4][2]; zero_acc<2>(z);
#pragma unroll 1
    for (int br = 0; br < 3; ++br) {
      const bf16_t* Ab = (const bf16_t*)(P.ws + (br == 0 ? OFF_GRG : br == 1 ? OFF_OB : OFF_DQ));
      const bf16_t* Wb = (const bf16_t*)(P.ws + OFF_WBRA + (size_t)br * (OFF_WBRB - OFF_WBRA));
      f32x4 g[4][2]; zero_acc<2>(g);
      gemm_core<2>(g, H + (size_t)tm * 128 * 1024, 1024, (const bf16_t*)(P.ws + OFF_WMG) + (size_t)(br * 1024 + n0) * 1024, 1024, 1024, lds);
#pragma unroll
      for (int mi = 0; mi < 4; ++mi)
#pragma unroll
        for (int ni = 0; ni < 2; ++ni)
#pragma unroll
          for (int j = 0; j < 4; ++j) g[mi][ni][j] = sigmoidf_(g[mi][ni][j]);
      f32x4 v[4][2]; zero_acc<2>(v);
      gemm_core<2>(v, Ab + (size_t)tm * 128 * 1024, 1024, Wb + (size_t)n0 * 1024, 1024, 1024, lds);
#pragma unroll
      for (int mi = 0; mi < 4; ++mi)
#pragma unroll
        for (int ni = 0; ni < 2; ++ni) z[mi][ni] += g[mi][ni] * v[mi][ni];
    }
#pragma unroll
    for (int mi = 0; mi < 4; ++mi)
#pragma unroll
      for (int ni = 0; ni < 2; ++ni) store4bf(Z + (size_t)(tm * 128 + wr * 64 + mi * 16 + fr) * 1024 + n0 + wc * 32 + ni * 16 + fq * 4, z[mi][ni]);
  }
}

DI void resid_gemm_phase(const Params& P, int l, int half_, int MT, const bf16_t* A, int K, const bf16_t* W, int goff, bool src_is_input, char* lds, int rph = 0) {
  const int tid = tidx(), lane = tid & 63, wid = tid >> 6, wr = wid >> 1, wc = wid & 1, fr = lane & 15, fq = lane >> 4;
  const float* MOD = (const float*)(P.ws + OFF_MOD) + (size_t)l * 9 * 6144 + goff;
  for (int u = blockIdx.x; u < MT * 16; u += gridDim.x) {
    const int tn = u / MT, tm = u % MT, n0 = tn * 64;
    f32x4 acc[4][2]; zero_acc<2>(acc);
    gemm_core<2>(acc, A + (size_t)tm * 128 * K, K, W + (size_t)n0 * K, K, K, lds);
#pragma unroll
    for (int mi = 0; mi < 4; ++mi) {
      const int grow = tm * 128 + wr * 64 + mi * 16 + fr;
      const int half = rph ? grow / rph : half_, row = rph ? grow % rph : grow; const RowInfo ri = rowinfo(row);
      const float* md = MOD + (size_t)(ri.isctx ? 8 : half * HB + ri.bl) * 6144;
      float* dst = resid_ptr(P, half, row);
      const float* src = src_is_input ? input_ptr(P, half, row) : dst;
#pragma unroll
      for (int ni = 0; ni < 2; ++ni) {
        const int c0 = n0 + wc * 32 + ni * 16 + fq * 4;
        const f32x4 gt = *(const f32x4*)(md + c0), sv = *(const f32x4*)(src + c0);
        *(f32x4*)(dst + c0) = sv + gt * acc[mi][ni];
      }
    }
  }
}

DI void ffn_in_phase(const Params& P, int l, int half, int MT, char* lds) {
  const int tid = tidx(), lane = tid & 63, wid = tid >> 6, wr = wid >> 1, wc = wid & 1, fr = lane & 15, fq = lane >> 4;
  const bf16_t* H = (const bf16_t*)(P.ws + OFF_HBF);
  bf16_t* HH = (bf16_t*)(P.ws + OFF_DQ);
  for (int u = blockIdx.x; u < MT * 44; u += gridDim.x) {
    const int tn = u / MT, tm = u % MT;
    f32x4 acc[4][4]; zero_acc<4>(acc);
    gemm_core<4>(acc, H + (size_t)tm * 128 * 1024, 1024, (const bf16_t*)(P.ws + OFF_WFI) + (size_t)tn * 128 * 1024, 1024, 1024, lds);
#pragma unroll
    for (int mi = 0; mi < 4; ++mi) {
      const int row = tm * 128 + wr * 64 + mi * 16 + fr;
#pragma unroll
      for (int q = 0; q < 2; ++q) {
        f32x4 v;
#pragma unroll
        for (int j = 0; j < 4; ++j) v[j] = siluf_(acc[mi][2 * q][j]) * acc[mi][2 * q + 1][j];
        store4bf(HH + (size_t)row * FH + tn * 64 + (wc * 2 + q) * 16 + fq * 4, v);
      }
    }
  }
}

#define XB_TMO      128
#define XB_XCNT(j)  (256  + 64 * (j))
#define XB_XSUB(j)  (1280 + 64 * (j))
#define XB_XGEN(j)  (2304 + 64 * (j))
#define XB_TOP      3328
#define XB_TOPGEN   3392
#define XCD_BAR_WORDS 3456
#define XB_SPIN_CAP (1u << 20)
#define LAS __attribute__((address_space(3)))
DI unsigned xb_ld(unsigned* p) { return __hip_atomic_load(p, __ATOMIC_RELAXED, __HIP_MEMORY_SCOPE_AGENT); }
DI unsigned xb_add(unsigned* p, unsigned v) { return __hip_atomic_fetch_add(p, v, __ATOMIC_RELAXED, __HIP_MEMORY_SCOPE_AGENT); }
DI unsigned xb_xcc_id() { return (unsigned)__builtin_amdgcn_s_getreg((3 << 11) | 20) & 0xFu; }
#define XB_SPIN(cond, bar) do { unsigned _sp = 0; while (cond) { __builtin_amdgcn_s_sleep(1); \
    if ((++_sp & 255u) == 0u) { if (xb_ld(&(bar)[XB_TMO])) break; if (_sp > XB_SPIN_CAP) { atomicAdd(&(bar)[XB_TMO], 1u); break; } } } } while (0)
struct XcdBarrier { unsigned* bar; unsigned x; volatile LAS unsigned* st; };
DI XcdBarrier xcd_barrier_post(unsigned* bar, volatile LAS unsigned* st) {
  XcdBarrier b; b.bar = bar; b.x = xb_xcc_id(); b.st = st;
  if (threadIdx.x == 0) (void)xb_add(&bar[XB_XCNT(b.x)], 1u);
  return b;
}
DI void xcd_barrier_complete(unsigned* bar, unsigned x, unsigned& nloc, unsigned& nx) {
  const unsigned G = gridDim.x * gridDim.y * gridDim.z;
  unsigned sum, cnt, mine, sp = 0u;
  for (;;) {
    sum = 0u; cnt = 0u; mine = 0u;
#pragma unroll
    for (unsigned j = 0; j < 16; ++j) { const unsigned c = xb_ld(&bar[XB_XCNT(j)]); sum += c; cnt += (c > 0u) ? 1u : 0u; mine = (j == x) ? c : mine; }
    if (sum == G) break;
    __builtin_amdgcn_s_sleep(1);
    if ((++sp & 255u) == 0u) { if (xb_ld(&bar[XB_TMO])) break; if (sp > XB_SPIN_CAP) { atomicAdd(&bar[XB_TMO], 1u); break; } }
  }
  nloc = mine > 0u ? mine : 1u; nx = cnt > 0u ? cnt : 1u;
}
DI void xcd_barrier(const XcdBarrier& b) {
  asm volatile("s_waitcnt vmcnt(0)" ::: "memory");
  __syncthreads();
  if (threadIdx.x == 0) {
    unsigned* bar = b.bar;
    __builtin_amdgcn_s_waitcnt(0);
    unsigned nloc = b.st[0], nx = b.st[1];
    if (nloc == 0u) { xcd_barrier_complete(bar, b.x, nloc, nx); b.st[0] = nloc; b.st[1] = nx; }
    const unsigned old = xb_add(&bar[XB_XSUB(b.x)], 1u);
    const unsigned gen = old / nloc;
    if (old + 1u == (gen + 1u) * nloc) {
      __builtin_amdgcn_fence(__ATOMIC_RELEASE, "agent");
      asm volatile("s_waitcnt vmcnt(0)" ::: "memory");
      const unsigned og = xb_add(&bar[XB_TOP], 1u);
      const unsigned tg = og / nx;
      if (og + 1u == (tg + 1u) * nx) xb_add(&bar[XB_TOPGEN], 1u);
      else XB_SPIN(xb_ld(&bar[XB_TOPGEN]) == tg, bar);
      __builtin_amdgcn_fence(__ATOMIC_ACQUIRE, "agent");
      xb_add(&bar[XB_XGEN(b.x)], 1u);
      asm volatile("s_waitcnt vmcnt(0)" ::: "memory");
    } else {
      XB_SPIN(xb_ld(&bar[XB_XGEN(b.x)]) == gen, bar);
      __builtin_amdgcn_fence(__ATOMIC_ACQUIRE, "agent");
      asm volatile("s_waitcnt vmcnt(0)" ::: "memory");
    }
  }
  __syncthreads();
}

constexpr int NPHASE = 1 + 2 * 15;
static_assert(OFF_RX == OFF_HBF + SZ1K, "joint HBF2 spans HBF + RX");
static_assert(OFF_QM - OFF_DQ >= (size_t)2 * MH * FH * 2, "joint HH spans DQ..VMT");
DI void run_phase(const Params& P, int ph, char* lds) {
  if (ph == 0) { phase0(P, lds); return; }
  const int q = ph - 1, l = q / 15, r = q % 15;
  const int MTl = (l == 0) ? MH / 128 : ML / 128;
  if (r >= 12) {
    const int rph = MTl * 128;
    if (r == 12) norm_phase(P, l, 0, 1, 2 * rph, rph);
    else if (r == 13) ffn_in_phase(P, l, 0, 2 * MTl, lds);
    else resid_gemm_phase(P, l, 0, 2 * MTl, (const bf16_t*)(P.ws + OFF_DQ), FH, (const bf16_t*)(P.ws + OFF_WFO), 5120, false, lds, rph);
    return;
  }
  const int half = r / 6, k = r % 6;
  switch (k) {
    case 0: if (half == 0) convert_weights(P, l, lds); norm_phase(P, l, half, 0, MH); break;
    case 1: g1_phase(P, l, half, lds); break;
    case 2: pc_phase(P, l, half, lds); break;
    case 3: pd_phase(P, l, half, ph, lds); break;
    case 4: merge_phase(P, l, half, MTl, lds); break;
    default: resid_gemm_phase(P, l, half, MTl, (const bf16_t*)(P.ws + OFF_RX), 1024, (const bf16_t*)(P.ws + OFF_WOUT), 2048, l == 0, lds); break;
  }
}

__global__ void __launch_bounds__(256, 2) fwd_kernel(Params P, int ph0, int ph1) {
  extern __shared__ __attribute__((aligned(16))) char smem[];
  volatile LAS unsigned* st = (volatile LAS unsigned*)(smem + LDS_BAR);
  if (threadIdx.x < 2) st[threadIdx.x] = 0u;
  __syncthreads();
  const XcdBarrier xb = xcd_barrier_post((unsigned*)(P.ws + OFF_BAR), st);
  for (int ph = ph0; ph < ph1; ++ph) {
    run_phase(P, ph, smem);
    if (ph + 1 < ph1) { if (ph == 0) cg::this_grid().sync(); else xcd_barrier(xb); }
  }
}

extern "C" void kernel_launch(void* const* d_in, const int* in_sizes, int n_in, void* d_out, int out_size, void* d_ws, size_t ws_size, hipStream_t stream) {
  static int grid_blocks = 0;
  if (!grid_blocks) {
    hipFuncSetAttribute((const void*)fwd_kernel, hipFuncAttributeMaxDynamicSharedMemorySize, LDS_BYTES);
    int dev = 0, cus = 0, per_cu = 0;
    hipGetDevice(&dev);
    hipDeviceGetAttribute(&cus, hipDeviceAttributeMultiprocessorCount, dev);
    hipOccupancyMaxActiveBlocksPerMultiprocessor(&per_cu, fwd_kernel, 256, LDS_BYTES);
    if (per_cu > 2) per_cu = 2;
    grid_blocks = cus * per_cu;
    if (grid_blocks <= 0) grid_blocks = 256;
  }
  if (ws_size < WS_NEED) { fprintf(stderr, "workspace too small: %zu < %zu\n", ws_size, (size_t)WS_NEED); return; }
  hipMemsetAsync((char*)d_ws + OFF_BAR, 0, XCD_BAR_WORDS * 4 + 2048, stream);
  Params p{};
  const float** f = (const float**)&p;
  for (int i = 0; i < 32; ++i) f[i] = (const float*)d_in[i];
  p.out = (float*)d_out; p.ws = (char*)d_ws;
#if ONE_LAUNCH
  int ph0 = 0, ph1 = NPHASE;
  void* args[] = {&p, &ph0, &ph1};
  hipError_t e = hipLaunchCooperativeKernel((const void*)fwd_kernel, dim3(grid_blocks), dim3(256), args, LDS_BYTES, stream);
  if (e != hipSuccess) fprintf(stderr, "cooperative launch failed: %s (grid %d)\n", hipGetErrorString(e), grid_blocks);
#else
  for (int ph = 0; ph < NPHASE; ++ph) fwd_kernel<<<grid_blocks, 256, LDS_BYTES, stream>>>(p, ph, ph + 1);
#endif
}
```

```cpp
#include <hip/hip_runtime.h>
#include <hip/hip_cooperative_groups.h>
#include <cstdio>
#include <cstdint>
namespace cg = cooperative_groups;

#ifndef ONE_LAUNCH
#define ONE_LAUNCH 1
#endif

typedef unsigned short bf16_t;
typedef short bf16x8 __attribute__((ext_vector_type(8)));
typedef float f32x4 __attribute__((ext_vector_type(4)));
typedef float f32x16 __attribute__((ext_vector_type(16)));
#define DI __device__ __forceinline__

constexpr int D = 1024, T = 2048, CT = 256, HB = 4;
constexpr int ML = HB * T;
constexpr int MC = HB * CT;
constexpr int MH = ML + MC;
constexpr int NKEY = T + CT;
constexpr int N1 = 5888;
constexpr int FH = 2816;
constexpr int INC = 8864;
constexpr float EPS = 1e-6f;
constexpr float LOG2E = 1.4426950408889634f;

constexpr size_t al(size_t x) { return (x + 255) & ~(size_t)255; }
constexpr size_t OFF_MOD = 0;
constexpr size_t OFF_RM = al(OFF_MOD + 2 * 9 * 6144 * 4);
constexpr size_t OFF_RD = al(OFF_RM + 2 * 2048 * 16 * 4);
constexpr size_t OFF_LAM = al(OFF_RD + 2 * 2048 * 32 * 4);
constexpr size_t OFF_BAR = al(OFF_LAM + 256);
constexpr size_t OFF_CTR = OFF_BAR + 3456 * 4;
constexpr size_t OFF_CARRY = al(OFF_CTR + 2048);
constexpr size_t OFF_XC = al(OFF_CARRY + (size_t)HB * 2 * 18 * 1024 * 8);
constexpr size_t OFF_WIN = al(OFF_XC + (size_t)2048 * 1024 * 4);
constexpr size_t OFF_WMG = al(OFF_WIN + (size_t)N1 * 1024 * 2);
constexpr size_t OFF_WUQ = al(OFF_WMG + (size_t)3072 * 1024 * 2);
constexpr size_t OFF_WUKV = al(OFF_WUQ + (size_t)1536 * 384 * 2);
constexpr size_t OFF_WLRU = al(OFF_WUKV + (size_t)2048 * 256 * 2);
constexpr size_t OFF_WBRA = al(OFF_WLRU + (size_t)4096 * 128 * 2);
constexpr size_t OFF_WBRB = al(OFF_WBRA + (size_t)1024 * 1024 * 2);
constexpr size_t OFF_WBRC = al(OFF_WBRB + (size_t)1024 * 1024 * 2);
constexpr size_t OFF_WOUT = al(OFF_WBRC + (size_t)1024 * 1024 * 2);
constexpr size_t OFF_WFI = al(OFF_WOUT + (size_t)1024 * 1024 * 2);
constexpr size_t OFF_WFO = al(OFF_WFI + (size_t)5632 * 1024 * 2);
constexpr size_t OFF_HBF = al(OFF_WFO + (size_t)1024 * FH * 2);
constexpr size_t SZ1K = (size_t)MH * 1024 * 2;
constexpr size_t OFF_RX = al(OFF_HBF + SZ1K);
constexpr size_t OFF_GRG = al(OFF_RX + SZ1K);
constexpr size_t OFF_CQKV = al(OFF_GRG + SZ1K);
constexpr size_t OFF_DQ = al(OFF_CQKV + (size_t)MH * 768 * 2);
constexpr size_t OFF_DK = al(OFF_DQ + SZ1K);
constexpr size_t OFF_DVT = al(OFF_DK + SZ1K);
constexpr size_t OFF_KM = al(OFF_DVT + SZ1K);
constexpr size_t OFF_VMT = al(OFF_KM + (size_t)MH * 1536 * 2);
constexpr size_t OFF_QM = al(OFF_VMT + SZ1K);
constexpr size_t OFF_OB = al(OFF_QM + (size_t)MH * 1536 * 2);
constexpr size_t OFF_XCV = al(OFF_OB + SZ1K);
constexpr size_t WS_NEED = al(OFF_XCV + SZ1K);
static_assert(OFF_DK == OFF_DQ + SZ1K && OFF_DVT == OFF_DK + SZ1K, "HH alias needs contiguous DQ/DK/DVT");
static_assert((size_t)MH * FH * 2 <= 3 * SZ1K, "HH alias size");

constexpr int LDS_BYTES = 73728 + 1024 + 3072 + 32;
constexpr int LDS_BAR = 73728 + 1024 + 3072;
constexpr int LDS_RS = 73728, LDS_SEG = 73728 + 1024;

struct Params {
  const float *x, *c, *ctx, *c_ctx, *w_mod, *b_mod, *norm1_g, *norm2_g, *w_in, *conv_w, *conv_b, *lru_wa, *lru_ba, *lru_wi, *lru_bi,
      *lru_lambda, *mla_qn_g, *mla_w_uq, *mla_kvn_g, *mla_w_ukv, *mla_q_g, *mla_k_g, *diff_q_g, *diff_k_g, *diff_lambda, *diff_subln_g,
      *w_br_a, *w_br_b, *w_br_c, *w_out, *w_ffn_in, *w_ffn_out;
  float* out;
  char* ws;
};

DI int tidx() { int t = __builtin_amdgcn_workitem_id_x(); asm volatile("" : "+v"(t)); return t; }
DI float bf2f(unsigned short u) { return __uint_as_float(((unsigned)u) << 16); }
DI unsigned short f2bf(float x) { unsigned u = __float_as_uint(x); u += 0x7fffu + ((u >> 16) & 1u); return (unsigned short)(u >> 16); }
typedef __bf16 bf16n2 __attribute__((ext_vector_type(2)));
typedef float f32x2n __attribute__((ext_vector_type(2)));
DI unsigned pack2(float lo, float hi) { const f32x2n v = {lo, hi}; return __builtin_bit_cast(unsigned, __builtin_convertvector(v, bf16n2)); }
DI float lo2f(unsigned u) { return __uint_as_float(u << 16); }
DI float hi2f(unsigned u) { return __uint_as_float(u & 0xffff0000u); }
DI float sigmoidf_(float x) { return 1.0f / (1.0f + __expf(-x)); }
DI float siluf_(float x) { return x * sigmoidf_(x); }
DI float geluf_(float x) { const float u = 0.7978845608028654f * (x + 0.044715f * x * x * x); return 0.5f * x * (1.0f + tanhf(u)); }
DI int perm16(int o) { return (o & 3) | ((o & 4) << 1) | ((o & 8) >> 1); }
DI int keypos(int kk) { return (kk & ~15) | perm16(kk & 15); }
struct RowInfo { int bl, t, isctx; };
DI RowInfo rowinfo(int lr) { RowInfo r; if (lr < ML) { r.bl = lr >> 11; r.t = lr & 2047; r.isctx = 0; } else { const int q = lr - ML; r.bl = q >> 8; r.t = q & 255; r.isctx = 1; } return r; }
DI float* resid_ptr(const Params& P, int half, int lr) {
  return lr < ML ? P.out + ((size_t)half * ML + lr) * D : (float*)(P.ws + OFF_XC) + ((size_t)half * MC + (lr - ML)) * D;
}
DI const float* input_ptr(const Params& P, int half, int lr) {
  return lr < ML ? P.x + ((size_t)half * ML + lr) * D : P.ctx + ((size_t)half * MC + (lr - ML)) * D;
}
DI float lam_init_of(int l) { return l == 0 ? 0.2f : 0.35550906f; }

typedef __attribute__((address_space(3))) unsigned lds_u32_t;
#define GLDS16(gsrc, ldst) __builtin_amdgcn_global_load_lds((const unsigned*)(gsrc), (lds_u32_t*)(ldst), 16, 0, 0)
DI void gemm_core_ring2(f32x4 (&acc)[4][2], const bf16_t* __restrict__ A, int lda, const bf16_t* __restrict__ W, int ldw, int K, char* lds) {
  constexpr int NT = 2, STAGE = 24576;
  const int tid = tidx(), lane = tid & 63, wid = tid >> 6, wr = wid >> 1, wc = wid & 1, fr = lane & 15, fq = lane >> 4;
  const int crow = tid >> 3, csrc = (tid & 7) ^ ((crow >> 1) & 7);
  const int nk = K >> 6;
  const bf16_t* ap = A + (size_t)crow * lda + csrc * 8;
  const bf16_t* wp = W + (size_t)crow * ldw + csrc * 8;
  const int sw = (fr >> 1) & 7;
  const int wbase = __builtin_amdgcn_readfirstlane(wid) * 1024;
#define RING_STAGE(KT, BUF) do { char* a_ = lds + (BUF) * STAGE + wbase; char* w_ = a_ + 16384; \
    _Pragma("unroll") for (int i = 0; i < 4; ++i) GLDS16(ap + (size_t)(32 * i) * lda + (KT) * 64, a_ + i * 4096); \
    _Pragma("unroll") for (int i = 0; i < NT; ++i) GLDS16(wp + (size_t)(32 * i) * ldw + (KT) * 64, w_ + i * 4096); } while (0)
  RING_STAGE(0, 0); RING_STAGE(1, 1);
  int buf = 0, nbuf = 2;
  for (int j = 0; j < nk; ++j) {
    if (j + 1 < nk) asm volatile("s_waitcnt vmcnt(6)" ::: "memory"); else asm volatile("s_waitcnt vmcnt(0)" ::: "memory");
    asm volatile("s_waitcnt lgkmcnt(0)" ::: "memory");
    __builtin_amdgcn_s_barrier();
    asm volatile("" ::: "memory");
    if (j + 2 < nk) RING_STAGE(j + 2, nbuf);
    {
      const char* a = lds + buf * STAGE; const char* w = a + 16384;
      bf16x8 bf0[4], af0[NT], bf1[4], af1[NT];
      { const int co = ((0 * 4 + fq) ^ sw) * 16;
#pragma unroll
        for (int mi = 0; mi < 4; ++mi) bf0[mi] = *(const bf16x8*)(a + (wr * 64 + mi * 16 + fr) * 128 + co);
#pragma unroll
        for (int ni = 0; ni < NT; ++ni) af0[ni] = *(const bf16x8*)(w + (wc * NT * 16 + ni * 16 + fr) * 128 + co); }
      { const int co = ((1 * 4 + fq) ^ sw) * 16;
#pragma unroll
        for (int mi = 0; mi < 4; ++mi) bf1[mi] = *(const bf16x8*)(a + (wr * 64 + mi * 16 + fr) * 128 + co);
#pragma unroll
        for (int ni = 0; ni < NT; ++ni) af1[ni] = *(const bf16x8*)(w + (wc * NT * 16 + ni * 16 + fr) * 128 + co); }
#pragma unroll
      for (int mi = 0; mi < 4; ++mi)
#pragma unroll
        for (int ni = 0; ni < NT; ++ni) acc[mi][ni] = __builtin_amdgcn_mfma_f32_16x16x32_bf16(af0[ni], bf0[mi], acc[mi][ni], 0, 0, 0);
#pragma unroll
      for (int mi = 0; mi < 4; ++mi)
#pragma unroll
        for (int ni = 0; ni < NT; ++ni) acc[mi][ni] = __builtin_amdgcn_mfma_f32_16x16x32_bf16(af1[ni], bf1[mi], acc[mi][ni], 0, 0, 0);
    }
    buf = (buf == 2) ? 0 : buf + 1; nbuf = (nbuf == 2) ? 0 : nbuf + 1;
  }
  __syncthreads();
#undef RING_STAGE
}
template <int NT>
DI void gemm_core(f32x4 (&acc)[4][NT], const bf16_t* __restrict__ A, int lda, const bf16_t* __restrict__ W, int ldw, int K, char* lds) {
  if constexpr (NT == 2) { gemm_core_ring2(acc, A, lda, W, ldw, K, lds); return; }
  constexpr int STAGE = 32768;
  const int tid = tidx(), lane = tid & 63, wid = tid >> 6, wr = wid >> 1, wc = wid & 1, fr = lane & 15, fq = lane >> 4;
  const int crow = tid >> 3, csrc = (tid & 7) ^ ((crow >> 1) & 7);
  const int nk = K >> 6;
  const bf16_t* ap = A + (size_t)crow * lda + csrc * 8;
  const bf16_t* wp = W + (size_t)crow * ldw + csrc * 8;
  const int sw = (fr >> 1) & 7;
  const int wbase = __builtin_amdgcn_readfirstlane(wid) * 1024;
#define GEMM_STAGE(KT, BUF) do { char* a_ = lds + (BUF) * STAGE + wbase; char* w_ = a_ + 16384; \
    _Pragma("unroll") for (int i = 0; i < 4; ++i) GLDS16(ap + (size_t)(32 * i) * lda + (KT) * 64, a_ + i * 4096); \
    _Pragma("unroll") for (int i = 0; i < NT; ++i) GLDS16(wp + (size_t)(32 * i) * ldw + (KT) * 64, w_ + i * 4096); } while (0)
#define GEMM_LDFR(BUF, KS, BF, AF) do { const char* a = lds + (BUF) * STAGE; const char* w = a + 16384; const int co = (((KS) * 4 + fq) ^ sw) * 16; \
      _Pragma("unroll") for (int mi = 0; mi < 4; ++mi) BF[mi] = *(const bf16x8*)(a + (wr * 64 + mi * 16 + fr) * 128 + co); \
      _Pragma("unroll") for (int ni = 0; ni < NT; ++ni) AF[ni] = *(const bf16x8*)(w + (wc * NT * 16 + ni * 16 + fr) * 128 + co); } while (0)
#define GEMM_MMA(BF, AF) do { \
      _Pragma("unroll") for (int mi = 0; mi < 4; ++mi) \
        _Pragma("unroll") for (int ni = 0; ni < NT; ++ni) acc[mi][ni] = __builtin_amdgcn_mfma_f32_16x16x32_bf16(AF[ni], BF[mi], acc[mi][ni], 0, 0, 0); } while (0)
#define GEMM_COMPUTE(BUF) do { bf16x8 bf0[4], af0[NT], bf1[4], af1[NT]; \
    GEMM_LDFR(BUF, 0, bf0, af0); \
    __builtin_amdgcn_sched_barrier(0); \
    GEMM_LDFR(BUF, 1, bf1, af1); \
    GEMM_MMA(bf0, af0); \
    __builtin_amdgcn_sched_barrier(0); \
    GEMM_MMA(bf1, af1); } while (0)
  GEMM_STAGE(0, 0);
  __syncthreads();
  for (int kt = 0; kt + 1 < nk; ++kt) {
    GEMM_STAGE(kt + 1, (kt + 1) & 1);
    GEMM_COMPUTE(kt & 1);
    __syncthreads();
  }
  GEMM_COMPUTE((nk - 1) & 1);
  __syncthreads();
#undef GEMM_COMPUTE
#undef GEMM_MMA
#undef GEMM_LDFR
#undef GEMM_STAGE
}
template <int NT> DI void zero_acc(f32x4 (&acc)[4][NT]) {
#pragma unroll
  for (int mi = 0; mi < 4; ++mi)
#pragma unroll
    for (int ni = 0; ni < NT; ++ni) acc[mi][ni] = (f32x4){0.f, 0.f, 0.f, 0.f};
}
DI float ssq8(uint4 v) { const float a = lo2f(v.x), b = hi2f(v.x), c = lo2f(v.y), d = hi2f(v.y), e = lo2f(v.z), f = hi2f(v.z), g = lo2f(v.w), h = hi2f(v.w); return a * a + b * b + c * c + d * d + e * e + f * f + g * g + h * h; }
DI void store4bf(bf16_t* p, f32x4 v) { uint2 w; w.x = pack2(v[0], v[1]); w.y = pack2(v[2], v[3]); *(uint2*)p = w; }

template <int K>
DI void row_rstd_table(const bf16_t* A, int lda, char* lds) {
  const int tid = tidx(), row = tid >> 1, hf = tid & 1;
  const bf16_t* p = A + (size_t)row * lda + hf * (K >> 1);
  float ss = 0.f;
#pragma unroll
  for (int i0 = 0; i0 < (K >> 4); i0 += 8) {
    uint4 v[8];
#pragma unroll
    for (int i = 0; i < 8; ++i) v[i] = *(const uint4*)(p + (i0 + i) * 8);
#pragma unroll
    for (int i = 0; i < 8; ++i) ss += ssq8(v[i]);
  }
  ss += __shfl_xor(ss, 1);
  if (hf == 0) ((float*)(lds + LDS_RS))[row] = rsqrtf(ss / (float)K + EPS);
}

DI void phase0(const Params& P, char* lds) {
  const int tid = tidx(), lane = tid & 63, wid = tid >> 6;
  float* sil = (float*)lds;
  float* part = (float*)(lds + 9 * 1024 * 4);
  float* MOD = (float*)(P.ws + OFF_MOD);
  for (int u = blockIdx.x; u < 192 + 384 + 1; u += gridDim.x) {
    if (u < 192) {
      const int l = u / 96, cg_ = u % 96;
      __syncthreads();
      for (int i = tid; i < 9 * 1024; i += 256) { const int r = i >> 10, k = i & 1023; const float v = r < 8 ? P.c[r * 1024 + k] : P.c_ctx[k]; sil[i] = siluf_(v); }
      __syncthreads();
      float acc[9];
#pragma unroll
      for (int r = 0; r < 9; ++r) acc[r] = 0.f;
      const float* wm = P.w_mod + (size_t)l * 1024 * 6144 + cg_ * 64 + lane;
      for (int k = wid * 256; k < wid * 256 + 256; k += 8) {
        float w[8];
#pragma unroll
        for (int e = 0; e < 8; ++e) w[e] = wm[(size_t)(k + e) * 6144];
#pragma unroll
        for (int e = 0; e < 8; ++e)
#pragma unroll
          for (int r = 0; r < 9; ++r) acc[r] += sil[r * 1024 + k + e] * w[e];
      }
#pragma unroll
      for (int r = 0; r < 9; ++r) part[(wid * 9 + r) * 64 + lane] = acc[r];
      __syncthreads();
      for (int i = tid; i < 9 * 64; i += 256) {
        const int r = i >> 6, cc = i & 63;
        const float s = part[(0 * 9 + r) * 64 + cc] + part[(1 * 9 + r) * 64 + cc] + part[(2 * 9 + r) * 64 + cc] + part[(3 * 9 + r) * 64 + cc];
        MOD[((size_t)l * 9 + r) * 6144 + cg_ * 64 + cc] = s + P.b_mod[l * 6144 + cg_ * 64 + cc];
      }
    } else if (u < 192 + 384) {
      const int i = (u - 192) * 256 + tid;
      const int t = i / 48, e = i % 48;
      const float rowid = (float)(t >> 6), colid = (float)(t & 63);
      if (e < 16) {
        const int fi = e & 7; const float fr_ = powf(10000.0f, -(float)fi / 8.0f);
        const float ang = (e < 8 ? rowid : colid) * fr_;
        ((float*)(P.ws + OFF_RM))[t * 16 + e] = cosf(ang);
        ((float*)(P.ws + OFF_RM))[2048 * 16 + t * 16 + e] = sinf(ang);
      } else {
        const int e2 = e - 16, fi = e2 & 15; const float fr_ = powf(10000.0f, -(float)fi / 16.0f);
        const float ang = (e2 < 16 ? rowid : colid) * fr_;
        ((float*)(P.ws + OFF_RD))[t * 32 + e2] = cosf(ang);
        ((float*)(P.ws + OFF_RD))[2048 * 32 + t * 32 + e2] = sinf(ang);
      }
    } else {
      if (tid < 2) {
        const float* dl = P.diff_lambda + tid * 256;
        float s1 = 0.f, s2 = 0.f;
        for (int i = 0; i < 64; ++i) { s1 += dl[i] * dl[64 + i]; s2 += dl[128 + i] * dl[192 + i]; }
        ((float*)(P.ws + OFF_LAM))[tid] = expf(s1) - expf(s2) + lam_init_of(tid);
      }
    }
  }
}

constexpr int CT_WIN = (N1 / 64) * 16, CT_WMG = CT_WIN + 48 * 16, CT_WUQ = CT_WMG + 24 * 6, CT_WUKV = CT_WUQ + 32 * 4, CT_WLRU = CT_WUKV + 64 * 2,
              CT_WBR = CT_WLRU + 4 * 16 * 16, CT_WFI = CT_WBR + 88 * 16, CT_WFO = CT_WFI + 16 * 44;
DI void convert_weights(const Params& P, int l, char* lds) {
  const int tid = tidx();
  bf16_t* tl = (bf16_t*)lds;
  for (int t = blockIdx.x; t < CT_WFO; t += gridDim.x) {
    int m, lt, NTl, K; bf16_t* dst; const float* sbase; int sstride; const float* kscale = nullptr;
    if (t < CT_WIN) { m = 0; lt = t; NTl = N1 / 64; K = 1024; dst = (bf16_t*)(P.ws + OFF_WIN); sbase = P.w_in + (size_t)l * 1024 * INC; sstride = INC; }
    else if (t < CT_WMG) { m = 1; lt = t - CT_WIN; NTl = 48; K = 1024; dst = (bf16_t*)(P.ws + OFF_WMG); sbase = P.w_in + (size_t)l * 1024 * INC; sstride = INC; }
    else if (t < CT_WUQ) { m = 2; lt = t - CT_WMG; NTl = 24; K = 384; dst = (bf16_t*)(P.ws + OFF_WUQ); sbase = P.mla_w_uq + (size_t)l * 384 * 1536; sstride = 1536; kscale = P.mla_qn_g + l * 384; }
    else if (t < CT_WUKV) { m = 3; lt = t - CT_WUQ; NTl = 32; K = 256; dst = (bf16_t*)(P.ws + OFF_WUKV); sbase = P.mla_w_ukv + (size_t)l * 256 * 2048; sstride = 2048; kscale = P.mla_kvn_g + l * 256; }
    else if (t < CT_WLRU) { m = 4; lt = t - CT_WUKV; NTl = 64; K = 128; dst = (bf16_t*)(P.ws + OFF_WLRU); sbase = nullptr; sstride = 128; }
    else if (t < CT_WBR) { const int q = t - CT_WLRU; const int mm = q >> 8; m = 5; lt = q & 255; NTl = 16; K = 1024; dst = (bf16_t*)(P.ws + OFF_WBRA + (size_t)mm * (OFF_WBRB - OFF_WBRA));
      sbase = (mm == 0 ? P.w_br_a : mm == 1 ? P.w_br_b : mm == 2 ? P.w_br_c : P.w_out) + (size_t)l * 1024 * 1024; sstride = 1024; }
    else if (t < CT_WFI) { m = 6; lt = t - CT_WBR; NTl = 88; K = 1024; dst = (bf16_t*)(P.ws + OFF_WFI); sbase = P.w_ffn_in + (size_t)l * 1024 * 5632; sstride = 5632; }
    else { m = 7; lt = t - CT_WFI; NTl = 16; K = FH; dst = (bf16_t*)(P.ws + OFF_WFO); sbase = P.w_ffn_out + (size_t)l * FH * 1024; sstride = 1024; }
    const int tn = lt % NTl, tk = lt / NTl;
    const int n = tn * 64 + (tid & 15) * 4;
    int sc = n; const float* sb = sbase;
    if (m == 0) { if (n < 2048) sc = n; else if (n < 2816) { const int j = n - 2048; sc = j < 672 ? 2048 + j : -1; } else sc = 2720 + (n - 2816); }
    else if (m == 1) sc = 5792 + n;
    else if (m == 4) { const int blk = n >> 9, r = (n >> 8) & 1, q4 = (n >> 6) & 3, g32 = (n >> 5) & 1, gate = (n >> 4) & 1, cc = n & 15;
      sb = (gate ? P.lru_wi : P.lru_wa) + (((size_t)l * 2 + r) * 8 + blk) * 128 * 128; sc = q4 * 32 + g32 * 16 + cc; }
    else if (m == 6) { const int tn2 = n >> 7, c16 = (n >> 5) & 3, gate = (n >> 4) & 1, cc = n & 15; sc = gate * FH + tn2 * 64 + c16 * 16 + cc; }
    __syncthreads();
#pragma unroll
    for (int p = 0; p < 4; ++p) {
      const int kl = (tid >> 4) + 16 * p, k = tk * 64 + kl;
      f32x4 v = {0.f, 0.f, 0.f, 0.f};
      if (sc >= 0) v = *(const f32x4*)(sb + (size_t)k * sstride + sc);
      if (kscale) v = v * kscale[k];
      const int nl = (tid & 15) * 4;
      tl[(nl + 0) * 72 + kl] = f2bf(v[0]); tl[(nl + 1) * 72 + kl] = f2bf(v[1]); tl[(nl + 2) * 72 + kl] = f2bf(v[2]); tl[(nl + 3) * 72 + kl] = f2bf(v[3]);
    }
    __syncthreads();
    {
      const int nl = tid >> 2, kc = (tid & 3) * 16;
      const uint4 a = *(const uint4*)(tl + nl * 72 + kc), b2 = *(const uint4*)(tl + nl * 72 + kc + 8);
      bf16_t* d = dst + (size_t)(tn * 64 + nl) * K + tk * 64 + kc;
      *(uint4*)d = a; *(uint4*)(d + 8) = b2;
    }
  }
}
static_assert(OFF_WBRC - OFF_WBRB == OFF_WBRB - OFF_WBRA && OFF_WOUT - OFF_WBRC == OFF_WBRB - OFF_WBRA, "br weights equally spaced");

DI void norm_phase(const Params& P, int l, int half_, int which  , int nrows, int rph = 0  ) {
  const int lane = tidx() & 63, wid = tidx() >> 6;
  const float* g = (which == 0 ? P.norm1_g : P.norm2_g) + l * 1024;
  const float* MOD = (const float*)(P.ws + OFF_MOD) + (size_t)l * 9 * 6144;
  bf16_t* H = (bf16_t*)(P.ws + OFF_HBF);
  for (int grow = blockIdx.x * 4 + wid; grow < nrows; grow += gridDim.x * 4) {
    const int half = rph ? grow / rph : half_, row = rph ? grow % rph : grow;
    const RowInfo ri = rowinfo(row);
    const float* src = (which == 0 && l == 0) ? input_ptr(P, half, row) : resid_ptr(P, half, row);
    const float* md = MOD + (size_t)(ri.isctx ? 8 : half * HB + ri.bl) * 6144 + (which == 0 ? 0 : 3072);
    f32x4 v[4]; float ss = 0.f;
#pragma unroll
    for (int i = 0; i < 4; ++i) { v[i] = *(const f32x4*)(src + i * 256 + lane * 4); ss += v[i][0] * v[i][0] + v[i][1] * v[i][1] + v[i][2] * v[i][2] + v[i][3] * v[i][3]; }
#pragma unroll
    for (int o = 1; o < 64; o <<= 1) ss += __shfl_xor(ss, o);
    const float rstd = rsqrtf(ss * (1.0f / 1024.0f) + EPS);
#pragma unroll
    for (int i = 0; i < 4; ++i) {
      const int c0 = i * 256 + lane * 4;
      const f32x4 gg = *(const f32x4*)(g + c0), sh = *(const f32x4*)(md + c0), sc = *(const f32x4*)(md + 1024 + c0);
      f32x4 o;
#pragma unroll
      for (int j = 0; j < 4; ++j) o[j] = v[i][j] * rstd * gg[j] * (1.0f + sc[j]) + sh[j];
      store4bf(H + (size_t)grow * 1024 + c0, o);
    }
  }
}

DI void g1_phase(const Params& P, int l, int half, char* lds) {
  const int tid = tidx(), lane = tid & 63, wid = tid >> 6, wr = wid >> 1, wc = wid & 1, fr = lane & 15, fq = lane >> 4;
  const bf16_t* H = (const bf16_t*)(P.ws + OFF_HBF);
  const bf16_t* W = (const bf16_t*)(P.ws + OFF_WIN);
  const float* RDc = (const float*)(P.ws + OFF_RD); const float* RDs = RDc + 2048 * 32;
  constexpr int MT = MH / 128, NTL = N1 / 128;
  for (int u = blockIdx.x; u < MT * NTL; u += gridDim.x) {
    const int tn = u / MT, tm = u % MT;
    f32x4 acc[4][4]; zero_acc<4>(acc);
    gemm_core<4>(acc, H + (size_t)tm * 128 * 1024, 1024, W + (size_t)tn * 128 * 1024, 1024, 1024, lds);
    const int rowb = tm * 128 + wr * 64 + fr;
    if (tn < 8) {
      bf16_t* O = (bf16_t*)(P.ws + OFF_RX);
#pragma unroll
      for (int mi = 0; mi < 4; ++mi)
#pragma unroll
        for (int ni = 0; ni < 4; ++ni) store4bf(O + (size_t)(rowb + mi * 16) * 1024 + tn * 128 + wc * 64 + ni * 16 + fq * 4, acc[mi][ni]);
    } else if (tn < 16) {
      bf16_t* O = (bf16_t*)(P.ws + OFF_GRG);
#pragma unroll
      for (int mi = 0; mi < 4; ++mi)
#pragma unroll
        for (int ni = 0; ni < 4; ++ni) { f32x4 v = acc[mi][ni];
#pragma unroll
          for (int j = 0; j < 4; ++j) v[j] = geluf_(v[j]);
          store4bf(O + (size_t)(rowb + mi * 16) * 1024 + (tn - 8) * 128 + wc * 64 + ni * 16 + fq * 4, v); }
    } else if (tn < 22) {
      bf16_t* O = (bf16_t*)(P.ws + OFF_CQKV);
#pragma unroll
      for (int mi = 0; mi < 4; ++mi)
#pragma unroll
        for (int ni = 0; ni < 4; ++ni) store4bf(O + (size_t)(rowb + mi * 16) * 768 + (tn - 16) * 128 + wc * 64 + ni * 16 + fq * 4, acc[mi][ni]);
    } else if (tn < 38) {
      const int isk = tn >= 30; const int tl = isk ? tn - 30 : tn - 22;
      bf16_t* O = (bf16_t*)(P.ws + (isk ? OFF_DK : OFF_DQ));
      const float* g = (isk ? P.diff_k_g : P.diff_q_g) + l * 64;
#pragma unroll
      for (int mi = 0; mi < 4; ++mi) {
        const int row = rowb + mi * 16; const RowInfo ri = rowinfo(row);
        float ss = 0.f;
#pragma unroll
        for (int ni = 0; ni < 4; ++ni)
#pragma unroll
          for (int j = 0; j < 4; ++j) ss += acc[mi][ni][j] * acc[mi][ni][j];
        ss += __shfl_xor(ss, 16); ss += __shfl_xor(ss, 32);
        const float rstd = rsqrtf(ss * (1.0f / 64.0f) + EPS);
#pragma unroll
        for (int ni = 0; ni < 4; ++ni) {
          const int d0 = ni * 16 + fq * 4;
          const f32x4 gg = *(const f32x4*)(g + d0);
          f32x4 y;
#pragma unroll
          for (int j = 0; j < 4; ++j) y[j] = acc[mi][ni][j] * rstd * gg[j];
          if (!ri.isctx) {
            const int pi = d0 >> 1;
            const float c0 = RDc[ri.t * 32 + pi], s0 = RDs[ri.t * 32 + pi], c1 = RDc[ri.t * 32 + pi + 1], s1 = RDs[ri.t * 32 + pi + 1];
            const float a0 = y[0] * c0 - y[1] * s0, a1 = y[0] * s0 + y[1] * c0, a2 = y[2] * c1 - y[3] * s1, a3 = y[2] * s1 + y[3] * c1;
            y = (f32x4){a0, a1, a2, a3};
          }
          store4bf(O + (size_t)row * 1024 + tl * 128 + wc * 64 + d0, y);
        }
      }
    } else {
      bf16_t* O = (bf16_t*)(P.ws + OFF_DVT);
      const int h = tn - 38;
#pragma unroll
      for (int mi = 0; mi < 4; ++mi) {
        const int row = rowb + mi * 16; const RowInfo ri = rowinfo(row);
        const int pos = keypos(ri.isctx ? 2048 + ri.t : ri.t);
        bf16_t* ob = O + ((size_t)(ri.bl * 8 + h) * 128) * NKEY + pos;
#pragma unroll
        for (int ni = 0; ni < 4; ++ni)
#pragma unroll
          for (int j = 0; j < 4; ++j) ob[(size_t)(wc * 64 + ni * 16 + fq * 4 + j) * NKEY] = f2bf(acc[mi][ni][j]);
      }
    }
  }
}

template <int CTRL> DI float dppf(float old, float v) { return __int_as_float(__builtin_amdgcn_update_dpp(__float_as_int(old), __float_as_int(v), CTRL, 0xf, 0xf, false)); }
template <int R> DI void row_scan(float& a, float& b) {
  constexpr int B0 = R == 0 ? 0x110 : 0x100;
  { const float ap = dppf<B0 + 1>(1.0f, a), bp = dppf<B0 + 1>(0.0f, b); b = a * bp + b; a = a * ap; }
  { const float ap = dppf<B0 + 2>(1.0f, a), bp = dppf<B0 + 2>(0.0f, b); b = a * bp + b; a = a * ap; }
  { const float ap = dppf<B0 + 4>(1.0f, a), bp = dppf<B0 + 4>(0.0f, b); b = a * bp + b; a = a * ap; }
  { const float ap = dppf<B0 + 8>(1.0f, a), bp = dppf<B0 + 8>(0.0f, b); b = a * bp + b; a = a * ap; }
}
DI void conv_items(const Params& P, int l, int item0, int nitems) {
  const bf16_t* RX = (const bf16_t*)(P.ws + OFF_RX);
  bf16_t* XV = (bf16_t*)(P.ws + OFF_XCV);
  const int it = item0 + tidx();
  if (it >= nitems) return;
  const int row = it >> 7, ch = (it & 127) * 8;
  const RowInfo ri = rowinfo(row); const int Tseq = ri.isctx ? 256 : 2048;
  uint4 tv[4];
#pragma unroll
  for (int j = 0; j < 4; ++j) { const int tt = ri.t + j - 2; const bool ok = tt >= 0 && tt < Tseq; tv[j] = *(const uint4*)(RX + (size_t)(row + (ok ? j - 2 : 0)) * 1024 + ch); }
  float a8[8];
#pragma unroll
  for (int e = 0; e < 8; ++e) a8[e] = P.conv_b[l * 1024 + ch + e];
#pragma unroll
  for (int j = 0; j < 4; ++j) {
    const int tt = ri.t + j - 2; const float msk = (tt >= 0 && tt < Tseq) ? 1.0f : 0.0f;
    const float* cw = P.conv_w + ((size_t)l * 4 + j) * 1024 + ch;
    const unsigned w[4] = {tv[j].x, tv[j].y, tv[j].z, tv[j].w};
#pragma unroll
    for (int e = 0; e < 4; ++e) { a8[2 * e] += lo2f(w[e]) * (cw[2 * e] * msk); a8[2 * e + 1] += hi2f(w[e]) * (cw[2 * e + 1] * msk); }
  }
  uint4 o; o.x = pack2(a8[0], a8[1]); o.y = pack2(a8[2], a8[3]); o.z = pack2(a8[4], a8[5]); o.w = pack2(a8[6], a8[7]);
  *(uint4*)(XV + (size_t)row * 1024 + ch) = o;
}

template <int R>
DI void lru_seq_step(const Params& P, int l, int row0, int blk, int q4, bool need_out, float (&hcar)[4], const char* As, const char* Wsb, char* lds, int next_row0, bool has_next) {
  const int tid = tidx(), lane = tid & 63, wid = tid >> 6, wr = wid >> 1, wc = wid & 1, fr = lane & 15, fq = lane >> 4;
  float2* XW = (float2*)(lds + LDS_SEG);
  const int chq = wc * 16 + fq * 4, chg = blk * 128 + q4 * 32 + chq;
  bf16_t* TMP = (bf16_t*)(P.ws + OFF_RX);
  bf16_t* GRG = (bf16_t*)(P.ws + OFF_GRG);
  uint2 pf[4], pg[4];
  if (R == 1 && need_out) {
#pragma unroll
    for (int mi = 0; mi < 4; ++mi) { const size_t o = (size_t)(row0 + wr * 64 + mi * 16 + fr) * 1024 + chg; pf[mi] = *(const uint2*)(TMP + o); pg[mi] = *(const uint2*)(GRG + o); }
  }
  asm volatile("s_waitcnt vmcnt(0)" ::: "memory");
  __syncthreads();
  f32x4 acc[4][2]; zero_acc<2>(acc);
#pragma unroll
  for (int ks = 0; ks < 4; ++ks) {
    bf16x8 bfr[4], afr[2];
#pragma unroll
    for (int mi = 0; mi < 4; ++mi) bfr[mi] = *(const bf16x8*)(As + (wr * 64 + mi * 16 + fr) * 256 + (((ks * 4 + fq) ^ fr) * 16));
#pragma unroll
    for (int ni = 0; ni < 2; ++ni) afr[ni] = *(const bf16x8*)(Wsb + (wc * 32 + ni * 16 + fr) * 256 + (((ks * 4 + fq) ^ fr) * 16));
#pragma unroll
    for (int mi = 0; mi < 4; ++mi)
#pragma unroll
      for (int ni = 0; ni < 2; ++ni) acc[mi][ni] = __builtin_amdgcn_mfma_f32_16x16x32_bf16(afr[ni], bfr[mi], acc[mi][ni], 0, 0, 0);
  }
  float xcv[4][4];
#pragma unroll
  for (int mi = 0; mi < 4; ++mi) {
    const int tok = wr * 64 + mi * 16 + fr;
    const uint2 x2 = *(const uint2*)(As + tok * 256 + (((q4 * 4 + wc * 2 + (fq >> 1)) ^ fr) * 16) + (fq & 1) * 8);
    xcv[mi][0] = lo2f(x2.x); xcv[mi][1] = hi2f(x2.x); xcv[mi][2] = lo2f(x2.y); xcv[mi][3] = hi2f(x2.y);
  }
  float spl[4], bav[4], biv[4];
  {
    const f32x4* PRM = (const f32x4*)(lds + LDS_SEG + 1024);
#pragma unroll
    for (int j = 0; j < 4; ++j) { const f32x4 pv = PRM[R * 32 + chq + j]; spl[j] = pv[0]; bav[j] = pv[1]; biv[j] = pv[2]; }
  }
  asm volatile("s_waitcnt lgkmcnt(0)" ::: "memory");
  __syncthreads();
  if (has_next) {
    const bf16_t* XV = (const bf16_t*)(P.ws + OFF_XCV);
    const int wbase = __builtin_amdgcn_readfirstlane(wid) * 1024;
    const int xrow = tid >> 4, xsrc = (tid & 15) ^ (xrow & 15);
#pragma unroll
    for (int i = 0; i < 8; ++i) GLDS16(XV + (size_t)(next_row0 + xrow + 16 * i) * 1024 + blk * 128 + xsrc * 8, (char*)As + wbase + i * 4096);
  }
  float av[4][4], bv[4][4];
#pragma unroll
  for (int mi = 0; mi < 4; ++mi)
#pragma unroll
    for (int j = 0; j < 4; ++j) {
      const float sr = __builtin_amdgcn_rcpf(1.0f + __expf(-(acc[mi][0][j] + bav[j]))), si = __builtin_amdgcn_rcpf(1.0f + __expf(-(acc[mi][1][j] + biv[j])));
      const float la = -8.0f * sr * spl[j];
      const float a = __expf(la);
      av[mi][j] = a; bv[mi][j] = __builtin_amdgcn_sqrtf(fmaxf(0.f, 1.0f - a * a)) * si * xcv[mi][j];
    }
  const int endlane = (lane & ~15) | (R == 0 ? 15 : 0);
  float Ac[4][4], Bc[4][4], Aw[4], Bw[4];
#pragma unroll
  for (int j = 0; j < 4; ++j) { Aw[j] = 1.f; Bw[j] = 0.f; }
#pragma unroll
  for (int m = 0; m < 4; ++m) {
    const int mi = R == 0 ? m : 3 - m;
#pragma unroll
    for (int j = 0; j < 4; ++j) {
      row_scan<R>(av[mi][j], bv[mi][j]);
      const float At = __shfl(av[mi][j], endlane), Bt = __shfl(bv[mi][j], endlane);
      Ac[mi][j] = Aw[j]; Bc[mi][j] = Bw[j];
      Bw[j] = At * Bw[j] + Bt; Aw[j] = At * Aw[j];
    }
  }
  if (fr == 0) {
#pragma unroll
    for (int j = 0; j < 4; ++j) XW[wr * 32 + chq + j] = make_float2(Aw[j], Bw[j]);
  }
  asm volatile("s_waitcnt lgkmcnt(0)" ::: "memory");
  __builtin_amdgcn_s_barrier();
  asm volatile("" ::: "memory");
  const int first = R == 0 ? 0 : 1;
#pragma unroll
  for (int j = 0; j < 4; ++j) {
    const float2 e0 = XW[first * 32 + chq + j], e1 = XW[(1 - first) * 32 + chq + j];
    const float hw = (wr == first) ? hcar[j] : e0.x * hcar[j] + e0.y;
    float hout[4];
#pragma unroll
    for (int mi = 0; mi < 4; ++mi) { const float hb = Ac[mi][j] * hw + Bc[mi][j]; hout[mi] = av[mi][j] * hb + bv[mi][j]; }
#pragma unroll
    for (int mi = 0; mi < 4; ++mi) av[mi][j] = hout[mi];
    hcar[j] = e1.x * (e0.x * hcar[j] + e0.y) + e1.y;
  }
  if (need_out) {
#pragma unroll
    for (int mi = 0; mi < 4; ++mi) {
      const size_t o = (size_t)(row0 + wr * 64 + mi * 16 + fr) * 1024 + chg;
      if (R == 0) { store4bf(TMP + o, (f32x4){av[mi][0], av[mi][1], av[mi][2], av[mi][3]}); }
      else {
        const f32x4 y = {(av[mi][0] + lo2f(pf[mi].x)) * lo2f(pg[mi].x), (av[mi][1] + hi2f(pf[mi].x)) * hi2f(pg[mi].x),
                         (av[mi][2] + lo2f(pf[mi].y)) * lo2f(pg[mi].y), (av[mi][3] + hi2f(pf[mi].y)) * hi2f(pg[mi].y)};
        store4bf(GRG + o, y);
      }
    }
  }
}
DI void lru_seq_unit(const Params& P, int l, int u, char* lds) {
  const int tid = tidx(), wid = tid >> 6;
  const int bl = u >> 5, blk = (u >> 2) & 7, q4 = u & 3;
  const bf16_t* WL = (const bf16_t*)(P.ws + OFF_WLRU);
  const bf16_t* XV = (const bf16_t*)(P.ws + OFF_XCV);
  char* As = lds;
  char* Wb = lds + 32768;
  __syncthreads();
  const int wbase = __builtin_amdgcn_readfirstlane(wid) * 1024;
  {
    const int wrow = tid >> 4, wsrc = (tid & 15) ^ (wrow & 15);
#pragma unroll
    for (int r = 0; r < 2; ++r) {
      const bf16_t* ws_ = WL + (size_t)(blk * 512 + r * 256 + q4 * 64 + wrow) * 128 + wsrc * 8;
#pragma unroll
      for (int i = 0; i < 4; ++i) GLDS16(ws_ + (size_t)(16 * i) * 128, Wb + r * 16384 + wbase + i * 4096);
    }
    if (tid < 64) {
      const int r = tid >> 5, c = tid & 31, ch = blk * 128 + q4 * 32 + c;
      const float lm = P.lru_lambda[(l * 2 + r) * 1024 + ch];
      const float sp_ = (lm > 15.f) ? __expf(-lm) : log1pf(__expf(-lm));
      ((f32x4*)(lds + LDS_SEG + 1024))[tid] = (f32x4){sp_, P.lru_ba[(l * 2 + r) * 1024 + ch], P.lru_bi[(l * 2 + r) * 1024 + ch], 0.f};
    }
    const int xrow = tid >> 4, xsrc = (tid & 15) ^ (xrow & 15);
    const int r0 = ML + bl * 256;
#pragma unroll
    for (int i = 0; i < 8; ++i) GLDS16(XV + (size_t)(r0 + xrow + 16 * i) * 1024 + blk * 128 + xsrc * 8, As + wbase + i * 4096);
  }
  const bool ctx_out = (l == 0);
  float hcar[4] = {0.f, 0.f, 0.f, 0.f};
  for (int s = 0; s < 18; ++s) {
    const int row0 = s < 2 ? ML + bl * 256 + s * 128 : bl * 2048 + (s - 2) * 128;
    const int sn = s + 1;
    const int nrow0 = sn < 18 ? (sn < 2 ? ML + bl * 256 + sn * 128 : bl * 2048 + (sn - 2) * 128) : ML + bl * 256 + 128;
    lru_seq_step<0>(P, l, row0, blk, q4, s >= 2 || ctx_out, hcar, As, Wb, lds, nrow0, true);
  }
#pragma unroll
  for (int j = 0; j < 4; ++j) hcar[j] = 0.f;
  for (int s = 0; s < 18; ++s) {
    const int row0 = s < 2 ? ML + bl * 256 + (1 - s) * 128 : bl * 2048 + (15 - (s - 2)) * 128;
    const int sn = s + 1;
    const int nrow0 = sn < 2 ? ML + bl * 256 + (1 - sn) * 128 : bl * 2048 + (15 - (sn - 2)) * 128;
    lru_seq_step<1>(P, l, row0, blk, q4, s >= 2 || ctx_out, hcar, As, Wb + 16384, lds, nrow0, sn < 18);
  }
  asm volatile("s_waitcnt vmcnt(0)" ::: "memory");
  __syncthreads();
}

DI void pc_phase(const Params& P, int l, int half, char* lds) {
  const int tid = tidx(), lane = tid & 63, wid = tid >> 6, wr = wid >> 1, wc = wid & 1, fr = lane & 15, fq = lane >> 4;
  constexpr int MT = MH / 128;
  constexpr int NU_LRU = MH * 128 / 256, NU_UQ = MT * 12, NU_UKV = MT * 16;
  const bf16_t* CQKV = (const bf16_t*)(P.ws + OFF_CQKV);
  const float* rs = (const float*)(lds + LDS_RS);
  const float* RMc = (const float*)(P.ws + OFF_RM); const float* RMs = RMc + 2048 * 16;
  for (int u = blockIdx.x; u < NU_LRU + NU_UQ + NU_UKV; u += gridDim.x) {
    if (u < NU_LRU) { conv_items(P, l, u * 256, MH * 128); continue; }
    if (u < NU_LRU + NU_UQ) {
      const int v = u - NU_LRU, tn = v / MT, tm = v % MT;
      const bf16_t* A = CQKV + (size_t)tm * 128 * 768;
      __syncthreads();
      row_rstd_table<384>(A, 768, lds);
      f32x4 acc[4][4]; zero_acc<4>(acc);
      gemm_core<4>(acc, A, 768, (const bf16_t*)(P.ws + OFF_WUQ) + (size_t)tn * 128 * 384, 384, 384, lds);
      bf16_t* O = (bf16_t*)(P.ws + OFF_QM);
#pragma unroll
      for (int mi = 0; mi < 4; ++mi) {
        const int rl = wr * 64 + mi * 16 + fr; const float s = rs[rl];
#pragma unroll
        for (int ni = 0; ni < 4; ++ni) store4bf(O + (size_t)(tm * 128 + rl) * 1536 + tn * 128 + wc * 64 + ni * 16 + fq * 4, acc[mi][ni] * s);
      }
    } else {
      const int v = u - NU_LRU - NU_UQ, h = v / MT, tm = v % MT;
      const bf16_t* A = CQKV + (size_t)tm * 128 * 768 + 384;
      __syncthreads();
      row_rstd_table<256>(A, 768, lds);
      f32x4 acc[4][4]; zero_acc<4>(acc);
      gemm_core<4>(acc, A, 768, (const bf16_t*)(P.ws + OFF_WUKV) + (size_t)h * 128 * 256, 256, 256, lds);
      if (wc == 0) {
        bf16_t* O = (bf16_t*)(P.ws + OFF_KM);
        const float* kg = P.mla_k_g + l * 96;
#pragma unroll
        for (int mi = 0; mi < 4; ++mi) {
          const int rl = wr * 64 + mi * 16 + fr, row = tm * 128 + rl; const float s = rs[rl]; const RowInfo ri = rowinfo(row);
          const uint4 kr = *(const uint4*)(CQKV + (size_t)row * 768 + 640 + fq * 8);
          float k8[8] = {lo2f(kr.x), hi2f(kr.x), lo2f(kr.y), hi2f(kr.y), lo2f(kr.z), hi2f(kr.z), lo2f(kr.w), hi2f(kr.w)};
          float ss = 0.f;
#pragma unroll
          for (int e = 0; e < 8; ++e) ss += k8[e] * k8[e];
          f32x4 vv[4];
#pragma unroll
          for (int ni = 0; ni < 4; ++ni) { vv[ni] = acc[mi][ni] * s;
#pragma unroll
            for (int j = 0; j < 4; ++j) ss += vv[ni][j] * vv[ni][j]; }
          ss += __shfl_xor(ss, 16); ss += __shfl_xor(ss, 32);
          const float rstd = rsqrtf(ss * (1.0f / 96.0f) + EPS);
          bf16_t* orow = O + (size_t)row * 1536 + h * 96;
#pragma unroll
          for (int ni = 0; ni < 4; ++ni) { const int d0 = ni * 16 + fq * 4; const f32x4 gg = *(const f32x4*)(kg + d0); store4bf(orow + d0, vv[ni] * rstd * gg); }
#pragma unroll
          for (int e = 0; e < 8; ++e) k8[e] *= rstd * kg[64 + fq * 8 + e];
          if (!ri.isctx) {
#pragma unroll
            for (int e = 0; e < 4; ++e) {
              const int pi = fq * 4 + e; const float c = RMc[ri.t * 16 + pi], sn = RMs[ri.t * 16 + pi];
              const float x1 = k8[2 * e], x2 = k8[2 * e + 1]; k8[2 * e] = x1 * c - x2 * sn; k8[2 * e + 1] = x1 * sn + x2 * c;
            }
          }
          uint4 o; o.x = pack2(k8[0], k8[1]); o.y = pack2(k8[2], k8[3]); o.z = pack2(k8[4], k8[5]); o.w = pack2(k8[6], k8[7]);
          *(uint4*)(orow + 64 + fq * 8) = o;
        }
      } else {
        bf16_t* O = (bf16_t*)(P.ws + OFF_VMT);
#pragma unroll
        for (int mi = 0; mi < 4; ++mi) {
          const int rl = wr * 64 + mi * 16 + fr, row = tm * 128 + rl; const float s = rs[rl]; const RowInfo ri = rowinfo(row);
          const int pos = keypos(ri.isctx ? 2048 + ri.t : ri.t);
          bf16_t* ob = O + ((size_t)(ri.bl * 16 + h) * 64) * NKEY + pos;
#pragma unroll
          for (int ni = 0; ni < 4; ++ni)
#pragma unroll
            for (int j = 0; j < 4; ++j) ob[(size_t)(ni * 16 + fq * 4 + j) * NKEY] = f2bf(acc[mi][ni][j] * s);
        }
      }
    }
  }
}

struct QFrag { bf16x8 f0, f1, f2, f3, f4, f5; };
template <int KS> DI bf16x8 mla_qfrag(uint4 v, float rstd, const float* qg, int hh, int isctx, int t, const float* RMc, const float* RMs, float qscale) {
  float q[8] = {lo2f(v.x), hi2f(v.x), lo2f(v.y), hi2f(v.y), lo2f(v.z), hi2f(v.z), lo2f(v.w), hi2f(v.w)};
#pragma unroll
  for (int e = 0; e < 8; ++e) q[e] *= rstd * qg[KS * 16 + hh * 8 + e];
  if constexpr (KS >= 4) {
#pragma unroll
    for (int e = 0; e < 4; ++e) {
      const int pi = (KS - 4) * 8 + hh * 4 + e; const float c = isctx ? 1.0f : RMc[t * 16 + pi], sn = isctx ? 0.0f : RMs[t * 16 + pi];
      const float x1 = q[2 * e], x2 = q[2 * e + 1]; q[2 * e] = x1 * c - x2 * sn; q[2 * e + 1] = x1 * sn + x2 * c;
    }
  }
  uint4 w; w.x = pack2(q[0] * qscale, q[1] * qscale); w.y = pack2(q[2] * qscale, q[3] * qscale); w.z = pack2(q[4] * qscale, q[5] * qscale); w.w = pack2(q[6] * qscale, q[7] * qscale);
  return __builtin_bit_cast(bf16x8, w);
}
DI bf16x8 scale_qfrag(uint4 v, float qscale) {
  uint4 w; w.x = pack2(lo2f(v.x) * qscale, hi2f(v.x) * qscale); w.y = pack2(lo2f(v.y) * qscale, hi2f(v.y) * qscale);
  w.z = pack2(lo2f(v.z) * qscale, hi2f(v.z) * qscale); w.w = pack2(lo2f(v.w) * qscale, hi2f(v.w) * qscale);
  return __builtin_bit_cast(bf16x8, w);
}
template <int DK, int DV>
DI void attn_stream(f32x16 (&O)[DV / 32], float& lsum, const QFrag& qf, const bf16_t* __restrict__ Kb, int kstride, const bf16_t* __restrict__ Vt,
                    int bl, int kt0, int kt1, char* lds) {
  constexpr int KROW = (DK == 96) ? 256 : 128;
  constexpr int STG = 64 * KROW + DV * 128;
  const int tid = tidx(), lane = tid & 63, r = lane & 31, hh = lane >> 5;
  const int wbase = __builtin_amdgcn_readfirstlane(tid >> 6) * 1024;
  const int vrow = tid >> 3, vsrc = (tid & 7) ^ ((vrow >> 1) & 7);
  const int krow = (DK == 96) ? (tid >> 4) : (tid >> 3);
  const int ksrc = (DK == 96) ? ((tid & 15) ^ (krow & 15)) : ((tid & 7) ^ ((krow >> 1) & 7));
#define ATT_STAGE(KT, BUF) do { const int kt_ = (KT); const int keyrow0 = kt_ < 32 ? bl * 2048 + kt_ * 64 : ML + bl * 256 + (kt_ - 32) * 64; \
    char* kd_ = lds + (BUF) * STG + wbase; char* vd_ = kd_ + 64 * KROW; \
    if (DK == 96) { if (ksrc < 12) { _Pragma("unroll") for (int i = 0; i < 4; ++i) GLDS16(Kb + (size_t)(keyrow0 + krow + 16 * i) * kstride + ksrc * 8, kd_ + i * 4096); } } \
    else { _Pragma("unroll") for (int i = 0; i < 2; ++i) GLDS16(Kb + (size_t)(keyrow0 + krow + 32 * i) * kstride + ksrc * 8, kd_ + i * 4096); } \
    _Pragma("unroll") for (int i = 0; i < DV / 32; ++i) GLDS16(Vt + (size_t)(vrow + 32 * i) * NKEY + kt_ * 64 + vsrc * 8, vd_ + i * 4096); } while (0)
  float mrun = -1e30f; lsum = 0.f;
#pragma unroll
  for (int b = 0; b < DV / 32; ++b)
#pragma unroll
    for (int i = 0; i < 16; ++i) O[b][i] = 0.f;
  __syncthreads();
  ATT_STAGE(kt0, 0); ATT_STAGE(kt0 + 1, 1);
  int buf = 0, nbuf = 2;
  for (int kt = kt0; kt < kt1; ++kt) {
    if (kt + 1 < kt1) asm volatile("s_waitcnt vmcnt(6)" ::: "memory"); else asm volatile("s_waitcnt vmcnt(0)" ::: "memory");
    asm volatile("s_waitcnt lgkmcnt(0)" ::: "memory");
    __builtin_amdgcn_s_barrier();
    asm volatile("" ::: "memory");
    if (kt + 2 < kt1) ATT_STAGE(kt + 2, nbuf);
    const char* ks_ = lds + buf * STG; const char* vs_ = ks_ + 64 * KROW;
    f32x16 S[2];
    {
      const char* kp0 = ks_ + r * KROW; const char* kp1 = kp0 + 32 * KROW;
      const int ksw = (DK == 96) ? (r & 15) : ((r >> 1) & 7);
      constexpr int NKS = DK / 16;
      bf16x8 ka[NKS], kc[NKS];
#pragma unroll
      for (int i = 0; i < NKS; ++i) { const int co = ((i * 2 + hh) ^ ksw) * 16; ka[i] = *(const bf16x8*)(kp0 + co); kc[i] = *(const bf16x8*)(kp1 + co); }
      f32x16 zc;
#pragma unroll
      for (int i = 0; i < 16; ++i) zc[i] = 0.f;
      S[0] = __builtin_amdgcn_mfma_f32_32x32x16_bf16(ka[0], qf.f0, zc, 0, 0, 0);
      S[1] = __builtin_amdgcn_mfma_f32_32x32x16_bf16(kc[0], qf.f0, zc, 0, 0, 0);
#define QK_STEP(i) S[0] = __builtin_amdgcn_mfma_f32_32x32x16_bf16(ka[i], qf.f##i, S[0], 0, 0, 0); S[1] = __builtin_amdgcn_mfma_f32_32x32x16_bf16(kc[i], qf.f##i, S[1], 0, 0, 0)
      QK_STEP(1); QK_STEP(2); QK_STEP(3);
      if constexpr (DK == 96) { QK_STEP(4); QK_STEP(5); }
#undef QK_STEP
    }
    bf16x8 vpre[DV / 32][2];
#pragma unroll
    for (int b = 0; b < DV / 32; ++b)
#pragma unroll
      for (int s = 0; s < 2; ++s) vpre[b][s] = *(const bf16x8*)(vs_ + (b * 32 + r) * 128 + (((0 * 4 + s * 2 + hh) ^ ((r >> 1) & 7)) * 16));
    float mx = S[0][0];
#pragma unroll
    for (int kb = 0; kb < 2; ++kb)
#pragma unroll
      for (int i = 0; i < 16; ++i) mx = fmaxf(mx, S[kb][i]);
    { const auto sw_ = __builtin_amdgcn_permlane32_swap(__float_as_uint(mx), __float_as_uint(mx), false, false); mx = fmaxf(__uint_as_float(sw_[0]), __uint_as_float(sw_[1])); }
    const float mnew = fmaxf(mrun, mx);
    const float alpha = __builtin_amdgcn_exp2f(mrun - mnew);
    mrun = mnew;
    f32x2n psa = {0.f, 0.f}, psb = {0.f, 0.f};
    const f32x2n m2 = {mnew, mnew};
#pragma unroll
    for (int kb = 0; kb < 2; ++kb)
#pragma unroll
      for (int i = 0; i < 16; i += 4) {
        const f32x2n d0 = (f32x2n){S[kb][i], S[kb][i + 1]} - m2, d1 = (f32x2n){S[kb][i + 2], S[kb][i + 3]} - m2;
        const f32x2n e0 = {__builtin_amdgcn_exp2f(d0[0]), __builtin_amdgcn_exp2f(d0[1])}, e1 = {__builtin_amdgcn_exp2f(d1[0]), __builtin_amdgcn_exp2f(d1[1])};
        S[kb][i] = e0[0]; S[kb][i + 1] = e0[1]; S[kb][i + 2] = e1[0]; S[kb][i + 3] = e1[1];
        psa += e0; psb += e1;
      }
    lsum = lsum * alpha + ((psa[0] + psa[1]) + (psb[0] + psb[1]));
#pragma unroll
    for (int b = 0; b < DV / 32; ++b) O[b] = O[b] * alpha;
#pragma unroll
    for (int kb = 0; kb < 2; ++kb)
#pragma unroll
      for (int s = 0; s < 2; ++s) {
        uint4 pw; pw.x = pack2(S[kb][8 * s], S[kb][8 * s + 1]); pw.y = pack2(S[kb][8 * s + 2], S[kb][8 * s + 3]);
        pw.z = pack2(S[kb][8 * s + 4], S[kb][8 * s + 5]); pw.w = pack2(S[kb][8 * s + 6], S[kb][8 * s + 7]);
        const bf16x8 pf = __builtin_bit_cast(bf16x8, pw);
#pragma unroll
        for (int b = 0; b < DV / 32; ++b) {
          const bf16x8 vf = (kb == 0) ? vpre[b][s] : *(const bf16x8*)(vs_ + (b * 32 + r) * 128 + (((kb * 4 + s * 2 + hh) ^ ((r >> 1) & 7)) * 16));
          O[b] = __builtin_amdgcn_mfma_f32_32x32x16_bf16(vf, pf, O[b], 0, 0, 0);
        }
      }
    buf = (buf == 2) ? 0 : buf + 1; nbuf = (nbuf == 2) ? 0 : nbuf + 1;
  }
  __syncthreads();
}

DI void mla_unit(const Params& P, int l, int bl, int h, int qt, char* lds) {
  const int lane = tidx() & 63, wid = tidx() >> 6, r = lane & 31, hh = lane >> 5;
  const int isctx = qt >= 16;
  const int row = (isctx ? ML + bl * 256 + (qt - 16) * 128 : bl * 2048 + qt * 128) + wid * 32 + r;
  const int t = isctx ? 0 : qt * 128 + wid * 32 + r;
  const bf16_t* qp = (const bf16_t*)(P.ws + OFF_QM) + (size_t)row * 1536 + h * 96;
  const float* qg = P.mla_q_g + l * 96;
  const float* RMc = (const float*)(P.ws + OFF_RM); const float* RMs = RMc + 2048 * 16;
  const uint4 r0 = *(const uint4*)(qp + 0 * 16 + hh * 8), r1 = *(const uint4*)(qp + 1 * 16 + hh * 8), r2 = *(const uint4*)(qp + 2 * 16 + hh * 8),
              r3 = *(const uint4*)(qp + 3 * 16 + hh * 8), r4 = *(const uint4*)(qp + 4 * 16 + hh * 8), r5 = *(const uint4*)(qp + 5 * 16 + hh * 8);
  float ss = ssq8(r0) + ssq8(r1) + ssq8(r2) + ssq8(r3) + ssq8(r4) + ssq8(r5);
  ss += __shfl_xor(ss, 32);
  const float rstd = rsqrtf(ss * (1.0f / 96.0f) + EPS);
  const float qscale = 0.10206207261596577f * LOG2E;
  QFrag qf;
  qf.f0 = mla_qfrag<0>(r0, rstd, qg, hh, isctx, t, RMc, RMs, qscale); qf.f1 = mla_qfrag<1>(r1, rstd, qg, hh, isctx, t, RMc, RMs, qscale);
  qf.f2 = mla_qfrag<2>(r2, rstd, qg, hh, isctx, t, RMc, RMs, qscale); qf.f3 = mla_qfrag<3>(r3, rstd, qg, hh, isctx, t, RMc, RMs, qscale);
  qf.f4 = mla_qfrag<4>(r4, rstd, qg, hh, isctx, t, RMc, RMs, qscale); qf.f5 = mla_qfrag<5>(r5, rstd, qg, hh, isctx, t, RMc, RMs, qscale);
  f32x16 O[2]; float lsum;
  attn_stream<96, 64>(O, lsum, qf, (const bf16_t*)(P.ws + OFF_KM) + h * 96, 1536, (const bf16_t*)(P.ws + OFF_VMT) + ((size_t)(bl * 16 + h) * 64) * NKEY, bl, isctx ? 32 : 0, 36, lds);
  lsum += __shfl_xor(lsum, 32);
  const float inv = 1.0f / lsum;
  bf16_t* op = (bf16_t*)(P.ws + OFF_OB) + (size_t)row * 1024 + h * 64;
#pragma unroll
  for (int b = 0; b < 2; ++b)
#pragma unroll
    for (int g = 0; g < 4; ++g) {
      const f32x4 v = {O[b][4 * g] * inv, O[b][4 * g + 1] * inv, O[b][4 * g + 2] * inv, O[b][4 * g + 3] * inv};
      store4bf(op + b * 32 + 8 * g + 4 * hh, v);
    }
}

DI void diff_unit(const Params& P, int l, int bl, int h, int qt, char* lds) {
  const int lane = tidx() & 63, wid = tidx() >> 6, r = lane & 31, hh = lane >> 5;
  const int isctx = qt >= 16;
  const int row = (isctx ? ML + bl * 256 + (qt - 16) * 128 : bl * 2048 + qt * 128) + wid * 32 + r;
  bf16_t* qp = (bf16_t*)(P.ws + OFF_DQ) + (size_t)row * 1024 + h * 128;
  const bf16_t* Vt = (const bf16_t*)(P.ws + OFF_DVT) + ((size_t)(bl * 8 + h) * 128) * NKEY;
  const float qscale = 0.125f * LOG2E;
  const float lam = ((const float*)(P.ws + OFF_LAM))[l];
  f32x16 O[4]; float lsum;
  QFrag qa, qb;
  qa.f0 = scale_qfrag(*(const uint4*)(qp + 0 * 16 + hh * 8), qscale); qa.f1 = scale_qfrag(*(const uint4*)(qp + 1 * 16 + hh * 8), qscale);
  qa.f2 = scale_qfrag(*(const uint4*)(qp + 2 * 16 + hh * 8), qscale); qa.f3 = scale_qfrag(*(const uint4*)(qp + 3 * 16 + hh * 8), qscale);
  qa.f4 = qa.f0; qa.f5 = qa.f0;
  qb.f0 = scale_qfrag(*(const uint4*)(qp + 64 + 0 * 16 + hh * 8), qscale); qb.f1 = scale_qfrag(*(const uint4*)(qp + 64 + 1 * 16 + hh * 8), qscale);
  qb.f2 = scale_qfrag(*(const uint4*)(qp + 64 + 2 * 16 + hh * 8), qscale); qb.f3 = scale_qfrag(*(const uint4*)(qp + 64 + 3 * 16 + hh * 8), qscale);
  qb.f4 = qb.f0; qb.f5 = qb.f0;
  attn_stream<64, 128>(O, lsum, qa, (const bf16_t*)(P.ws + OFF_DK) + h * 128, 1024, Vt, bl, isctx ? 32 : 0, 36, lds);
  lsum += __shfl_xor(lsum, 32);
  {
    const float inv = 1.0f / lsum;
#pragma unroll
    for (int b = 0; b < 4; ++b)
#pragma unroll
      for (int g = 0; g < 4; ++g) {
        const f32x4 v = {O[b][4 * g] * inv, O[b][4 * g + 1] * inv, O[b][4 * g + 2] * inv, O[b][4 * g + 3] * inv};
        store4bf(qp + b * 32 + 8 * g + 4 * hh, v);
      }
  }
  attn_stream<64, 128>(O, lsum, qb, (const bf16_t*)(P.ws + OFF_DK) + h * 128 + 64, 1024, Vt, bl, isctx ? 32 : 0, 36, lds);
  lsum += __shfl_xor(lsum, 32);
  {
    const float inv = lam / lsum;
    float ss = 0.f;
#pragma unroll
    for (int b = 0; b < 4; ++b)
#pragma unroll
      for (int g = 0; g < 4; ++g) {
        const uint2 w = *(const uint2*)(qp + b * 32 + 8 * g + 4 * hh);
        const float a0 = lo2f(w.x) - O[b][4 * g] * inv, a1 = hi2f(w.x) - O[b][4 * g + 1] * inv, a2 = lo2f(w.y) - O[b][4 * g + 2] * inv, a3 = hi2f(w.y) - O[b][4 * g + 3] * inv;
        O[b][4 * g] = a0; O[b][4 * g + 1] = a1; O[b][4 * g + 2] = a2; O[b][4 * g + 3] = a3;
        ss += a0 * a0 + a1 * a1 + a2 * a2 + a3 * a3;
      }
    ss += __shfl_xor(ss, 32);
    const float rstd = rsqrtf(ss * (1.0f / 128.0f) + EPS) * (1.0f - lam_init_of(l));
    const float* sg = P.diff_subln_g + l * 128;
#pragma unroll
    for (int b = 0; b < 4; ++b)
#pragma unroll
      for (int g = 0; g < 4; ++g) {
        const int dv0 = b * 32 + 8 * g + 4 * hh;
        const f32x4 gg = *(const f32x4*)(sg + dv0);
        const f32x4 v = {O[b][4 * g] * rstd * gg[0], O[b][4 * g + 1] * rstd * gg[1], O[b][4 * g + 2] * rstd * gg[2], O[b][4 * g + 3] * rstd * gg[3]};
        store4bf(qp + dv0, v);
      }
  }
}

DI void pd_phase(const Params& P, int l, int half, int ph, char* lds) {
  const int nq_ctx = (l == 0) ? 2 : 0;
  const int n_dl = HB * 8 * 16, n_lru = HB * 8 * 4, n_ml = HB * 16 * 16, n_dc = HB * 8 * nq_ctx, n_mc = HB * 16 * nq_ctx;
  const int tot = n_dl + n_lru + n_ml + n_dc + n_mc;
  unsigned* ctr = (unsigned*)(P.ws + OFF_CTR) + ph * 8;
  volatile int* slot = (volatile int*)(lds + LDS_BAR + 8);
  const int myx = (int)((unsigned)__builtin_amdgcn_s_getreg((3 << 11) | 20) & 7u);
  for (;;) {
    __syncthreads();
    if (threadIdx.x == 0) {
      int got = -1;
      for (int y = 0; y < 8 && got < 0; ++y) {
        const int xx = (myx + y) & 7;
        const int i = (int)__hip_atomic_fetch_add(ctr + xx, 1u, __ATOMIC_RELAXED, __HIP_MEMORY_SCOPE_AGENT);
        const int uu = i * 8 + xx;
        if (uu < tot) got = uu;
      }
      *slot = got;
    }
    __syncthreads();
    const int u = *slot;
    if (u < 0) break;
    int v = u, kind, bl = 0, h = 0, qt = 0;
    if (v < n_dl) { kind = 0; const int x = v & 7, s = (v >> 3) & 63, rnd = v >> 9; const int g = x + 8 * ((s >> 4) + 4 * rnd); qt = s & 15; bl = g >> 3; h = g & 7; }
    else if ((v -= n_dl) < n_lru) { kind = 2; }
    else if ((v -= n_lru) < n_ml) { kind = 1; const int x = v & 7, s = (v >> 3) & 63, rnd = v >> 9; const int g = x + 8 * ((s >> 4) + 4 * rnd); qt = s & 15; bl = g >> 4; h = g & 15; }
    else if ((v -= n_ml) < n_dc) { kind = 0; bl = v >> 4; h = (v >> 1) & 7; qt = 16 + (v & 1); }
    else { v -= n_dc; kind = 1; bl = v >> 5; h = (v >> 1) & 15; qt = 16 + (v & 1); }
#ifndef NO_DIFF
    if (kind == 0) diff_unit(P, l, bl, h, qt, lds);
#endif
#ifndef NO_MLA
    if (kind == 1) mla_unit(P, l, bl, h, qt, lds);
#endif
#ifndef NO_LRUF
    if (kind == 2) lru_seq_unit(P, l, v, lds);
#endif
  }
}

DI void merge_phase(const Params& P, int l, int half, int MT, char* lds) {
  const int tid = tidx(), lane = tid & 63, wid = tid >> 6, wr = wid >> 1, wc = wid & 1, fr = lane & 15, fq = lane >> 4;
  const bf16_t* H = (const bf16_t*)(P.ws + OFF_HBF);
  bf16_t* Z = (bf16_t*)(P.ws + OFF_RX);
  for (int u = blockIdx.x; u < MT * 16; u += gridDim.x) {
    const int tn = u / MT, tm = u % MT, n0 = tn * 64;
    f32x4 z[4][2]; zero_acc<2>(z);
#pragma unroll 1
    for (int br = 0; br < 3; ++br) {
      const bf16_t* Ab = (const bf16_t*)(P.ws + (br == 0 ? OFF_GRG : br == 1 ? OFF_OB : OFF_DQ));
      const bf16_t* Wb = (const bf16_t*)(P.ws + OFF_WBRA + (size_t)br * (OFF_WBRB - OFF_WBRA));
      f32x4 g[4][2]; zero_acc<2>(g);
      gemm_core<2>(g, H + (size_t)tm * 128 * 1024, 1024, (const bf16_t*)(P.ws + OFF_WMG) + (size_t)(br * 1024 + n0) * 1024, 1024, 1024, lds);
#pragma unroll
      for (int mi = 0; mi < 4; ++mi)
#pragma unroll
        for (int ni = 0; ni < 2; ++ni)
#pragma unroll
          for (int j = 0; j < 4; ++j) g[mi][ni][j] = sigmoidf_(g[mi][ni][j]);
      f32x4 v[4][2]; zero_acc<2>(v);
      gemm_core<2>(v, Ab + (size_t)tm * 128 * 1024, 1024, Wb + (size_t)n0 * 1024, 1024, 1024, lds);
#pragma unroll
      for (int mi = 0; mi < 4; ++mi)
#pragma unroll
        for (int ni = 0; ni < 2; ++ni) z[mi][ni] += g[mi][ni] * v[mi][ni];
    }
#pragma unroll
    for (int mi = 0; mi < 4; ++mi)
#pragma unroll
      for (int ni = 0; ni < 2; ++ni) store4bf(Z + (size_t)(tm * 128 + wr * 64 + mi * 16 + fr) * 1024 + n0 + wc * 32 + ni * 16 + fq * 4, z[mi][ni]);
  }
}

DI void resid_gemm_phase(const Params& P, int l, int half_, int MT, const bf16_t* A, int K, const bf16_t* W, int goff, bool src_is_input, char* lds, int rph = 0) {
  const int tid = tidx(), lane = tid & 63, wid = tid >> 6, wr = wid >> 1, wc = wid & 1, fr = lane & 15, fq = lane >> 4;
  const float* MOD = (const float*)(P.ws + OFF_MOD) + (size_t)l * 9 * 6144 + goff;
  for (int u = blockIdx.x; u < MT * 16; u += gridDim.x) {
    const int L_ = u >> 3, tm = (u & 7) + 8 * (L_ >> 4), tn = L_ & 15, n0 = tn * 64;
    f32x4 acc[4][2]; zero_acc<2>(acc);
    gemm_core<2>(acc, A + (size_t)tm * 128 * K, K, W + (size_t)n0 * K, K, K, lds);
#pragma unroll
    for (int mi = 0; mi < 4; ++mi) {
      const int grow = tm * 128 + wr * 64 + mi * 16 + fr;
      const int half = rph ? grow / rph : half_, row = rph ? grow % rph : grow; const RowInfo ri = rowinfo(row);
      const float* md = MOD + (size_t)(ri.isctx ? 8 : half * HB + ri.bl) * 6144;
      float* dst = resid_ptr(P, half, row);
      const float* src = src_is_input ? input_ptr(P, half, row) : dst;
#pragma unroll
      for (int ni = 0; ni < 2; ++ni) {
        const int c0 = n0 + wc * 32 + ni * 16 + fq * 4;
        const f32x4 gt = *(const f32x4*)(md + c0), sv = *(const f32x4*)(src + c0);
        *(f32x4*)(dst + c0) = sv + gt * acc[mi][ni];
      }
    }
  }
}

DI void ffn_in_phase(const Params& P, int l, int half, int MT, char* lds) {
  const int tid = tidx(), lane = tid & 63, wid = tid >> 6, wr = wid >> 1, wc = wid & 1, fr = lane & 15, fq = lane >> 4;
  const bf16_t* H = (const bf16_t*)(P.ws + OFF_HBF);
  bf16_t* HH = (bf16_t*)(P.ws + OFF_DQ);
  for (int u = blockIdx.x; u < MT * 44; u += gridDim.x) {
    const int tn = u / MT, tm = u % MT;
    f32x4 acc[4][4]; zero_acc<4>(acc);
    gemm_core<4>(acc, H + (size_t)tm * 128 * 1024, 1024, (const bf16_t*)(P.ws + OFF_WFI) + (size_t)tn * 128 * 1024, 1024, 1024, lds);
#pragma unroll
    for (int mi = 0; mi < 4; ++mi) {
      const int row = tm * 128 + wr * 64 + mi * 16 + fr;
#pragma unroll
      for (int q = 0; q < 2; ++q) {
        f32x4 v;
#pragma unroll
        for (int j = 0; j < 4; ++j) v[j] = siluf_(acc[mi][2 * q][j]) * acc[mi][2 * q + 1][j];
        store4bf(HH + (size_t)row * FH + tn * 64 + (wc * 2 + q) * 16 + fq * 4, v);
      }
    }
  }
}

#define XB_TMO      128
#define XB_XCNT(j)  (256  + 64 * (j))
#define XB_XSUB(j)  (1280 + 64 * (j))
#define XB_XGEN(j)  (2304 + 64 * (j))
#define XB_TOP      3328
#define XB_TOPGEN   3392
#define XCD_BAR_WORDS 3456
#define XB_SPIN_CAP (1u << 20)
#define LAS __attribute__((address_space(3)))
DI unsigned xb_ld(unsigned* p) { return __hip_atomic_load(p, __ATOMIC_RELAXED, __HIP_MEMORY_SCOPE_AGENT); }
DI unsigned xb_add(unsigned* p, unsigned v) { return __hip_atomic_fetch_add(p, v, __ATOMIC_RELAXED, __HIP_MEMORY_SCOPE_AGENT); }
DI unsigned xb_xcc_id() { return (unsigned)__builtin_amdgcn_s_getreg((3 << 11) | 20) & 0xFu; }
#define XB_SPIN(cond, bar) do { unsigned _sp = 0; while (cond) { __builtin_amdgcn_s_sleep(1); \
    if ((++_sp & 255u) == 0u) { if (xb_ld(&(bar)[XB_TMO])) break; if (_sp > XB_SPIN_CAP) { atomicAdd(&(bar)[XB_TMO], 1u); break; } } } } while (0)
struct XcdBarrier { unsigned* bar; unsigned x; volatile LAS unsigned* st; };
DI XcdBarrier xcd_barrier_post(unsigned* bar, volatile LAS unsigned* st) {
  XcdBarrier b; b.bar = bar; b.x = xb_xcc_id(); b.st = st;
  if (threadIdx.x == 0) (void)xb_add(&bar[XB_XCNT(b.x)], 1u);
  return b;
}
DI void xcd_barrier_complete(unsigned* bar, unsigned x, unsigned& nloc, unsigned& nx) {
  const unsigned G = gridDim.x * gridDim.y * gridDim.z;
  unsigned sum, cnt, mine, sp = 0u;
  for (;;) {
    sum = 0u; cnt = 0u; mine = 0u;
#pragma unroll
    for (unsigned j = 0; j < 16; ++j) { const unsigned c = xb_ld(&bar[XB_XCNT(j)]); sum += c; cnt += (c > 0u) ? 1u : 0u; mine = (j == x) ? c : mine; }
    if (sum == G) break;
    __builtin_amdgcn_s_sleep(1);
    if ((++sp & 255u) == 0u) { if (xb_ld(&bar[XB_TMO])) break; if (sp > XB_SPIN_CAP) { atomicAdd(&bar[XB_TMO], 1u); break; } }
  }
  nloc = mine > 0u ? mine : 1u; nx = cnt > 0u ? cnt : 1u;
}
DI void xcd_barrier(const XcdBarrier& b) {
  asm volatile("s_waitcnt vmcnt(0)" ::: "memory");
  __syncthreads();
  if (threadIdx.x == 0) {
    unsigned* bar = b.bar;
    __builtin_amdgcn_s_waitcnt(0);
    unsigned nloc = b.st[0], nx = b.st[1];
    if (nloc == 0u) { xcd_barrier_complete(bar, b.x, nloc, nx); b.st[0] = nloc; b.st[1] = nx; }
    const unsigned old = xb_add(&bar[XB_XSUB(b.x)], 1u);
    const unsigned gen = old / nloc;
    if (old + 1u == (gen + 1u) * nloc) {
      __builtin_amdgcn_fence(__ATOMIC_RELEASE, "agent");
      asm volatile("s_waitcnt vmcnt(0)" ::: "memory");
      const unsigned og = xb_add(&bar[XB_TOP], 1u);
      const unsigned tg = og / nx;
      if (og + 1u == (tg + 1u) * nx) xb_add(&bar[XB_TOPGEN], 1u);
      else XB_SPIN(xb_ld(&bar[XB_TOPGEN]) == tg, bar);
      __builtin_amdgcn_fence(__ATOMIC_ACQUIRE, "agent");
      xb_add(&bar[XB_XGEN(b.x)], 1u);
      asm volatile("s_waitcnt vmcnt(0)" ::: "memory");
    } else {
      XB_SPIN(xb_ld(&bar[XB_XGEN(b.x)]) == gen, bar);
      __builtin_amdgcn_fence(__ATOMIC_ACQUIRE, "agent");
      asm volatile("s_waitcnt vmcnt(0)" ::: "memory");
    }
  }
  __syncthreads();
}

constexpr int NPHASE = 1 + 2 * 15;
static_assert(OFF_RX == OFF_HBF + SZ1K, "joint HBF2 spans HBF + RX");
static_assert(OFF_QM - OFF_DQ >= (size_t)2 * MH * FH * 2, "joint HH spans DQ..VMT");
DI void run_phase(const Params& P, int ph, char* lds) {
  if (ph == 0) { phase0(P, lds); return; }
  const int q = ph - 1, l = q / 15, r = q % 15;
  const int MTl = (l == 0) ? MH / 128 : ML / 128;
  if (r >= 12) {
    const int rph = MTl * 128;
    if (r == 12) norm_phase(P, l, 0, 1, 2 * rph, rph);
    else if (r == 13) ffn_in_phase(P, l, 0, 2 * MTl, lds);
    else resid_gemm_phase(P, l, 0, 2 * MTl, (const bf16_t*)(P.ws + OFF_DQ), FH, (const bf16_t*)(P.ws + OFF_WFO), 5120, false, lds, rph);
    return;
  }
  const int half = r / 6, k = r % 6;
  switch (k) {
    case 0: if (half == 0) convert_weights(P, l, lds); norm_phase(P, l, half, 0, MH); break;
    case 1: g1_phase(P, l, half, lds); break;
    case 2: pc_phase(P, l, half, lds); break;
    case 3: pd_phase(P, l, half, ph, lds); break;
    case 4: merge_phase(P, l, half, MTl, lds); break;
    default: resid_gemm_phase(P, l, half, MTl, (const bf16_t*)(P.ws + OFF_RX), 1024, (const bf16_t*)(P.ws + OFF_WOUT), 2048, l == 0, lds); break;
  }
}

__global__ void __launch_bounds__(256, 2) fwd_kernel(Params P, int ph0, int ph1) {
  extern __shared__ __attribute__((aligned(16))) char smem[];
  volatile LAS unsigned* st = (volatile LAS unsigned*)(smem + LDS_BAR);
  if (threadIdx.x < 2) st[threadIdx.x] = 0u;
  __syncthreads();
  const XcdBarrier xb = xcd_barrier_post((unsigned*)(P.ws + OFF_BAR), st);
  for (int ph = ph0; ph < ph1; ++ph) {
    run_phase(P, ph, smem);
    if (ph + 1 < ph1) { if (ph == 0) cg::this_grid().sync(); else xcd_barrier(xb); }
  }
}

extern "C" void kernel_launch(void* const* d_in, const int* in_sizes, int n_in, void* d_out, int out_size, void* d_ws, size_t ws_size, hipStream_t stream) {
  static int grid_blocks = 0;
  if (!grid_blocks) {
    hipFuncSetAttribute((const void*)fwd_kernel, hipFuncAttributeMaxDynamicSharedMemorySize, LDS_BYTES);
    int dev = 0, cus = 0, per_cu = 0;
    hipGetDevice(&dev);
    hipDeviceGetAttribute(&cus, hipDeviceAttributeMultiprocessorCount, dev);
    hipOccupancyMaxActiveBlocksPerMultiprocessor(&per_cu, fwd_kernel, 256, LDS_BYTES);
    if (per_cu > 2) per_cu = 2;
    grid_blocks = cus * per_cu;
    if (grid_blocks <= 0) grid_blocks = 256;
  }
  if (ws_size < WS_NEED) { fprintf(stderr, "workspace too small: %zu < %zu\n", ws_size, (size_t)WS_NEED); return; }
  hipMemsetAsync((char*)d_ws + OFF_BAR, 0, XCD_BAR_WORDS * 4 + 2048, stream);
  Params p{};
  const float** f = (const float**)&p;
  for (int i = 0; i < 32; ++i) f[i] = (const float*)d_in[i];
  p.out = (float*)d_out; p.ws = (char*)d_ws;
#if ONE_LAUNCH
  int ph0 = 0, ph1 = NPHASE;
  void* args[] = {&p, &ph0, &ph1};
  hipError_t e = hipLaunchCooperativeKernel((const void*)fwd_kernel, dim3(grid_blocks), dim3(256), args, LDS_BYTES, stream);
  if (e != hipSuccess) fprintf(stderr, "cooperative launch failed: %s (grid %d)\n", hipGetErrorString(e), grid_blocks);
#else
  for (int ph = 0; ph < NPHASE; ++ph) fwd_kernel<<<grid_blocks, 256, LDS_BYTES, stream>>>(p, ph, ph + 1);
#endif
}
```

```cpp
#include <hip/hip_runtime.h>
#include <hip/hip_cooperative_groups.h>
#include <cstdio>
#include <cstdint>
namespace cg = cooperative_groups;

#ifndef ONE_LAUNCH
#define ONE_LAUNCH 1
#endif

typedef unsigned short bf16_t;
typedef short bf16x8 __attribute__((ext_vector_type(8)));
typedef float f32x4 __attribute__((ext_vector_type(4)));
typedef float f32x16 __attribute__((ext_vector_type(16)));
#define DI __device__ __forceinline__

constexpr int D = 1024, T = 2048, CT = 256, HB = 4;
constexpr int ML = HB * T;
constexpr int MC = HB * CT;
constexpr int MH = ML + MC;
constexpr int NKEY = T + CT;
constexpr int N1 = 5888;
constexpr int FH = 2816;
constexpr int INC = 8864;
constexpr float EPS = 1e-6f;
constexpr float LOG2E = 1.4426950408889634f;

constexpr size_t al(size_t x) { return (x + 255) & ~(size_t)255; }
constexpr size_t OFF_MOD = 0;
constexpr size_t OFF_RM = al(OFF_MOD + 2 * 9 * 6144 * 4);
constexpr size_t OFF_RD = al(OFF_RM + 2 * 2048 * 16 * 4);
constexpr size_t OFF_LAM = al(OFF_RD + 2 * 2048 * 32 * 4);
constexpr size_t OFF_BAR = al(OFF_LAM + 256);
constexpr size_t OFF_CTR = OFF_BAR + 3456 * 4;
constexpr size_t OFF_CARRY = al(OFF_CTR + 2048);
constexpr size_t OFF_XC = al(OFF_CARRY + (size_t)HB * 2 * 18 * 1024 * 8);
constexpr size_t OFF_WIN = al(OFF_XC + (size_t)2048 * 1024 * 4);
constexpr size_t OFF_WMG = al(OFF_WIN + (size_t)N1 * 1024 * 2);
constexpr size_t OFF_WUQ = al(OFF_WMG + (size_t)3072 * 1024 * 2);
constexpr size_t OFF_WUKV = al(OFF_WUQ + (size_t)1536 * 384 * 2);
constexpr size_t OFF_WLRU = al(OFF_WUKV + (size_t)2048 * 256 * 2);
constexpr size_t OFF_WBRA = al(OFF_WLRU + (size_t)4096 * 128 * 2);
constexpr size_t OFF_WBRB = al(OFF_WBRA + (size_t)1024 * 1024 * 2);
constexpr size_t OFF_WBRC = al(OFF_WBRB + (size_t)1024 * 1024 * 2);
constexpr size_t OFF_WOUT = al(OFF_WBRC + (size_t)1024 * 1024 * 2);
constexpr size_t OFF_WFI = al(OFF_WOUT + (size_t)1024 * 1024 * 2);
constexpr size_t OFF_WFO = al(OFF_WFI + (size_t)5632 * 1024 * 2);
constexpr size_t OFF_HBF = al(OFF_WFO + (size_t)1024 * FH * 2);
constexpr size_t SZ1K = (size_t)MH * 1024 * 2;
constexpr size_t OFF_RX = al(OFF_HBF + SZ1K);
constexpr size_t OFF_GRG = al(OFF_RX + SZ1K);
constexpr size_t OFF_CQKV = al(OFF_GRG + SZ1K);
constexpr size_t OFF_DQ = al(OFF_CQKV + (size_t)MH * 768 * 2);
constexpr size_t OFF_DK = al(OFF_DQ + SZ1K);
constexpr size_t OFF_DVT = al(OFF_DK + SZ1K);
constexpr size_t OFF_KM = al(OFF_DVT + SZ1K);
constexpr size_t OFF_VMT = al(OFF_KM + (size_t)MH * 1536 * 2);
constexpr size_t OFF_QM = al(OFF_VMT + SZ1K);
constexpr size_t OFF_OB = al(OFF_QM + (size_t)MH * 1536 * 2);
constexpr size_t OFF_XCV = al(OFF_OB + SZ1K);
constexpr size_t WS_NEED = al(OFF_XCV + SZ1K);
static_assert(OFF_DK == OFF_DQ + SZ1K && OFF_DVT == OFF_DK + SZ1K, "HH alias needs contiguous DQ/DK/DVT");
static_assert((size_t)MH * FH * 2 <= 3 * SZ1K, "HH alias size");

constexpr int LDS_BYTES = 73728 + 1024 + 3072 + 32;
constexpr int LDS_BAR = 73728 + 1024 + 3072;
constexpr int LDS_RS = 73728, LDS_SEG = 73728 + 1024;

struct Params {
  const float *x, *c, *ctx, *c_ctx, *w_mod, *b_mod, *norm1_g, *norm2_g, *w_in, *conv_w, *conv_b, *lru_wa, *lru_ba, *lru_wi, *lru_bi,
      *lru_lambda, *mla_qn_g, *mla_w_uq, *mla_kvn_g, *mla_w_ukv, *mla_q_g, *mla_k_g, *diff_q_g, *diff_k_g, *diff_lambda, *diff_subln_g,
      *w_br_a, *w_br_b, *w_br_c, *w_out, *w_ffn_in, *w_ffn_out;
  float* out;
  char* ws;
};

DI int tidx() { int t = __builtin_amdgcn_workitem_id_x(); asm volatile("" : "+v"(t)); return t; }
DI float bf2f(unsigned short u) { return __uint_as_float(((unsigned)u) << 16); }
DI unsigned short f2bf(float x) { unsigned u = __float_as_uint(x); u += 0x7fffu + ((u >> 16) & 1u); return (unsigned short)(u >> 16); }
typedef __bf16 bf16n2 __attribute__((ext_vector_type(2)));
typedef float f32x2n __attribute__((ext_vector_type(2)));
DI unsigned pack2(float lo, float hi) { const f32x2n v = {lo, hi}; return __builtin_bit_cast(unsigned, __builtin_convertvector(v, bf16n2)); }
DI float lo2f(unsigned u) { return __uint_as_float(u << 16); }
DI float hi2f(unsigned u) { return __uint_as_float(u & 0xffff0000u); }
DI float sigmoidf_(float x) { return 1.0f / (1.0f + __expf(-x)); }
DI float siluf_(float x) { return x * sigmoidf_(x); }
DI float geluf_(float x) { const float u = 0.7978845608028654f * (x + 0.044715f * x * x * x); return 0.5f * x * (1.0f + tanhf(u)); }
DI int perm16(int o) { return (o & 3) | ((o & 4) << 1) | ((o & 8) >> 1); }
DI int keypos(int kk) { return (kk & ~15) | perm16(kk & 15); }
struct RowInfo { int bl, t, isctx; };
DI RowInfo rowinfo(int lr) { RowInfo r; if (lr < ML) { r.bl = lr >> 11; r.t = lr & 2047; r.isctx = 0; } else { const int q = lr - ML; r.bl = q >> 8; r.t = q & 255; r.isctx = 1; } return r; }
DI float* resid_ptr(const Params& P, int half, int lr) {
  return lr < ML ? P.out + ((size_t)half * ML + lr) * D : (float*)(P.ws + OFF_XC) + ((size_t)half * MC + (lr - ML)) * D;
}
DI const float* input_ptr(const Params& P, int half, int lr) {
  return lr < ML ? P.x + ((size_t)half * ML + lr) * D : P.ctx + ((size_t)half * MC + (lr - ML)) * D;
}
DI float lam_init_of(int l) { return l == 0 ? 0.2f : 0.35550906f; }

typedef __attribute__((address_space(3))) unsigned lds_u32_t;
#define GLDS16(gsrc, ldst) __builtin_amdgcn_global_load_lds((const unsigned*)(gsrc), (lds_u32_t*)(ldst), 16, 0, 0)
DI void gemm_core_ring2(f32x4 (&acc)[4][2], const bf16_t* __restrict__ A, int lda, const bf16_t* __restrict__ W, int ldw, int K, char* lds) {
  constexpr int NT = 2, STAGE = 24576;
  const int tid = tidx(), lane = tid & 63, wid = tid >> 6, wr = wid >> 1, wc = wid & 1, fr = lane & 15, fq = lane >> 4;
  const int crow = tid >> 3, csrc = (tid & 7) ^ ((crow >> 1) & 7);
  const int nk = K >> 6;
  const bf16_t* ap = A + (size_t)crow * lda + csrc * 8;
  const bf16_t* wp = W + (size_t)crow * ldw + csrc * 8;
  const int sw = (fr >> 1) & 7;
  const int wbase = __builtin_amdgcn_readfirstlane(wid) * 1024;
#define RING_STAGE(KT, BUF) do { char* a_ = lds + (BUF) * STAGE + wbase; char* w_ = a_ + 16384; \
    _Pragma("unroll") for (int i = 0; i < 4; ++i) GLDS16(ap + (size_t)(32 * i) * lda + (KT) * 64, a_ + i * 4096); \
    _Pragma("unroll") for (int i = 0; i < NT; ++i) GLDS16(wp + (size_t)(32 * i) * ldw + (KT) * 64, w_ + i * 4096); } while (0)
  RING_STAGE(0, 0); RING_STAGE(1, 1);
  int buf = 0, nbuf = 2;
  for (int j = 0; j < nk; ++j) {
    if (j + 1 < nk) asm volatile("s_waitcnt vmcnt(6)" ::: "memory"); else asm volatile("s_waitcnt vmcnt(0)" ::: "memory");
    asm volatile("s_waitcnt lgkmcnt(0)" ::: "memory");
    __builtin_amdgcn_s_barrier();
    asm volatile("" ::: "memory");
    if (j + 2 < nk) RING_STAGE(j + 2, nbuf);
    {
      const char* a = lds + buf * STAGE; const char* w = a + 16384;
      bf16x8 bf0[4], af0[NT], bf1[4], af1[NT];
      { const int co = ((0 * 4 + fq) ^ sw) * 16;
#pragma unroll
        for (int mi = 0; mi < 4; ++mi) bf0[mi] = *(const bf16x8*)(a + (wr * 64 + mi * 16 + fr) * 128 + co);
#pragma unroll
        for (int ni = 0; ni < NT; ++ni) af0[ni] = *(const bf16x8*)(w + (wc * NT * 16 + ni * 16 + fr) * 128 + co); }
      { const int co = ((1 * 4 + fq) ^ sw) * 16;
#pragma unroll
        for (int mi = 0; mi < 4; ++mi) bf1[mi] = *(const bf16x8*)(a + (wr * 64 + mi * 16 + fr) * 128 + co);
#pragma unroll
        for (int ni = 0; ni < NT; ++ni) af1[ni] = *(const bf16x8*)(w + (wc * NT * 16 + ni * 16 + fr) * 128 + co); }
#pragma unroll
      for (int mi = 0; mi < 4; ++mi)
#pragma unroll
        for (int ni = 0; ni < NT; ++ni) acc[mi][ni] = __builtin_amdgcn_mfma_f32_16x16x32_bf16(af0[ni], bf0[mi], acc[mi][ni], 0, 0, 0);
#pragma unroll
      for (int mi = 0; mi < 4; ++mi)
#pragma unroll
        for (int ni = 0; ni < NT; ++ni) acc[mi][ni] = __builtin_amdgcn_mfma_f32_16x16x32_bf16(af1[ni], bf1[mi], acc[mi][ni], 0, 0, 0);
    }
    buf = (buf == 2) ? 0 : buf + 1; nbuf = (nbuf == 2) ? 0 : nbuf + 1;
  }
  __syncthreads();
#undef RING_STAGE
}
template <int K_> DI void row_rstd_table(const bf16_t* A, int lda, char* lds);
template <int NT, int RSK = 0>
DI void gemm_core(f32x4 (&acc)[4][NT], const bf16_t* __restrict__ A, int lda, const bf16_t* __restrict__ W, int ldw, int K, char* lds) {
  if constexpr (NT == 2) { gemm_core_ring2(acc, A, lda, W, ldw, K, lds); return; }
  constexpr int STAGE = 32768;
  const int tid = tidx(), lane = tid & 63, wid = tid >> 6, wr = wid >> 1, wc = wid & 1, fr = lane & 15, fq = lane >> 4;
  const int crow = tid >> 3, csrc = (tid & 7) ^ ((crow >> 1) & 7);
  const int nk = K >> 6;
  const bf16_t* ap = A + (size_t)crow * lda + csrc * 8;
  const bf16_t* wp = W + (size_t)crow * ldw + csrc * 8;
  const int sw = (fr >> 1) & 7;
  const int wbase = __builtin_amdgcn_readfirstlane(wid) * 1024;
#define GEMM_STAGE(KT, BUF) do { char* a_ = lds + (BUF) * STAGE + wbase; char* w_ = a_ + 16384; \
    _Pragma("unroll") for (int i = 0; i < 4; ++i) GLDS16(ap + (size_t)(32 * i) * lda + (KT) * 64, a_ + i * 4096); \
    _Pragma("unroll") for (int i = 0; i < NT; ++i) GLDS16(wp + (size_t)(32 * i) * ldw + (KT) * 64, w_ + i * 4096); } while (0)
#define GEMM_LDFR(BUF, KS, BF, AF) do { const char* a = lds + (BUF) * STAGE; const char* w = a + 16384; const int co = (((KS) * 4 + fq) ^ sw) * 16; \
      _Pragma("unroll") for (int mi = 0; mi < 4; ++mi) BF[mi] = *(const bf16x8*)(a + (wr * 64 + mi * 16 + fr) * 128 + co); \
      _Pragma("unroll") for (int ni = 0; ni < NT; ++ni) AF[ni] = *(const bf16x8*)(w + (wc * NT * 16 + ni * 16 + fr) * 128 + co); } while (0)
#define GEMM_MMA(BF, AF) do { \
      _Pragma("unroll") for (int mi = 0; mi < 4; ++mi) \
        _Pragma("unroll") for (int ni = 0; ni < NT; ++ni) acc[mi][ni] = __builtin_amdgcn_mfma_f32_16x16x32_bf16(AF[ni], BF[mi], acc[mi][ni], 0, 0, 0); } while (0)
#define GEMM_COMPUTE(BUF) do { bf16x8 bf0[4], af0[NT], bf1[4], af1[NT]; \
    GEMM_LDFR(BUF, 0, bf0, af0); \
    __builtin_amdgcn_sched_barrier(0); \
    GEMM_LDFR(BUF, 1, bf1, af1); \
    GEMM_MMA(bf0, af0); \
    __builtin_amdgcn_sched_barrier(0); \
    GEMM_MMA(bf1, af1); } while (0)
  GEMM_STAGE(0, 0);
  if constexpr (RSK != 0) row_rstd_table<RSK>(A, lda, lds);
  __syncthreads();
  for (int kt = 0; kt + 1 < nk; ++kt) {
    GEMM_STAGE(kt + 1, (kt + 1) & 1);
    GEMM_COMPUTE(kt & 1);
    __syncthreads();
  }
  GEMM_COMPUTE((nk - 1) & 1);
  __syncthreads();
#undef GEMM_COMPUTE
#undef GEMM_MMA
#undef GEMM_LDFR
#undef GEMM_STAGE
}
template <int NT> DI void zero_acc(f32x4 (&acc)[4][NT]) {
#pragma unroll
  for (int mi = 0; mi < 4; ++mi)
#pragma unroll
    for (int ni = 0; ni < NT; ++ni) acc[mi][ni] = (f32x4){0.f, 0.f, 0.f, 0.f};
}
DI float ssq8(uint4 v) { const float a = lo2f(v.x), b = hi2f(v.x), c = lo2f(v.y), d = hi2f(v.y), e = lo2f(v.z), f = hi2f(v.z), g = lo2f(v.w), h = hi2f(v.w); return a * a + b * b + c * c + d * d + e * e + f * f + g * g + h * h; }
DI void store4bf(bf16_t* p, f32x4 v) { uint2 w; w.x = pack2(v[0], v[1]); w.y = pack2(v[2], v[3]); *(uint2*)p = w; }

template <int K>
DI void row_rstd_table(const bf16_t* A, int lda, char* lds) {
  const int tid = tidx(), row = tid >> 1, hf = tid & 1;
  const bf16_t* p = A + (size_t)row * lda + hf * (K >> 1);
  float ss = 0.f;
#pragma unroll
  for (int i0 = 0; i0 < (K >> 4); i0 += 8) {
    uint4 v[8];
#pragma unroll
    for (int i = 0; i < 8; ++i) v[i] = *(const uint4*)(p + (i0 + i) * 8);
#pragma unroll
    for (int i = 0; i < 8; ++i) ss += ssq8(v[i]);
  }
  ss += __shfl_xor(ss, 1);
  if (hf == 0) ((float*)(lds + LDS_RS))[row] = rsqrtf(ss / (float)K + EPS);
}

DI void phase0(const Params& P, char* lds) {
  const int tid = tidx(), lane = tid & 63, wid = tid >> 6;
  float* sil = (float*)lds;
  float* part = (float*)(lds + 9 * 1024 * 4);
  float* MOD = (float*)(P.ws + OFF_MOD);
  for (int u = blockIdx.x; u < 192 + 384 + 1; u += gridDim.x) {
    if (u < 192) {
      const int l = u / 96, cg_ = u % 96;
      __syncthreads();
      for (int i = tid; i < 9 * 1024; i += 256) { const int r = i >> 10, k = i & 1023; const float v = r < 8 ? P.c[r * 1024 + k] : P.c_ctx[k]; sil[i] = siluf_(v); }
      __syncthreads();
      float acc[9];
#pragma unroll
      for (int r = 0; r < 9; ++r) acc[r] = 0.f;
      const float* wm = P.w_mod + (size_t)l * 1024 * 6144 + cg_ * 64 + lane;
      for (int k = wid * 256; k < wid * 256 + 256; k += 8) {
        float w[8];
#pragma unroll
        for (int e = 0; e < 8; ++e) w[e] = wm[(size_t)(k + e) * 6144];
#pragma unroll
        for (int e = 0; e < 8; ++e)
#pragma unroll
          for (int r = 0; r < 9; ++r) acc[r] += sil[r * 1024 + k + e] * w[e];
      }
#pragma unroll
      for (int r = 0; r < 9; ++r) part[(wid * 9 + r) * 64 + lane] = acc[r];
      __syncthreads();
      for (int i = tid; i < 9 * 64; i += 256) {
        const int r = i >> 6, cc = i & 63;
        const float s = part[(0 * 9 + r) * 64 + cc] + part[(1 * 9 + r) * 64 + cc] + part[(2 * 9 + r) * 64 + cc] + part[(3 * 9 + r) * 64 + cc];
        MOD[((size_t)l * 9 + r) * 6144 + cg_ * 64 + cc] = s + P.b_mod[l * 6144 + cg_ * 64 + cc];
      }
    } else if (u < 192 + 384) {
      const int i = (u - 192) * 256 + tid;
      const int t = i / 48, e = i % 48;
      const float rowid = (float)(t >> 6), colid = (float)(t & 63);
      if (e < 16) {
        const int fi = e & 7; const float fr_ = powf(10000.0f, -(float)fi / 8.0f);
        const float ang = (e < 8 ? rowid : colid) * fr_;
        ((float*)(P.ws + OFF_RM))[t * 16 + e] = cosf(ang);
        ((float*)(P.ws + OFF_RM))[2048 * 16 + t * 16 + e] = sinf(ang);
      } else {
        const int e2 = e - 16, fi = e2 & 15; const float fr_ = powf(10000.0f, -(float)fi / 16.0f);
        const float ang = (e2 < 16 ? rowid : colid) * fr_;
        ((float*)(P.ws + OFF_RD))[t * 32 + e2] = cosf(ang);
        ((float*)(P.ws + OFF_RD))[2048 * 32 + t * 32 + e2] = sinf(ang);
      }
    } else {
      if (tid < 2) {
        const float* dl = P.diff_lambda + tid * 256;
        float s1 = 0.f, s2 = 0.f;
        for (int i = 0; i < 64; ++i) { s1 += dl[i] * dl[64 + i]; s2 += dl[128 + i] * dl[192 + i]; }
        ((float*)(P.ws + OFF_LAM))[tid] = expf(s1) - expf(s2) + lam_init_of(tid);
      }
    }
  }
}

constexpr int CT_WIN = (N1 / 64) * 16, CT_WMG = CT_WIN + 48 * 16, CT_WUQ = CT_WMG + 24 * 6, CT_WUKV = CT_WUQ + 32 * 4, CT_WLRU = CT_WUKV + 64 * 2,
              CT_WBR = CT_WLRU + 4 * 16 * 16, CT_WFI = CT_WBR + 88 * 16, CT_WFO = CT_WFI + 16 * 44;
DI void convert_weights(const Params& P, int l, char* lds) {
  const int tid = tidx();
  bf16_t* tl = (bf16_t*)lds;
  for (int t = blockIdx.x; t < CT_WFO; t += gridDim.x) {
    int m, lt, NTl, K; bf16_t* dst; const float* sbase; int sstride; const float* kscale = nullptr;
    if (t < CT_WIN) { m = 0; lt = t; NTl = N1 / 64; K = 1024; dst = (bf16_t*)(P.ws + OFF_WIN); sbase = P.w_in + (size_t)l * 1024 * INC; sstride = INC; }
    else if (t < CT_WMG) { m = 1; lt = t - CT_WIN; NTl = 48; K = 1024; dst = (bf16_t*)(P.ws + OFF_WMG); sbase = P.w_in + (size_t)l * 1024 * INC; sstride = INC; }
    else if (t < CT_WUQ) { m = 2; lt = t - CT_WMG; NTl = 24; K = 384; dst = (bf16_t*)(P.ws + OFF_WUQ); sbase = P.mla_w_uq + (size_t)l * 384 * 1536; sstride = 1536; kscale = P.mla_qn_g + l * 384; }
    else if (t < CT_WUKV) { m = 3; lt = t - CT_WUQ; NTl = 32; K = 256; dst = (bf16_t*)(P.ws + OFF_WUKV); sbase = P.mla_w_ukv + (size_t)l * 256 * 2048; sstride = 2048; kscale = P.mla_kvn_g + l * 256; }
    else if (t < CT_WLRU) { m = 4; lt = t - CT_WUKV; NTl = 64; K = 128; dst = (bf16_t*)(P.ws + OFF_WLRU); sbase = nullptr; sstride = 128; }
    else if (t < CT_WBR) { const int q = t - CT_WLRU; const int mm = q >> 8; m = 5; lt = q & 255; NTl = 16; K = 1024; dst = (bf16_t*)(P.ws + OFF_WBRA + (size_t)mm * (OFF_WBRB - OFF_WBRA));
      sbase = (mm == 0 ? P.w_br_a : mm == 1 ? P.w_br_b : mm == 2 ? P.w_br_c : P.w_out) + (size_t)l * 1024 * 1024; sstride = 1024; }
    else if (t < CT_WFI) { m = 6; lt = t - CT_WBR; NTl = 88; K = 1024; dst = (bf16_t*)(P.ws + OFF_WFI); sbase = P.w_ffn_in + (size_t)l * 1024 * 5632; sstride = 5632; }
    else { m = 7; lt = t - CT_WFI; NTl = 16; K = FH; dst = (bf16_t*)(P.ws + OFF_WFO); sbase = P.w_ffn_out + (size_t)l * FH * 1024; sstride = 1024; }
    const int tn = lt % NTl, tk = lt / NTl;
    const int n = tn * 64 + (tid & 15) * 4;
    int sc = n; const float* sb = sbase;
    if (m == 0) { if (n < 2048) sc = n; else if (n < 2816) { const int j = n - 2048; sc = j < 672 ? 2048 + j : -1; } else sc = 2720 + (n - 2816); }
    else if (m == 1) sc = 5792 + n;
    else if (m == 4) { const int blk = n >> 9, r = (n >> 8) & 1, q4 = (n >> 6) & 3, g32 = (n >> 5) & 1, gate = (n >> 4) & 1, cc = n & 15;
      sb = (gate ? P.lru_wi : P.lru_wa) + (((size_t)l * 2 + r) * 8 + blk) * 128 * 128; sc = q4 * 32 + g32 * 16 + cc; }
    else if (m == 6) { const int tn2 = n >> 7, c16 = (n >> 5) & 3, gate = (n >> 4) & 1, cc = n & 15; sc = gate * FH + tn2 * 64 + c16 * 16 + cc; }
    __syncthreads();
#pragma unroll
    for (int p = 0; p < 4; ++p) {
      const int kl = (tid >> 4) + 16 * p, k = tk * 64 + kl;
      f32x4 v = {0.f, 0.f, 0.f, 0.f};
      if (sc >= 0) v = *(const f32x4*)(sb + (size_t)k * sstride + sc);
      if (kscale) v = v * kscale[k];
      const int nl = (tid & 15) * 4;
      tl[(nl + 0) * 72 + kl] = f2bf(v[0]); tl[(nl + 1) * 72 + kl] = f2bf(v[1]); tl[(nl + 2) * 72 + kl] = f2bf(v[2]); tl[(nl + 3) * 72 + kl] = f2bf(v[3]);
    }
    __syncthreads();
    {
      const int nl = tid >> 2, kc = (tid & 3) * 16;
      const uint4 a = *(const uint4*)(tl + nl * 72 + kc), b2 = *(const uint4*)(tl + nl * 72 + kc + 8);
      bf16_t* d = dst + (size_t)(tn * 64 + nl) * K + tk * 64 + kc;
      *(uint4*)d = a; *(uint4*)(d + 8) = b2;
    }
  }
}
static_assert(OFF_WBRC - OFF_WBRB == OFF_WBRB - OFF_WBRA && OFF_WOUT - OFF_WBRC == OFF_WBRB - OFF_WBRA, "br weights equally spaced");

DI void norm_phase(const Params& P, int l, int half_, int which  , int nrows, int rph = 0  ) {
  const int lane = tidx() & 63, wid = tidx() >> 6;
  const float* g = (which == 0 ? P.norm1_g : P.norm2_g) + l * 1024;
  const float* MOD = (const float*)(P.ws + OFF_MOD) + (size_t)l * 9 * 6144;
  bf16_t* H = (bf16_t*)(P.ws + OFF_HBF);
  for (int grow = blockIdx.x * 4 + wid; grow < nrows; grow += gridDim.x * 4) {
    const int half = rph ? grow / rph : half_, row = rph ? grow % rph : grow;
    const RowInfo ri = rowinfo(row);
    const float* src = (which == 0 && l == 0) ? input_ptr(P, half, row) : resid_ptr(P, half, row);
    const float* md = MOD + (size_t)(ri.isctx ? 8 : half * HB + ri.bl) * 6144 + (which == 0 ? 0 : 3072);
    f32x4 v[4]; float ss = 0.f;
#pragma unroll
    for (int i = 0; i < 4; ++i) { v[i] = *(const f32x4*)(src + i * 256 + lane * 4); ss += v[i][0] * v[i][0] + v[i][1] * v[i][1] + v[i][2] * v[i][2] + v[i][3] * v[i][3]; }
#pragma unroll
    for (int o = 1; o < 64; o <<= 1) ss += __shfl_xor(ss, o);
    const float rstd = rsqrtf(ss * (1.0f / 1024.0f) + EPS);
#pragma unroll
    for (int i = 0; i < 4; ++i) {
      const int c0 = i * 256 + lane * 4;
      const f32x4 gg = *(const f32x4*)(g + c0), sh = *(const f32x4*)(md + c0), sc = *(const f32x4*)(md + 1024 + c0);
      f32x4 o;
#pragma unroll
      for (int j = 0; j < 4; ++j) o[j] = v[i][j] * rstd * gg[j] * (1.0f + sc[j]) + sh[j];
      store4bf(H + (size_t)grow * 1024 + c0, o);
    }
  }
}

DI void g1_phase(const Params& P, int l, int half, char* lds) {
  const int tid = tidx(), lane = tid & 63, wid = tid >> 6, wr = wid >> 1, wc = wid & 1, fr = lane & 15, fq = lane >> 4;
  const bf16_t* H = (const bf16_t*)(P.ws + OFF_HBF);
  const bf16_t* W = (const bf16_t*)(P.ws + OFF_WIN);
  const float* RDc = (const float*)(P.ws + OFF_RD); const float* RDs = RDc + 2048 * 32;
  constexpr int MT = MH / 128, NTL = N1 / 128;
  for (int u = blockIdx.x; u < MT * NTL; u += gridDim.x) {
    const int tn = u / MT, tm = u % MT;
    f32x4 acc[4][4]; zero_acc<4>(acc);
    gemm_core<4>(acc, H + (size_t)tm * 128 * 1024, 1024, W + (size_t)tn * 128 * 1024, 1024, 1024, lds);
    const int rowb = tm * 128 + wr * 64 + fr;
    if (tn < 8) {
      bf16_t* O = (bf16_t*)(P.ws + OFF_RX);
#pragma unroll
      for (int mi = 0; mi < 4; ++mi)
#pragma unroll
        for (int ni = 0; ni < 4; ++ni) store4bf(O + (size_t)(rowb + mi * 16) * 1024 + tn * 128 + wc * 64 + ni * 16 + fq * 4, acc[mi][ni]);
    } else if (tn < 16) {
      bf16_t* O = (bf16_t*)(P.ws + OFF_GRG);
#pragma unroll
      for (int mi = 0; mi < 4; ++mi)
#pragma unroll
        for (int ni = 0; ni < 4; ++ni) { f32x4 v = acc[mi][ni];
#pragma unroll
          for (int j = 0; j < 4; ++j) v[j] = geluf_(v[j]);
          store4bf(O + (size_t)(rowb + mi * 16) * 1024 + (tn - 8) * 128 + wc * 64 + ni * 16 + fq * 4, v); }
    } else if (tn < 22) {
      bf16_t* O = (bf16_t*)(P.ws + OFF_CQKV);
#pragma unroll
      for (int mi = 0; mi < 4; ++mi)
#pragma unroll
        for (int ni = 0; ni < 4; ++ni) store4bf(O + (size_t)(rowb + mi * 16) * 768 + (tn - 16) * 128 + wc * 64 + ni * 16 + fq * 4, acc[mi][ni]);
    } else if (tn < 38) {
      const int isk = tn >= 30; const int tl = isk ? tn - 30 : tn - 22;
      bf16_t* O = (bf16_t*)(P.ws + (isk ? OFF_DK : OFF_DQ));
      const float* g = (isk ? P.diff_k_g : P.diff_q_g) + l * 64;
#pragma unroll
      for (int mi = 0; mi < 4; ++mi) {
        const int row = rowb + mi * 16; const RowInfo ri = rowinfo(row);
        float ss = 0.f;
#pragma unroll
        for (int ni = 0; ni < 4; ++ni)
#pragma unroll
          for (int j = 0; j < 4; ++j) ss += acc[mi][ni][j] * acc[mi][ni][j];
        ss += __shfl_xor(ss, 16); ss += __shfl_xor(ss, 32);
        const float rstd = rsqrtf(ss * (1.0f / 64.0f) + EPS);
#pragma unroll
        for (int ni = 0; ni < 4; ++ni) {
          const int d0 = ni * 16 + fq * 4;
          const f32x4 gg = *(const f32x4*)(g + d0);
          f32x4 y;
#pragma unroll
          for (int j = 0; j < 4; ++j) y[j] = acc[mi][ni][j] * rstd * gg[j];
          if (!ri.isctx) {
            const int pi = d0 >> 1;
            const float c0 = RDc[ri.t * 32 + pi], s0 = RDs[ri.t * 32 + pi], c1 = RDc[ri.t * 32 + pi + 1], s1 = RDs[ri.t * 32 + pi + 1];
            const float a0 = y[0] * c0 - y[1] * s0, a1 = y[0] * s0 + y[1] * c0, a2 = y[2] * c1 - y[3] * s1, a3 = y[2] * s1 + y[3] * c1;
            y = (f32x4){a0, a1, a2, a3};
          }
          store4bf(O + (size_t)row * 1024 + tl * 128 + wc * 64 + d0, y);
        }
      }
    } else {
      bf16_t* O = (bf16_t*)(P.ws + OFF_DVT);
      const int h = tn - 38;
#pragma unroll
      for (int mi = 0; mi < 4; ++mi) {
        const int row = rowb + mi * 16; const RowInfo ri = rowinfo(row);
        const int pos = keypos(ri.isctx ? 2048 + ri.t : ri.t);
        bf16_t* ob = O + ((size_t)(ri.bl * 8 + h) * 128) * NKEY + pos;
#pragma unroll
        for (int ni = 0; ni < 4; ++ni)
#pragma unroll
          for (int j = 0; j < 4; ++j) ob[(size_t)(wc * 64 + ni * 16 + fq * 4 + j) * NKEY] = f2bf(acc[mi][ni][j]);
      }
    }
  }
}

template <int CTRL> DI float dppf(float old, float v) { return __int_as_float(__builtin_amdgcn_update_dpp(__float_as_int(old), __float_as_int(v), CTRL, 0xf, 0xf, false)); }
template <int R> DI void row_scan(float& a, float& b) {
  constexpr int B0 = R == 0 ? 0x110 : 0x100;
  { const float ap = dppf<B0 + 1>(1.0f, a), bp = dppf<B0 + 1>(0.0f, b); b = a * bp + b; a = a * ap; }
  { const float ap = dppf<B0 + 2>(1.0f, a), bp = dppf<B0 + 2>(0.0f, b); b = a * bp + b; a = a * ap; }
  { const float ap = dppf<B0 + 4>(1.0f, a), bp = dppf<B0 + 4>(0.0f, b); b = a * bp + b; a = a * ap; }
  { const float ap = dppf<B0 + 8>(1.0f, a), bp = dppf<B0 + 8>(0.0f, b); b = a * bp + b; a = a * ap; }
}
DI void conv_items(const Params& P, int l, int item0, int nitems) {
  const bf16_t* RX = (const bf16_t*)(P.ws + OFF_RX);
  bf16_t* XV = (bf16_t*)(P.ws + OFF_XCV);
  const int it = item0 + tidx();
  if (it >= nitems) return;
  const int row0 = (it >> 7) * 8, ch = (it & 127) * 8;
  const RowInfo ri = rowinfo(row0); const int Tseq = ri.isctx ? 256 : 2048;
  uint4 tv[11];
#pragma unroll
  for (int i = 0; i < 11; ++i) {
    const int tt = ri.t + i - 2; const bool ok = tt >= 0 && tt < Tseq;
    const uint4 v = *(const uint4*)(RX + (size_t)(row0 + (ok ? i - 2 : 0)) * 1024 + ch);
    tv[i] = ok ? v : make_uint4(0u, 0u, 0u, 0u);
  }
  float cwf[4][8], bias[8];
#pragma unroll
  for (int e = 0; e < 8; ++e) bias[e] = P.conv_b[l * 1024 + ch + e];
#pragma unroll
  for (int j = 0; j < 4; ++j)
#pragma unroll
    for (int e = 0; e < 8; ++e) cwf[j][e] = P.conv_w[((size_t)l * 4 + j) * 1024 + ch + e];
#pragma unroll
  for (int o = 0; o < 8; ++o) {
    float a8[8];
#pragma unroll
    for (int e = 0; e < 8; ++e) a8[e] = bias[e];
#pragma unroll
    for (int j = 0; j < 4; ++j) {
      const unsigned w[4] = {tv[o + j].x, tv[o + j].y, tv[o + j].z, tv[o + j].w};
#pragma unroll
      for (int e = 0; e < 4; ++e) { a8[2 * e] += lo2f(w[e]) * cwf[j][2 * e]; a8[2 * e + 1] += hi2f(w[e]) * cwf[j][2 * e + 1]; }
    }
    uint4 ov; ov.x = pack2(a8[0], a8[1]); ov.y = pack2(a8[2], a8[3]); ov.z = pack2(a8[4], a8[5]); ov.w = pack2(a8[6], a8[7]);
    *(uint4*)(XV + (size_t)(row0 + o) * 1024 + ch) = ov;
  }
}

template <int R>
DI void lru_seq_step(const Params& P, int l, int row0, int blk, int q4, bool need_out, float (&hcar)[4], const char* As, const char* Wsb, char* lds, int next_row0, bool has_next) {
  const int tid = tidx(), lane = tid & 63, wid = tid >> 6, wr = wid >> 1, wc = wid & 1, fr = lane & 15, fq = lane >> 4;
  float2* XW = (float2*)(lds + LDS_SEG);
  const int chq = wc * 16 + fq * 4, chg = blk * 128 + q4 * 32 + chq;
  bf16_t* TMP = (bf16_t*)(P.ws + OFF_RX);
  bf16_t* GRG = (bf16_t*)(P.ws + OFF_GRG);
  uint2 pf[4], pg[4];
  if (R == 1 && need_out) {
#pragma unroll
    for (int mi = 0; mi < 4; ++mi) { const size_t o = (size_t)(row0 + wr * 64 + mi * 16 + fr) * 1024 + chg; pf[mi] = *(const uint2*)(TMP + o); pg[mi] = *(const uint2*)(GRG + o); }
  }
  asm volatile("s_waitcnt vmcnt(0)" ::: "memory");
  __syncthreads();
  f32x4 acc[4][2]; zero_acc<2>(acc);
#pragma unroll
  for (int ks = 0; ks < 4; ++ks) {
    bf16x8 bfr[4], afr[2];
#pragma unroll
    for (int mi = 0; mi < 4; ++mi) bfr[mi] = *(const bf16x8*)(As + (wr * 64 + mi * 16 + fr) * 256 + (((ks * 4 + fq) ^ fr) * 16));
#pragma unroll
    for (int ni = 0; ni < 2; ++ni) afr[ni] = *(const bf16x8*)(Wsb + (wc * 32 + ni * 16 + fr) * 256 + (((ks * 4 + fq) ^ fr) * 16));
#pragma unroll
    for (int mi = 0; mi < 4; ++mi)
#pragma unroll
      for (int ni = 0; ni < 2; ++ni) acc[mi][ni] = __builtin_amdgcn_mfma_f32_16x16x32_bf16(afr[ni], bfr[mi], acc[mi][ni], 0, 0, 0);
  }
  float xcv[4][4];
#pragma unroll
  for (int mi = 0; mi < 4; ++mi) {
    const int tok = wr * 64 + mi * 16 + fr;
    const uint2 x2 = *(const uint2*)(As + tok * 256 + (((q4 * 4 + wc * 2 + (fq >> 1)) ^ fr) * 16) + (fq & 1) * 8);
    xcv[mi][0] = lo2f(x2.x); xcv[mi][1] = hi2f(x2.x); xcv[mi][2] = lo2f(x2.y); xcv[mi][3] = hi2f(x2.y);
  }
  float spl[4], bav[4], biv[4];
  {
    const f32x4* PRM = (const f32x4*)(lds + LDS_SEG + 1024);
#pragma unroll
    for (int j = 0; j < 4; ++j) { const f32x4 pv = PRM[R * 32 + chq + j]; spl[j] = pv[0]; bav[j] = pv[1]; biv[j] = pv[2]; }
  }
  asm volatile("s_waitcnt lgkmcnt(0)" ::: "memory");
  __syncthreads();
  if (has_next) {
    const bf16_t* XV = (const bf16_t*)(P.ws + OFF_XCV);
    const int wbase = __builtin_amdgcn_readfirstlane(wid) * 1024;
    const int xrow = tid >> 4, xsrc = (tid & 15) ^ (xrow & 15);
#pragma unroll
    for (int i = 0; i < 8; ++i) GLDS16(XV + (size_t)(next_row0 + xrow + 16 * i) * 1024 + blk * 128 + xsrc * 8, (char*)As + wbase + i * 4096);
  }
  float av[4][4], bv[4][4];
#pragma unroll
  for (int mi = 0; mi < 4; ++mi)
#pragma unroll
    for (int j = 0; j < 4; ++j) {
      const float sr = __builtin_amdgcn_rcpf(1.0f + __expf(-(acc[mi][0][j] + bav[j]))), si = __builtin_amdgcn_rcpf(1.0f + __expf(-(acc[mi][1][j] + biv[j])));
      const float la = -8.0f * sr * spl[j];
      const float a = __expf(la);
      av[mi][j] = a; bv[mi][j] = __builtin_amdgcn_sqrtf(fmaxf(0.f, 1.0f - a * a)) * si * xcv[mi][j];
    }
  const int endlane = (lane & ~15) | (R == 0 ? 15 : 0);
  float Ac[4][4], Bc[4][4], Aw[4], Bw[4];
#pragma unroll
  for (int j = 0; j < 4; ++j) { Aw[j] = 1.f; Bw[j] = 0.f; }
#pragma unroll
  for (int m = 0; m < 4; ++m) {
    const int mi = R == 0 ? m : 3 - m;
#pragma unroll
    for (int j = 0; j < 4; ++j) {
      row_scan<R>(av[mi][j], bv[mi][j]);
      const float At = __shfl(av[mi][j], endlane), Bt = __shfl(bv[mi][j], endlane);
      Ac[mi][j] = Aw[j]; Bc[mi][j] = Bw[j];
      Bw[j] = At * Bw[j] + Bt; Aw[j] = At * Aw[j];
    }
  }
  if (fr == 0) {
#pragma unroll
    for (int j = 0; j < 4; ++j) XW[wr * 32 + chq + j] = make_float2(Aw[j], Bw[j]);
  }
  asm volatile("s_waitcnt lgkmcnt(0)" ::: "memory");
  __builtin_amdgcn_s_barrier();
  asm volatile("" ::: "memory");
  const int first = R == 0 ? 0 : 1;
#pragma unroll
  for (int j = 0; j < 4; ++j) {
    const float2 e0 = XW[first * 32 + chq + j], e1 = XW[(1 - first) * 32 + chq + j];
    const float hw = (wr == first) ? hcar[j] : e0.x * hcar[j] + e0.y;
    float hout[4];
#pragma unroll
    for (int mi = 0; mi < 4; ++mi) { const float hb = Ac[mi][j] * hw + Bc[mi][j]; hout[mi] = av[mi][j] * hb + bv[mi][j]; }
#pragma unroll
    for (int mi = 0; mi < 4; ++mi) av[mi][j] = hout[mi];
    hcar[j] = e1.x * (e0.x * hcar[j] + e0.y) + e1.y;
  }
  if (need_out) {
#pragma unroll
    for (int mi = 0; mi < 4; ++mi) {
      const size_t o = (size_t)(row0 + wr * 64 + mi * 16 + fr) * 1024 + chg;
      if (R == 0) { store4bf(TMP + o, (f32x4){av[mi][0], av[mi][1], av[mi][2], av[mi][3]}); }
      else {
        const f32x4 y = {(av[mi][0] + lo2f(pf[mi].x)) * lo2f(pg[mi].x), (av[mi][1] + hi2f(pf[mi].x)) * hi2f(pg[mi].x),
                         (av[mi][2] + lo2f(pf[mi].y)) * lo2f(pg[mi].y), (av[mi][3] + hi2f(pf[mi].y)) * hi2f(pg[mi].y)};
        store4bf(GRG + o, y);
      }
    }
  }
}
DI void lru_seq_unit(const Params& P, int l, int u, char* lds) {
  const int tid = tidx(), wid = tid >> 6;
  const int bl = u >> 5, blk = (u >> 2) & 7, q4 = u & 3;
  const bf16_t* WL = (const bf16_t*)(P.ws + OFF_WLRU);
  const bf16_t* XV = (const bf16_t*)(P.ws + OFF_XCV);
  char* As = lds;
  char* Wb = lds + 32768;
  __syncthreads();
  const int wbase = __builtin_amdgcn_readfirstlane(wid) * 1024;
  {
    const int wrow = tid >> 4, wsrc = (tid & 15) ^ (wrow & 15);
#pragma unroll
    for (int r = 0; r < 2; ++r) {
      const bf16_t* ws_ = WL + (size_t)(blk * 512 + r * 256 + q4 * 64 + wrow) * 128 + wsrc * 8;
#pragma unroll
      for (int i = 0; i < 4; ++i) GLDS16(ws_ + (size_t)(16 * i) * 128, Wb + r * 16384 + wbase + i * 4096);
    }
    if (tid < 64) {
      const int r = tid >> 5, c = tid & 31, ch = blk * 128 + q4 * 32 + c;
      const float lm = P.lru_lambda[(l * 2 + r) * 1024 + ch];
      const float sp_ = (lm > 15.f) ? __expf(-lm) : log1pf(__expf(-lm));
      ((f32x4*)(lds + LDS_SEG + 1024))[tid] = (f32x4){sp_, P.lru_ba[(l * 2 + r) * 1024 + ch], P.lru_bi[(l * 2 + r) * 1024 + ch], 0.f};
    }
    const int xrow = tid >> 4, xsrc = (tid & 15) ^ (xrow & 15);
    const int r0 = ML + bl * 256;
#pragma unroll
    for (int i = 0; i < 8; ++i) GLDS16(XV + (size_t)(r0 + xrow + 16 * i) * 1024 + blk * 128 + xsrc * 8, As + wbase + i * 4096);
  }
  const bool ctx_out = (l == 0);
  float hcar[4] = {0.f, 0.f, 0.f, 0.f};
  for (int s = 0; s < 18; ++s) {
    const int row0 = s < 2 ? ML + bl * 256 + s * 128 : bl * 2048 + (s - 2) * 128;
    const int sn = s + 1;
    const int nrow0 = sn < 18 ? (sn < 2 ? ML + bl * 256 + sn * 128 : bl * 2048 + (sn - 2) * 128) : ML + bl * 256 + 128;
    lru_seq_step<0>(P, l, row0, blk, q4, s >= 2 || ctx_out, hcar, As, Wb, lds, nrow0, true);
  }
#pragma unroll
  for (int j = 0; j < 4; ++j) hcar[j] = 0.f;
  for (int s = 0; s < 18; ++s) {
    const int row0 = s < 2 ? ML + bl * 256 + (1 - s) * 128 : bl * 2048 + (15 - (s - 2)) * 128;
    const int sn = s + 1;
    const int nrow0 = sn < 2 ? ML + bl * 256 + (1 - sn) * 128 : bl * 2048 + (15 - (sn - 2)) * 128;
    lru_seq_step<1>(P, l, row0, blk, q4, s >= 2 || ctx_out, hcar, As, Wb + 16384, lds, nrow0, sn < 18);
  }
  asm volatile("s_waitcnt vmcnt(0)" ::: "memory");
  __syncthreads();
}

DI void pc_phase(const Params& P, int l, int half, char* lds) {
  const int tid = tidx(), lane = tid & 63, wid = tid >> 6, wr = wid >> 1, wc = wid & 1, fr = lane & 15, fq = lane >> 4;
  constexpr int MT = MH / 128;
  constexpr int NU_LRU = (MH / 8) * 128 / 256, NU_UQ = MT * 12, NU_UKV = MT * 16;
  const bf16_t* CQKV = (const bf16_t*)(P.ws + OFF_CQKV);
  const float* rs = (const float*)(lds + LDS_RS);
  const float* RMc = (const float*)(P.ws + OFF_RM); const float* RMs = RMc + 2048 * 16;
  for (int u = blockIdx.x; u < NU_LRU + NU_UQ + NU_UKV; u += gridDim.x) {
    if (u < NU_LRU) { conv_items(P, l, u * 256, (MH / 8) * 128); continue; }
    if (u < NU_LRU + NU_UQ) {
      const int v = u - NU_LRU, tn = v / MT, tm = v % MT;
      const bf16_t* A = CQKV + (size_t)tm * 128 * 768;
      __syncthreads();
      f32x4 acc[4][4]; zero_acc<4>(acc);
      gemm_core<4, 384>(acc, A, 768, (const bf16_t*)(P.ws + OFF_WUQ) + (size_t)tn * 128 * 384, 384, 384, lds);
      bf16_t* O = (bf16_t*)(P.ws + OFF_QM);
#pragma unroll
      for (int mi = 0; mi < 4; ++mi) {
        const int rl = wr * 64 + mi * 16 + fr; const float s = rs[rl];
#pragma unroll
        for (int ni = 0; ni < 4; ++ni) store4bf(O + (size_t)(tm * 128 + rl) * 1536 + tn * 128 + wc * 64 + ni * 16 + fq * 4, acc[mi][ni] * s);
      }
    } else {
      const int v = u - NU_LRU - NU_UQ, h = v / MT, tm = v % MT;
      const bf16_t* A = CQKV + (size_t)tm * 128 * 768 + 384;
      __syncthreads();
      f32x4 acc[4][4]; zero_acc<4>(acc);
      gemm_core<4, 256>(acc, A, 768, (const bf16_t*)(P.ws + OFF_WUKV) + (size_t)h * 128 * 256, 256, 256, lds);
      if (wc == 0) {
        bf16_t* O = (bf16_t*)(P.ws + OFF_KM);
        const float* kg = P.mla_k_g + l * 96;
#pragma unroll
        for (int mi = 0; mi < 4; ++mi) {
          const int rl = wr * 64 + mi * 16 + fr, row = tm * 128 + rl; const float s = rs[rl]; const RowInfo ri = rowinfo(row);
          const uint4 kr = *(const uint4*)(CQKV + (size_t)row * 768 + 640 + fq * 8);
          float k8[8] = {lo2f(kr.x), hi2f(kr.x), lo2f(kr.y), hi2f(kr.y), lo2f(kr.z), hi2f(kr.z), lo2f(kr.w), hi2f(kr.w)};
          float ss = 0.f;
#pragma unroll
          for (int e = 0; e < 8; ++e) ss += k8[e] * k8[e];
          f32x4 vv[4];
#pragma unroll
          for (int ni = 0; ni < 4; ++ni) { vv[ni] = acc[mi][ni] * s;
#pragma unroll
            for (int j = 0; j < 4; ++j) ss += vv[ni][j] * vv[ni][j]; }
          ss += __shfl_xor(ss, 16); ss += __shfl_xor(ss, 32);
          const float rstd = rsqrtf(ss * (1.0f / 96.0f) + EPS);
          bf16_t* orow = O + (size_t)row * 1536 + h * 96;
#pragma unroll
          for (int ni = 0; ni < 4; ++ni) { const int d0 = ni * 16 + fq * 4; const f32x4 gg = *(const f32x4*)(kg + d0); store4bf(orow + d0, vv[ni] * rstd * gg); }
#pragma unroll
          for (int e = 0; e < 8; ++e) k8[e] *= rstd * kg[64 + fq * 8 + e];
          if (!ri.isctx) {
#pragma unroll
            for (int e = 0; e < 4; ++e) {
              const int pi = fq * 4 + e; const float c = RMc[ri.t * 16 + pi], sn = RMs[ri.t * 16 + pi];
              const float x1 = k8[2 * e], x2 = k8[2 * e + 1]; k8[2 * e] = x1 * c - x2 * sn; k8[2 * e + 1] = x1 * sn + x2 * c;
            }
          }
          uint4 o; o.x = pack2(k8[0], k8[1]); o.y = pack2(k8[2], k8[3]); o.z = pack2(k8[4], k8[5]); o.w = pack2(k8[6], k8[7]);
          *(uint4*)(orow + 64 + fq * 8) = o;
        }
      } else {
        bf16_t* O = (bf16_t*)(P.ws + OFF_VMT);
#pragma unroll
        for (int mi = 0; mi < 4; ++mi) {
          const int rl = wr * 64 + mi * 16 + fr, row = tm * 128 + rl; const float s = rs[rl]; const RowInfo ri = rowinfo(row);
          const int pos = keypos(ri.isctx ? 2048 + ri.t : ri.t);
          bf16_t* ob = O + ((size_t)(ri.bl * 16 + h) * 64) * NKEY + pos;
#pragma unroll
          for (int ni = 0; ni < 4; ++ni)
#pragma unroll
            for (int j = 0; j < 4; ++j) ob[(size_t)(ni * 16 + fq * 4 + j) * NKEY] = f2bf(acc[mi][ni][j] * s);
        }
      }
    }
  }
}

struct QFrag { bf16x8 f0, f1, f2, f3, f4, f5; };
template <int KS> DI bf16x8 mla_qfrag(uint4 v, float rstd, const float* qg, int hh, int isctx, int t, const float* RMc, const float* RMs, float qscale) {
  float q[8] = {lo2f(v.x), hi2f(v.x), lo2f(v.y), hi2f(v.y), lo2f(v.z), hi2f(v.z), lo2f(v.w), hi2f(v.w)};
#pragma unroll
  for (int e = 0; e < 8; ++e) q[e] *= rstd * qg[KS * 16 + hh * 8 + e];
  if constexpr (KS >= 4) {
#pragma unroll
    for (int e = 0; e < 4; ++e) {
      const int pi = (KS - 4) * 8 + hh * 4 + e; const float c = isctx ? 1.0f : RMc[t * 16 + pi], sn = isctx ? 0.0f : RMs[t * 16 + pi];
      const float x1 = q[2 * e], x2 = q[2 * e + 1]; q[2 * e] = x1 * c - x2 * sn; q[2 * e + 1] = x1 * sn + x2 * c;
    }
  }
  uint4 w; w.x = pack2(q[0] * qscale, q[1] * qscale); w.y = pack2(q[2] * qscale, q[3] * qscale); w.z = pack2(q[4] * qscale, q[5] * qscale); w.w = pack2(q[6] * qscale, q[7] * qscale);
  return __builtin_bit_cast(bf16x8, w);
}
DI bf16x8 scale_qfrag(uint4 v, float qscale) {
  uint4 w; w.x = pack2(lo2f(v.x) * qscale, hi2f(v.x) * qscale); w.y = pack2(lo2f(v.y) * qscale, hi2f(v.y) * qscale);
  w.z = pack2(lo2f(v.z) * qscale, hi2f(v.z) * qscale); w.w = pack2(lo2f(v.w) * qscale, hi2f(v.w) * qscale);
  return __builtin_bit_cast(bf16x8, w);
}
template <int DK, int DV>
DI void attn_prestage(const bf16_t* __restrict__ Kb, int kstride, const bf16_t* __restrict__ Vt, int bl, int kt0, char* lds) {
  constexpr int KROW = (DK == 96) ? 256 : 128;
  constexpr int STG = 64 * KROW + DV * 128;
  const int tid = tidx();
  const int wbase = __builtin_amdgcn_readfirstlane(tid >> 6) * 1024;
  const int vrow = tid >> 3, vsrc = (tid & 7) ^ ((vrow >> 1) & 7);
  const int krow = (DK == 96) ? (tid >> 4) : (tid >> 3);
  const int ksrc = (DK == 96) ? ((tid & 15) ^ (krow & 15)) : ((tid & 7) ^ ((krow >> 1) & 7));
  __syncthreads();
#pragma unroll
  for (int s = 0; s < 2; ++s) {
    const int kt_ = kt0 + s; const int keyrow0 = kt_ < 32 ? bl * 2048 + kt_ * 64 : ML + bl * 256 + (kt_ - 32) * 64;
    char* kd_ = lds + s * STG + wbase; char* vd_ = kd_ + 64 * KROW;
    if (DK == 96) { if (ksrc < 12) {
#pragma unroll
        for (int i = 0; i < 4; ++i) GLDS16(Kb + (size_t)(keyrow0 + krow + 16 * i) * kstride + ksrc * 8, kd_ + i * 4096); } }
    else {
#pragma unroll
      for (int i = 0; i < 2; ++i) GLDS16(Kb + (size_t)(keyrow0 + krow + 32 * i) * kstride + ksrc * 8, kd_ + i * 4096); }
#pragma unroll
    for (int i = 0; i < DV / 32; ++i) GLDS16(Vt + (size_t)(vrow + 32 * i) * NKEY + kt_ * 64 + vsrc * 8, vd_ + i * 4096);
  }
}
template <int DK, int DV, bool PRE = false>
DI void attn_stream(f32x16 (&O)[DV / 32], float& lsum, const QFrag& qf, const bf16_t* __restrict__ Kb, int kstride, const bf16_t* __restrict__ Vt,
                    int bl, int kt0, int kt1, char* lds) {
  constexpr int KROW = (DK == 96) ? 256 : 128;
  constexpr int STG = 64 * KROW + DV * 128;
  const int tid = tidx(), lane = tid & 63, r = lane & 31, hh = lane >> 5;
  const int wbase = __builtin_amdgcn_readfirstlane(tid >> 6) * 1024;
  const int vrow = tid >> 3, vsrc = (tid & 7) ^ ((vrow >> 1) & 7);
  const int krow = (DK == 96) ? (tid >> 4) : (tid >> 3);
  const int ksrc = (DK == 96) ? ((tid & 15) ^ (krow & 15)) : ((tid & 7) ^ ((krow >> 1) & 7));
#define ATT_STAGE(KT, BUF) do { const int kt_ = (KT); const int keyrow0 = kt_ < 32 ? bl * 2048 + kt_ * 64 : ML + bl * 256 + (kt_ - 32) * 64; \
    char* kd_ = lds + (BUF) * STG + wbase; char* vd_ = kd_ + 64 * KROW; \
    if (DK == 96) { if (ksrc < 12) { _Pragma("unroll") for (int i = 0; i < 4; ++i) GLDS16(Kb + (size_t)(keyrow0 + krow + 16 * i) * kstride + ksrc * 8, kd_ + i * 4096); } } \
    else { _Pragma("unroll") for (int i = 0; i < 2; ++i) GLDS16(Kb + (size_t)(keyrow0 + krow + 32 * i) * kstride + ksrc * 8, kd_ + i * 4096); } \
    _Pragma("unroll") for (int i = 0; i < DV / 32; ++i) GLDS16(Vt + (size_t)(vrow + 32 * i) * NKEY + kt_ * 64 + vsrc * 8, vd_ + i * 4096); } while (0)
  float mrun = -1e30f; lsum = 0.f;
#pragma unroll
  for (int b = 0; b < DV / 32; ++b)
#pragma unroll
    for (int i = 0; i < 16; ++i) O[b][i] = 0.f;
  if (!PRE) { __syncthreads(); ATT_STAGE(kt0, 0); ATT_STAGE(kt0 + 1, 1); }
  int buf = 0, nbuf = 2;
  for (int kt = kt0; kt < kt1; ++kt) {
    if (kt + 1 < kt1) asm volatile("s_waitcnt vmcnt(6)" ::: "memory"); else asm volatile("s_waitcnt vmcnt(0)" ::: "memory");
    asm volatile("s_waitcnt lgkmcnt(0)" ::: "memory");
    __builtin_amdgcn_s_barrier();
    asm volatile("" ::: "memory");
    if (kt + 2 < kt1) ATT_STAGE(kt + 2, nbuf);
    const char* ks_ = lds + buf * STG; const char* vs_ = ks_ + 64 * KROW;
    f32x16 S[2];
    {
      const char* kp0 = ks_ + r * KROW; const char* kp1 = kp0 + 32 * KROW;
      const int ksw = (DK == 96) ? (r & 15) : ((r >> 1) & 7);
      constexpr int NKS = DK / 16;
      bf16x8 ka[NKS], kc[NKS];
#pragma unroll
      for (int i = 0; i < NKS; ++i) { const int co = ((i * 2 + hh) ^ ksw) * 16; ka[i] = *(const bf16x8*)(kp0 + co); kc[i] = *(const bf16x8*)(kp1 + co); }
      f32x16 zc;
#pragma unroll
      for (int i = 0; i < 16; ++i) zc[i] = 0.f;
      S[0] = __builtin_amdgcn_mfma_f32_32x32x16_bf16(ka[0], qf.f0, zc, 0, 0, 0);
      S[1] = __builtin_amdgcn_mfma_f32_32x32x16_bf16(kc[0], qf.f0, zc, 0, 0, 0);
#define QK_STEP(i) S[0] = __builtin_amdgcn_mfma_f32_32x32x16_bf16(ka[i], qf.f##i, S[0], 0, 0, 0); S[1] = __builtin_amdgcn_mfma_f32_32x32x16_bf16(kc[i], qf.f##i, S[1], 0, 0, 0)
      QK_STEP(1); QK_STEP(2); QK_STEP(3);
      if constexpr (DK == 96) { QK_STEP(4); QK_STEP(5); }
#undef QK_STEP
    }
    bf16x8 vpre[DV / 32][2];
#pragma unroll
    for (int b = 0; b < DV / 32; ++b)
#pragma unroll
      for (int s = 0; s < 2; ++s) vpre[b][s] = *(const bf16x8*)(vs_ + (b * 32 + r) * 128 + (((0 * 4 + s * 2 + hh) ^ ((r >> 1) & 7)) * 16));
    float mx = S[0][0];
#pragma unroll
    for (int kb = 0; kb < 2; ++kb)
#pragma unroll
      for (int i = 0; i < 16; ++i) mx = fmaxf(mx, S[kb][i]);
    { const auto sw_ = __builtin_amdgcn_permlane32_swap(__float_as_uint(mx), __float_as_uint(mx), false, false); mx = fmaxf(__uint_as_float(sw_[0]), __uint_as_float(sw_[1])); }
    const float mnew = fmaxf(mrun, mx);
    const float alpha = __builtin_amdgcn_exp2f(mrun - mnew);
    mrun = mnew;
    f32x2n psa = {0.f, 0.f}, psb = {0.f, 0.f};
    const f32x2n m2 = {mnew, mnew};
#pragma unroll
    for (int kb = 0; kb < 2; ++kb)
#pragma unroll
      for (int i = 0; i < 16; i += 4) {
        const f32x2n d0 = (f32x2n){S[kb][i], S[kb][i + 1]} - m2, d1 = (f32x2n){S[kb][i + 2], S[kb][i + 3]} - m2;
        const f32x2n e0 = {__builtin_amdgcn_exp2f(d0[0]), __builtin_amdgcn_exp2f(d0[1])}, e1 = {__builtin_amdgcn_exp2f(d1[0]), __builtin_amdgcn_exp2f(d1[1])};
        S[kb][i] = e0[0]; S[kb][i + 1] = e0[1]; S[kb][i + 2] = e1[0]; S[kb][i + 3] = e1[1];
        psa += e0; psb += e1;
      }
    lsum = lsum * alpha + ((psa[0] + psa[1]) + (psb[0] + psb[1]));
#pragma unroll
    for (int b = 0; b < DV / 32; ++b) O[b] = O[b] * alpha;
#pragma unroll
    for (int kb = 0; kb < 2; ++kb)
#pragma unroll
      for (int s = 0; s < 2; ++s) {
        uint4 pw; pw.x = pack2(S[kb][8 * s], S[kb][8 * s + 1]); pw.y = pack2(S[kb][8 * s + 2], S[kb][8 * s + 3]);
        pw.z = pack2(S[kb][8 * s + 4], S[kb][8 * s + 5]); pw.w = pack2(S[kb][8 * s + 6], S[kb][8 * s + 7]);
        const bf16x8 pf = __builtin_bit_cast(bf16x8, pw);
#pragma unroll
        for (int b = 0; b < DV / 32; ++b) {
          const bf16x8 vf = (kb == 0) ? vpre[b][s] : *(const bf16x8*)(vs_ + (b * 32 + r) * 128 + (((kb * 4 + s * 2 + hh) ^ ((r >> 1) & 7)) * 16));
          O[b] = __builtin_amdgcn_mfma_f32_32x32x16_bf16(vf, pf, O[b], 0, 0, 0);
        }
      }
    buf = (buf == 2) ? 0 : buf + 1; nbuf = (nbuf == 2) ? 0 : nbuf + 1;
  }
  __syncthreads();
}

DI void mla_unit(const Params& P, int l, int bl, int h, int qt, char* lds) {
  const int lane = tidx() & 63, wid = tidx() >> 6, r = lane & 31, hh = lane >> 5;
  const int isctx = qt >= 16;
  const int row = (isctx ? ML + bl * 256 + (qt - 16) * 128 : bl * 2048 + qt * 128) + wid * 32 + r;
  const int t = isctx ? 0 : qt * 128 + wid * 32 + r;
  attn_prestage<96, 64>((const bf16_t*)(P.ws + OFF_KM) + h * 96, 1536, (const bf16_t*)(P.ws + OFF_VMT) + ((size_t)(bl * 16 + h) * 64) * NKEY, bl, isctx ? 32 : 0, lds);
  const bf16_t* qp = (const bf16_t*)(P.ws + OFF_QM) + (size_t)row * 1536 + h * 96;
  const float* qg = P.mla_q_g + l * 96;
  const float* RMc = (const float*)(P.ws + OFF_RM); const float* RMs = RMc + 2048 * 16;
  const uint4 r0 = *(const uint4*)(qp + 0 * 16 + hh * 8), r1 = *(const uint4*)(qp + 1 * 16 + hh * 8), r2 = *(const uint4*)(qp + 2 * 16 + hh * 8),
              r3 = *(const uint4*)(qp + 3 * 16 + hh * 8), r4 = *(const uint4*)(qp + 4 * 16 + hh * 8), r5 = *(const uint4*)(qp + 5 * 16 + hh * 8);
  float ss = ssq8(r0) + ssq8(r1) + ssq8(r2) + ssq8(r3) + ssq8(r4) + ssq8(r5);
  ss += __shfl_xor(ss, 32);
  const float rstd = rsqrtf(ss * (1.0f / 96.0f) + EPS);
  const float qscale = 0.10206207261596577f * LOG2E;
  QFrag qf;
  qf.f0 = mla_qfrag<0>(r0, rstd, qg, hh, isctx, t, RMc, RMs, qscale); qf.f1 = mla_qfrag<1>(r1, rstd, qg, hh, isctx, t, RMc, RMs, qscale);
  qf.f2 = mla_qfrag<2>(r2, rstd, qg, hh, isctx, t, RMc, RMs, qscale); qf.f3 = mla_qfrag<3>(r3, rstd, qg, hh, isctx, t, RMc, RMs, qscale);
  qf.f4 = mla_qfrag<4>(r4, rstd, qg, hh, isctx, t, RMc, RMs, qscale); qf.f5 = mla_qfrag<5>(r5, rstd, qg, hh, isctx, t, RMc, RMs, qscale);
  f32x16 O[2]; float lsum;
  attn_stream<96, 64, true>(O, lsum, qf, (const bf16_t*)(P.ws + OFF_KM) + h * 96, 1536, (const bf16_t*)(P.ws + OFF_VMT) + ((size_t)(bl * 16 + h) * 64) * NKEY, bl, isctx ? 32 : 0, 36, lds);
  lsum += __shfl_xor(lsum, 32);
  const float inv = 1.0f / lsum;
  bf16_t* op = (bf16_t*)(P.ws + OFF_OB) + (size_t)row * 1024 + h * 64;
#pragma unroll
  for (int b = 0; b < 2; ++b)
#pragma unroll
    for (int g = 0; g < 4; ++g) {
      const f32x4 v = {O[b][4 * g] * inv, O[b][4 * g + 1] * inv, O[b][4 * g + 2] * inv, O[b][4 * g + 3] * inv};
      store4bf(op + b * 32 + 8 * g + 4 * hh, v);
    }
}

DI void diff_unit(const Params& P, int l, int bl, int h, int qt, char* lds) {
  const int lane = tidx() & 63, wid = tidx() >> 6, r = lane & 31, hh = lane >> 5;
  const int isctx = qt >= 16;
  const int row = (isctx ? ML + bl * 256 + (qt - 16) * 128 : bl * 2048 + qt * 128) + wid * 32 + r;
  bf16_t* qp = (bf16_t*)(P.ws + OFF_DQ) + (size_t)row * 1024 + h * 128;
  const bf16_t* Vt = (const bf16_t*)(P.ws + OFF_DVT) + ((size_t)(bl * 8 + h) * 128) * NKEY;
  const float qscale = 0.125f * LOG2E;
  const float lam = ((const float*)(P.ws + OFF_LAM))[l];
  f32x16 O[4]; float lsum;
  attn_prestage<64, 128>((const bf16_t*)(P.ws + OFF_DK) + h * 128, 1024, Vt, bl, isctx ? 32 : 0, lds);
  QFrag qa, qb;
  qa.f0 = scale_qfrag(*(const uint4*)(qp + 0 * 16 + hh * 8), qscale); qa.f1 = scale_qfrag(*(const uint4*)(qp + 1 * 16 + hh * 8), qscale);
  qa.f2 = scale_qfrag(*(const uint4*)(qp + 2 * 16 + hh * 8), qscale); qa.f3 = scale_qfrag(*(const uint4*)(qp + 3 * 16 + hh * 8), qscale);
  qa.f4 = qa.f0; qa.f5 = qa.f0;
  qb.f0 = scale_qfrag(*(const uint4*)(qp + 64 + 0 * 16 + hh * 8), qscale); qb.f1 = scale_qfrag(*(const uint4*)(qp + 64 + 1 * 16 + hh * 8), qscale);
  qb.f2 = scale_qfrag(*(const uint4*)(qp + 64 + 2 * 16 + hh * 8), qscale); qb.f3 = scale_qfrag(*(const uint4*)(qp + 64 + 3 * 16 + hh * 8), qscale);
  qb.f4 = qb.f0; qb.f5 = qb.f0;
  attn_stream<64, 128, true>(O, lsum, qa, (const bf16_t*)(P.ws + OFF_DK) + h * 128, 1024, Vt, bl, isctx ? 32 : 0, 36, lds);
  attn_prestage<64, 128>((const bf16_t*)(P.ws + OFF_DK) + h * 128 + 64, 1024, Vt, bl, isctx ? 32 : 0, lds);
  lsum += __shfl_xor(lsum, 32);
  {
    const float inv = 1.0f / lsum;
#pragma unroll
    for (int b = 0; b < 4; ++b)
#pragma unroll
      for (int g = 0; g < 4; ++g) {
        const f32x4 v = {O[b][4 * g] * inv, O[b][4 * g + 1] * inv, O[b][4 * g + 2] * inv, O[b][4 * g + 3] * inv};
        store4bf(qp + b * 32 + 8 * g + 4 * hh, v);
      }
  }
  attn_stream<64, 128, true>(O, lsum, qb, (const bf16_t*)(P.ws + OFF_DK) + h * 128 + 64, 1024, Vt, bl, isctx ? 32 : 0, 36, lds);
  lsum += __shfl_xor(lsum, 32);
  {
    const float inv = lam / lsum;
    float ss = 0.f;
#pragma unroll
    for (int b = 0; b < 4; ++b)
#pragma unroll
      for (int g = 0; g < 4; ++g) {
        const uint2 w = *(const uint2*)(qp + b * 32 + 8 * g + 4 * hh);
        const float a0 = lo2f(w.x) - O[b][4 * g] * inv, a1 = hi2f(w.x) - O[b][4 * g + 1] * inv, a2 = lo2f(w.y) - O[b][4 * g + 2] * inv, a3 = hi2f(w.y) - O[b][4 * g + 3] * inv;
        O[b][4 * g] = a0; O[b][4 * g + 1] = a1; O[b][4 * g + 2] = a2; O[b][4 * g + 3] = a3;
        ss += a0 * a0 + a1 * a1 + a2 * a2 + a3 * a3;
      }
    ss += __shfl_xor(ss, 32);
    const float rstd = rsqrtf(ss * (1.0f / 128.0f) + EPS) * (1.0f - lam_init_of(l));
    const float* sg = P.diff_subln_g + l * 128;
#pragma unroll
    for (int b = 0; b < 4; ++b)
#pragma unroll
      for (int g = 0; g < 4; ++g) {
        const int dv0 = b * 32 + 8 * g + 4 * hh;
        const f32x4 gg = *(const f32x4*)(sg + dv0);
        const f32x4 v = {O[b][4 * g] * rstd * gg[0], O[b][4 * g + 1] * rstd * gg[1], O[b][4 * g + 2] * rstd * gg[2], O[b][4 * g + 3] * rstd * gg[3]};
        store4bf(qp + dv0, v);
      }
  }
}

DI void pd_phase(const Params& P, int l, int half, int ph, char* lds) {
  const int nq_ctx = (l == 0) ? 2 : 0;
  const int n_dl = HB * 8 * 16, n_lru = HB * 8 * 4, n_ml = HB * 16 * 16, n_dc = HB * 8 * nq_ctx, n_mc = HB * 16 * nq_ctx;
  const int tot = n_dl + n_lru + n_ml + n_dc + n_mc;
  unsigned* ctr = (unsigned*)(P.ws + OFF_CTR) + ph * 8;
  volatile int* slot = (volatile int*)(lds + LDS_BAR + 8);
  const int myx = (int)((unsigned)__builtin_amdgcn_s_getreg((3 << 11) | 20) & 7u);
  for (;;) {
    __syncthreads();
    if (threadIdx.x == 0) {
      int got = -1;
      for (int y = 0; y < 8 && got < 0; ++y) {
        const int xx = (myx + y) & 7;
        const int i = (int)__hip_atomic_fetch_add(ctr + xx, 1u, __ATOMIC_RELAXED, __HIP_MEMORY_SCOPE_AGENT);
        const int uu = i * 8 + xx;
        if (uu < tot) got = uu;
      }
      *slot = got;
    }
    __syncthreads();
    const int u = *slot;
    if (u < 0) break;
    int v = u, kind, bl = 0, h = 0, qt = 0;
    if (v < n_dl) { kind = 0; const int x = v & 7, s = (v >> 3) & 63, rnd = v >> 9; const int g = x + 8 * ((s >> 4) + 4 * rnd); qt = s & 15; bl = g >> 3; h = g & 7; }
    else if ((v -= n_dl) < n_lru) { kind = 2; }
    else if ((v -= n_lru) < n_ml) { kind = 1; const int x = v & 7, s = (v >> 3) & 63, rnd = v >> 9; const int g = x + 8 * ((s >> 4) + 4 * rnd); qt = s & 15; bl = g >> 4; h = g & 15; }
    else if ((v -= n_ml) < n_dc) { kind = 0; bl = v >> 4; h = (v >> 1) & 7; qt = 16 + (v & 1); }
    else { v -= n_dc; kind = 1; bl = v >> 5; h = (v >> 1) & 15; qt = 16 + (v & 1); }
#ifndef NO_DIFF
    if (kind == 0) diff_unit(P, l, bl, h, qt, lds);
#endif
#ifndef NO_MLA
    if (kind == 1) mla_unit(P, l, bl, h, qt, lds);
#endif
#ifndef NO_LRUF
    if (kind == 2) lru_seq_unit(P, l, v, lds);
#endif
  }
}

DI void merge_phase(const Params& P, int l, int half, int MT, char* lds) {
  const int tid = tidx(), lane = tid & 63, wid = tid >> 6, wr = wid >> 1, wc = wid & 1, fr = lane & 15, fq = lane >> 4;
  const bf16_t* H = (const bf16_t*)(P.ws + OFF_HBF);
  bf16_t* Z = (bf16_t*)(P.ws + OFF_RX);
  for (int u = blockIdx.x; u < MT * 16; u += gridDim.x) {
    const int tn = u / MT, tm = u % MT, n0 = tn * 64;
    f32x4 z[4][2]; zero_acc<2>(z);
#pragma unroll 1
    for (int br = 0; br < 3; ++br) {
      const bf16_t* Ab = (const bf16_t*)(P.ws + (br == 0 ? OFF_GRG : br == 1 ? OFF_OB : OFF_DQ));
      const bf16_t* Wb = (const bf16_t*)(P.ws + OFF_WBRA + (size_t)br * (OFF_WBRB - OFF_WBRA));
      f32x4 g[4][2]; zero_acc<2>(g);
      gemm_core<2>(g, H + (size_t)tm * 128 * 1024, 1024, (const bf16_t*)(P.ws + OFF_WMG) + (size_t)(br * 1024 + n0) * 1024, 1024, 1024, lds);
#pragma unroll
      for (int mi = 0; mi < 4; ++mi)
#pragma unroll
        for (int ni = 0; ni < 2; ++ni)
#pragma unroll
          for (int j = 0; j < 4; ++j) g[mi][ni][j] = sigmoidf_(g[mi][ni][j]);
      f32x4 v[4][2]; zero_acc<2>(v);
      gemm_core<2>(v, Ab + (size_t)tm * 128 * 1024, 1024, Wb + (size_t)n0 * 1024, 1024, 1024, lds);
#pragma unroll
      for (int mi = 0; mi < 4; ++mi)
#pragma unroll
        for (int ni = 0; ni < 2; ++ni) z[mi][ni] += g[mi][ni] * v[mi][ni];
    }
#pragma unroll
    for (int mi = 0; mi < 4; ++mi)
#pragma unroll
      for (int ni = 0; ni < 2; ++ni) store4bf(Z + (size_t)(tm * 128 + wr * 64 + mi * 16 + fr) * 1024 + n0 + wc * 32 + ni * 16 + fq * 4, z[mi][ni]);
  }
}

DI void resid_gemm_phase(const Params& P, int l, int half_, int MT, const bf16_t* A, int K, const bf16_t* W, int goff, bool src_is_input, char* lds, int rph = 0) {
  const int tid = tidx(), lane = tid & 63, wid = tid >> 6, wr = wid >> 1, wc = wid & 1, fr = lane & 15, fq = lane >> 4;
  const float* MOD = (const float*)(P.ws + OFF_MOD) + (size_t)l * 9 * 6144 + goff;
  for (int u = blockIdx.x; u < MT * 16; u += gridDim.x) {
    const int L_ = u >> 3, tm = (u & 7) + 8 * (L_ >> 4), tn = L_ & 15, n0 = tn * 64;
    f32x4 acc[4][2]; zero_acc<2>(acc);
    gemm_core<2>(acc, A + (size_t)tm * 128 * K, K, W + (size_t)n0 * K, K, K, lds);
#pragma unroll
    for (int mi = 0; mi < 4; ++mi) {
      const int grow = tm * 128 + wr * 64 + mi * 16 + fr;
      const int half = rph ? grow / rph : half_, row = rph ? grow % rph : grow; const RowInfo ri = rowinfo(row);
      const float* md = MOD + (size_t)(ri.isctx ? 8 : half * HB + ri.bl) * 6144;
      float* dst = resid_ptr(P, half, row);
      const float* src = src_is_input ? input_ptr(P, half, row) : dst;
#pragma unroll
      for (int ni = 0; ni < 2; ++ni) {
        const int c0 = n0 + wc * 32 + ni * 16 + fq * 4;
        const f32x4 gt = *(const f32x4*)(md + c0), sv = *(const f32x4*)(src + c0);
        *(f32x4*)(dst + c0) = sv + gt * acc[mi][ni];
      }
    }
  }
}

DI void ffn_in_phase(const Params& P, int l, int half, int MT, char* lds) {
  const int tid = tidx(), lane = tid & 63, wid = tid >> 6, wr = wid >> 1, wc = wid & 1, fr = lane & 15, fq = lane >> 4;
  const bf16_t* H = (const bf16_t*)(P.ws + OFF_HBF);
  bf16_t* HH = (bf16_t*)(P.ws + OFF_DQ);
  for (int u = blockIdx.x; u < MT * 44; u += gridDim.x) {
    const int tn = u / MT, tm = u % MT;
    f32x4 acc[4][4]; zero_acc<4>(acc);
    gemm_core<4>(acc, H + (size_t)tm * 128 * 1024, 1024, (const bf16_t*)(P.ws + OFF_WFI) + (size_t)tn * 128 * 1024, 1024, 1024, lds);
#pragma unroll
    for (int mi = 0; mi < 4; ++mi) {
      const int row = tm * 128 + wr * 64 + mi * 16 + fr;
#pragma unroll
      for (int q = 0; q < 2; ++q) {
        f32x4 v;
#pragma unroll
        for (int j = 0; j < 4; ++j) v[j] = siluf_(acc[mi][2 * q][j]) * acc[mi][2 * q + 1][j];
        store4bf(HH + (size_t)row * FH + tn * 64 + (wc * 2 + q) * 16 + fq * 4, v);
      }
    }
  }
}

#define XB_TMO      128
#define XB_XCNT(j)  (256  + 64 * (j))
#define XB_XSUB(j)  (1280 + 64 * (j))
#define XB_XGEN(j)  (2304 + 64 * (j))
#define XB_TOP      3328
#define XB_TOPGEN   3392
#define XCD_BAR_WORDS 3456
#define XB_SPIN_CAP (1u << 20)
#define LAS __attribute__((address_space(3)))
DI unsigned xb_ld(unsigned* p) { return __hip_atomic_load(p, __ATOMIC_RELAXED, __HIP_MEMORY_SCOPE_AGENT); }
DI unsigned xb_add(unsigned* p, unsigned v) { return __hip_atomic_fetch_add(p, v, __ATOMIC_RELAXED, __HIP_MEMORY_SCOPE_AGENT); }
DI unsigned xb_xcc_id() { return (unsigned)__builtin_amdgcn_s_getreg((3 << 11) | 20) & 0xFu; }
#define XB_SPIN(cond, bar) do { unsigned _sp = 0; while (cond) { __builtin_amdgcn_s_sleep(1); \
    if ((++_sp & 255u) == 0u) { if (xb_ld(&(bar)[XB_TMO])) break; if (_sp > XB_SPIN_CAP) { atomicAdd(&(bar)[XB_TMO], 1u); break; } } } } while (0)
struct XcdBarrier { unsigned* bar; unsigned x; volatile LAS unsigned* st; };
DI XcdBarrier xcd_barrier_post(unsigned* bar, volatile LAS unsigned* st) {
  XcdBarrier b; b.bar = bar; b.x = xb_xcc_id(); b.st = st;
  if (threadIdx.x == 0) (void)xb_add(&bar[XB_XCNT(b.x)], 1u);
  return b;
}
DI void xcd_barrier_complete(unsigned* bar, unsigned x, unsigned& nloc, unsigned& nx) {
  const unsigned G = gridDim.x * gridDim.y * gridDim.z;
  unsigned sum, cnt, mine, sp = 0u;
  for (;;) {
    sum = 0u; cnt = 0u; mine = 0u;
#pragma unroll
    for (unsigned j = 0; j < 16; ++j) { const unsigned c = xb_ld(&bar[XB_XCNT(j)]); sum += c; cnt += (c > 0u) ? 1u : 0u; mine = (j == x) ? c : mine; }
    if (sum == G) break;
    __builtin_amdgcn_s_sleep(1);
    if ((++sp & 255u) == 0u) { if (xb_ld(&bar[XB_TMO])) break; if (sp > XB_SPIN_CAP) { atomicAdd(&bar[XB_TMO], 1u); break; } }
  }
  nloc = mine > 0u ? mine : 1u; nx = cnt > 0u ? cnt : 1u;
}
DI void xcd_barrier(const XcdBarrier& b) {
  asm volatile("s_waitcnt vmcnt(0)" ::: "memory");
  __syncthreads();
  if (threadIdx.x == 0) {
    unsigned* bar = b.bar;
    __builtin_amdgcn_s_waitcnt(0);
    unsigned nloc = b.st[0], nx = b.st[1];
    if (nloc == 0u) { xcd_barrier_complete(bar, b.x, nloc, nx); b.st[0] = nloc; b.st[1] = nx; }
    const unsigned old = xb_add(&bar[XB_XSUB(b.x)], 1u);
    const unsigned gen = old / nloc;
    if (old + 1u == (gen + 1u) * nloc) {
      __builtin_amdgcn_fence(__ATOMIC_RELEASE, "agent");
      asm volatile("s_waitcnt vmcnt(0)" ::: "memory");
      const unsigned og = xb_add(&bar[XB_TOP], 1u);
      const unsigned tg = og / nx;
      if (og + 1u == (tg + 1u) * nx) xb_add(&bar[XB_TOPGEN], 1u);
      else XB_SPIN(xb_ld(&bar[XB_TOPGEN]) == tg, bar);
      __builtin_amdgcn_fence(__ATOMIC_ACQUIRE, "agent");
      xb_add(&bar[XB_XGEN(b.x)], 1u);
      asm volatile("s_waitcnt vmcnt(0)" ::: "memory");
    } else {
      XB_SPIN(xb_ld(&bar[XB_XGEN(b.x)]) == gen, bar);
      __builtin_amdgcn_fence(__ATOMIC_ACQUIRE, "agent");
      asm volatile("s_waitcnt vmcnt(0)" ::: "memory");
    }
  }
  __syncthreads();
}

constexpr int NPHASE = 1 + 2 * 15;
static_assert(OFF_RX == OFF_HBF + SZ1K, "joint HBF2 spans HBF + RX");
static_assert(OFF_QM - OFF_DQ >= (size_t)2 * MH * FH * 2, "joint HH spans DQ..VMT");
DI void run_phase(const Params& P, int ph, char* lds) {
  if (ph == 0) { phase0(P, lds); return; }
  const int q = ph - 1, l = q / 15, r = q % 15;
  const int MTl = (l == 0) ? MH / 128 : ML / 128;
  if (r >= 12) {
    const int rph = MTl * 128;
    if (r == 12) norm_phase(P, l, 0, 1, 2 * rph, rph);
    else if (r == 13) ffn_in_phase(P, l, 0, 2 * MTl, lds);
    else resid_gemm_phase(P, l, 0, 2 * MTl, (const bf16_t*)(P.ws + OFF_DQ), FH, (const bf16_t*)(P.ws + OFF_WFO), 5120, false, lds, rph);
    return;
  }
  const int half = r / 6, k = r % 6;
  switch (k) {
    case 0: if (half == 0) convert_weights(P, l, lds); norm_phase(P, l, half, 0, MH); break;
    case 1: g1_phase(P, l, half, lds); break;
    case 2: pc_phase(P, l, half, lds); break;
    case 3: pd_phase(P, l, half, ph, lds); break;
    case 4: merge_phase(P, l, half, MTl, lds); break;
    default: resid_gemm_phase(P, l, half, MTl, (const bf16_t*)(P.ws + OFF_RX), 1024, (const bf16_t*)(P.ws + OFF_WOUT), 2048, l == 0, lds); break;
  }
}

__global__ void __launch_bounds__(256, 2) fwd_kernel(Params P, int ph0, int ph1) {
  extern __shared__ __attribute__((aligned(16))) char smem[];
  volatile LAS unsigned* st = (volatile LAS unsigned*)(smem + LDS_BAR);
  if (threadIdx.x < 2) st[threadIdx.x] = 0u;
  __syncthreads();
  const XcdBarrier xb = xcd_barrier_post((unsigned*)(P.ws + OFF_BAR), st);
  for (int ph = ph0; ph < ph1; ++ph) {
    run_phase(P, ph, smem);
    if (ph + 1 < ph1) { if (ph == 0) cg::this_grid().sync(); else xcd_barrier(xb); }
  }
}

extern "C" void kernel_launch(void* const* d_in, const int* in_sizes, int n_in, void* d_out, int out_size, void* d_ws, size_t ws_size, hipStream_t stream) {
  static int grid_blocks = 0;
  if (!grid_blocks) {
    hipFuncSetAttribute((const void*)fwd_kernel, hipFuncAttributeMaxDynamicSharedMemorySize, LDS_BYTES);
    int dev = 0, cus = 0, per_cu = 0;
    hipGetDevice(&dev);
    hipDeviceGetAttribute(&cus, hipDeviceAttributeMultiprocessorCount, dev);
    hipOccupancyMaxActiveBlocksPerMultiprocessor(&per_cu, fwd_kernel, 256, LDS_BYTES);
    if (per_cu > 2) per_cu = 2;
    grid_blocks = cus * per_cu;
    if (grid_blocks <= 0) grid_blocks = 256;
  }
  if (ws_size < WS_NEED) { fprintf(stderr, "workspace too small: %zu < %zu\n", ws_size, (size_t)WS_NEED); return; }
  hipMemsetAsync((char*)d_ws + OFF_BAR, 0, XCD_BAR_WORDS * 4 + 2048, stream);
  Params p{};
  const float** f = (const float**)&p;
  for (int i = 0; i < 32; ++i) f[i] = (const float*)d_in[i];
  p.out = (float*)d_out; p.ws = (char*)d_ws;
#if ONE_LAUNCH
  int ph0 = 0, ph1 = NPHASE;
  void* args[] = {&p, &ph0, &ph1};
  hipError_t e = hipLaunchCooperativeKernel((const void*)fwd_kernel, dim3(grid_blocks), dim3(256), args, LDS_BYTES, stream);
  if (e != hipSuccess) fprintf(stderr, "cooperative launch failed: %s (grid %d)\n", hipGetErrorString(e), grid_blocks);
#else
  for (int ph = 0; ph < NPHASE; ++ph) fwd_kernel<<<grid_blocks, 256, LDS_BYTES, stream>>>(p, ph, ph + 1);
#endif
}
```

```cpp
#include <hip/hip_runtime.h>
#include <hip/hip_cooperative_groups.h>
#include <cstdio>
#include <cstdint>
namespace cg = cooperative_groups;

#ifndef ONE_LAUNCH
#define ONE_LAUNCH 1
#endif

typedef unsigned short bf16_t;
typedef short bf16x8 __attribute__((ext_vector_type(8)));
typedef float f32x4 __attribute__((ext_vector_type(4)));
typedef float f32x16 __attribute__((ext_vector_type(16)));
#define DI __device__ __forceinline__

constexpr int D = 1024, T = 2048, CT = 256, HB = 4;
constexpr int ML = HB * T;
constexpr int MC = HB * CT;
constexpr int MH = ML + MC;
constexpr int NKEY = T + CT;
constexpr int N1 = 5888;
constexpr int FH = 2816;
constexpr int INC = 8864;
constexpr float EPS = 1e-6f;
constexpr float LOG2E = 1.4426950408889634f;

constexpr size_t al(size_t x) { return (x + 255) & ~(size_t)255; }
constexpr size_t OFF_MOD = 0;
constexpr size_t OFF_RM = al(OFF_MOD + 2 * 9 * 6144 * 4);
constexpr size_t OFF_RD = al(OFF_RM + 2 * 2048 * 16 * 4);
constexpr size_t OFF_LAM = al(OFF_RD + 2 * 2048 * 32 * 4);
constexpr size_t OFF_BAR = al(OFF_LAM + 256);
constexpr size_t OFF_CTR = OFF_BAR + 3456 * 4;
constexpr size_t OFF_CARRY = al(OFF_CTR + 2048);
constexpr size_t OFF_XC = al(OFF_CARRY + (size_t)HB * 2 * 18 * 1024 * 8);
constexpr size_t OFF_WIN = al(OFF_XC + (size_t)2048 * 1024 * 4);
constexpr size_t OFF_WMG = al(OFF_WIN + (size_t)N1 * 1024 * 2);
constexpr size_t OFF_WUQ = al(OFF_WMG + (size_t)3072 * 1024 * 2);
constexpr size_t OFF_WUKV = al(OFF_WUQ + (size_t)1536 * 384 * 2);
constexpr size_t OFF_WLRU = al(OFF_WUKV + (size_t)2048 * 256 * 2);
constexpr size_t OFF_WBRA = al(OFF_WLRU + (size_t)4096 * 128 * 2);
constexpr size_t OFF_WBRB = al(OFF_WBRA + (size_t)1024 * 1024 * 2);
constexpr size_t OFF_WBRC = al(OFF_WBRB + (size_t)1024 * 1024 * 2);
constexpr size_t OFF_WOUT = al(OFF_WBRC + (size_t)1024 * 1024 * 2);
constexpr size_t OFF_WFI = al(OFF_WOUT + (size_t)1024 * 1024 * 2);
constexpr size_t OFF_WFO = al(OFF_WFI + (size_t)5632 * 1024 * 2);
constexpr size_t OFF_HBF = al(OFF_WFO + (size_t)1024 * FH * 2);
constexpr size_t SZ1K = (size_t)MH * 1024 * 2;
constexpr size_t OFF_RX = al(OFF_HBF + SZ1K);
constexpr size_t OFF_GRG = al(OFF_RX + SZ1K);
constexpr size_t OFF_CQKV = al(OFF_GRG + SZ1K);
constexpr size_t OFF_DQ = al(OFF_CQKV + (size_t)MH * 768 * 2);
constexpr size_t OFF_DK = al(OFF_DQ + SZ1K);
constexpr size_t OFF_DVT = al(OFF_DK + SZ1K);
constexpr size_t OFF_KM = al(OFF_DVT + SZ1K);
constexpr size_t OFF_VMT = al(OFF_KM + (size_t)MH * 1536 * 2);
constexpr size_t OFF_QM = al(OFF_VMT + SZ1K);
constexpr size_t OFF_OB = al(OFF_QM + (size_t)MH * 1536 * 2);
constexpr size_t OFF_XCV = al(OFF_OB + SZ1K);
constexpr size_t WS_NEED = al(OFF_XCV + SZ1K);
static_assert(OFF_DK == OFF_DQ + SZ1K && OFF_DVT == OFF_DK + SZ1K, "HH alias needs contiguous DQ/DK/DVT");
static_assert((size_t)MH * FH * 2 <= 3 * SZ1K, "HH alias size");

constexpr int LDS_BYTES = 73728 + 1024 + 3072 + 32;
constexpr int LDS_BAR = 73728 + 1024 + 3072;
constexpr int LDS_RS = 73728, LDS_SEG = 73728 + 1024;

struct Params {
  const float *x, *c, *ctx, *c_ctx, *w_mod, *b_mod, *norm1_g, *norm2_g, *w_in, *conv_w, *conv_b, *lru_wa, *lru_ba, *lru_wi, *lru_bi,
      *lru_lambda, *mla_qn_g, *mla_w_uq, *mla_kvn_g, *mla_w_ukv, *mla_q_g, *mla_k_g, *diff_q_g, *diff_k_g, *diff_lambda, *diff_subln_g,
      *w_br_a, *w_br_b, *w_br_c, *w_out, *w_ffn_in, *w_ffn_out;
  float* out;
  char* ws;
};

DI int tidx() { int t = __builtin_amdgcn_workitem_id_x(); asm volatile("" : "+v"(t)); return t; }
DI float bf2f(unsigned short u) { return __uint_as_float(((unsigned)u) << 16); }
DI unsigned short f2bf(float x) { unsigned u = __float_as_uint(x); u += 0x7fffu + ((u >> 16) & 1u); return (unsigned short)(u >> 16); }
typedef __bf16 bf16n2 __attribute__((ext_vector_type(2)));
typedef float f32x2n __attribute__((ext_vector_type(2)));
DI unsigned pack2(float lo, float hi) { const f32x2n v = {lo, hi}; return __builtin_bit_cast(unsigned, __builtin_convertvector(v, bf16n2)); }
DI float lo2f(unsigned u) { return __uint_as_float(u << 16); }
DI float hi2f(unsigned u) { return __uint_as_float(u & 0xffff0000u); }
DI float sigmoidf_(float x) { return 1.0f / (1.0f + __expf(-x)); }
DI float siluf_(float x) { return x * sigmoidf_(x); }
DI float geluf_(float x) { const float u = 0.7978845608028654f * (x + 0.044715f * x * x * x); return 0.5f * x * (1.0f + tanhf(u)); }
DI int perm16(int o) { return (o & 3) | ((o & 4) << 1) | ((o & 8) >> 1); }
DI int keypos(int kk) { return (kk & ~15) | perm16(kk & 15); }
struct RowInfo { int bl, t, isctx; };
DI RowInfo rowinfo(int lr) { RowInfo r; if (lr < ML) { r.bl = lr >> 11; r.t = lr & 2047; r.isctx = 0; } else { const int q = lr - ML; r.bl = q >> 8; r.t = q & 255; r.isctx = 1; } return r; }
DI float* resid_ptr(const Params& P, int half, int lr) {
  return lr < ML ? P.out + ((size_t)half * ML + lr) * D : (float*)(P.ws + OFF_XC) + ((size_t)half * MC + (lr - ML)) * D;
}
DI const float* input_ptr(const Params& P, int half, int lr) {
  return lr < ML ? P.x + ((size_t)half * ML + lr) * D : P.ctx + ((size_t)half * MC + (lr - ML)) * D;
}
DI float lam_init_of(int l) { return l == 0 ? 0.2f : 0.35550906f; }

typedef __attribute__((address_space(3))) unsigned lds_u32_t;
#define GLDS16(gsrc, ldst) __builtin_amdgcn_global_load_lds((const unsigned*)(gsrc), (lds_u32_t*)(ldst), 16, 0, 0)
DI void gemm_core_ring2(f32x4 (&acc)[4][2], const bf16_t* __restrict__ A, int lda, const bf16_t* __restrict__ W, int ldw, int K, char* lds) {
  constexpr int NT = 2, STAGE = 24576;
  const int tid = tidx(), lane = tid & 63, wid = tid >> 6, wr = wid >> 1, wc = wid & 1, fr = lane & 15, fq = lane >> 4;
  const int crow = tid >> 3, csrc = (tid & 7) ^ ((crow >> 1) & 7);
  const int nk = K >> 6;
  const bf16_t* ap = A + (size_t)crow * lda + csrc * 8;
  const bf16_t* wp = W + (size_t)crow * ldw + csrc * 8;
  const int sw = (fr >> 1) & 7;
  const int wbase = __builtin_amdgcn_readfirstlane(wid) * 1024;
#define RING_STAGE(KT, BUF) do { char* a_ = lds + (BUF) * STAGE + wbase; char* w_ = a_ + 16384; \
    _Pragma("unroll") for (int i = 0; i < 4; ++i) GLDS16(ap + (size_t)(32 * i) * lda + (KT) * 64, a_ + i * 4096); \
    _Pragma("unroll") for (int i = 0; i < NT; ++i) GLDS16(wp + (size_t)(32 * i) * ldw + (KT) * 64, w_ + i * 4096); } while (0)
  RING_STAGE(0, 0); RING_STAGE(1, 1);
  int buf = 0, nbuf = 2;
  for (int j = 0; j < nk; ++j) {
    if (j + 1 < nk) asm volatile("s_waitcnt vmcnt(6)" ::: "memory"); else asm volatile("s_waitcnt vmcnt(0)" ::: "memory");
    asm volatile("s_waitcnt lgkmcnt(0)" ::: "memory");
    __builtin_amdgcn_s_barrier();
    asm volatile("" ::: "memory");
    if (j + 2 < nk) RING_STAGE(j + 2, nbuf);
    {
      const char* a = lds + buf * STAGE; const char* w = a + 16384;
      bf16x8 bf0[4], af0[NT], bf1[4], af1[NT];
      { const int co = ((0 * 4 + fq) ^ sw) * 16;
#pragma unroll
        for (int mi = 0; mi < 4; ++mi) bf0[mi] = *(const bf16x8*)(a + (wr * 64 + mi * 16 + fr) * 128 + co);
#pragma unroll
        for (int ni = 0; ni < NT; ++ni) af0[ni] = *(const bf16x8*)(w + (wc * NT * 16 + ni * 16 + fr) * 128 + co); }
      { const int co = ((1 * 4 + fq) ^ sw) * 16;
#pragma unroll
        for (int mi = 0; mi < 4; ++mi) bf1[mi] = *(const bf16x8*)(a + (wr * 64 + mi * 16 + fr) * 128 + co);
#pragma unroll
        for (int ni = 0; ni < NT; ++ni) af1[ni] = *(const bf16x8*)(w + (wc * NT * 16 + ni * 16 + fr) * 128 + co); }
#pragma unroll
      for (int mi = 0; mi < 4; ++mi)
#pragma unroll
        for (int ni = 0; ni < NT; ++ni) acc[mi][ni] = __builtin_amdgcn_mfma_f32_16x16x32_bf16(af0[ni], bf0[mi], acc[mi][ni], 0, 0, 0);
#pragma unroll
      for (int mi = 0; mi < 4; ++mi)
#pragma unroll
        for (int ni = 0; ni < NT; ++ni) acc[mi][ni] = __builtin_amdgcn_mfma_f32_16x16x32_bf16(af1[ni], bf1[mi], acc[mi][ni], 0, 0, 0);
    }
    buf = (buf == 2) ? 0 : buf + 1; nbuf = (nbuf == 2) ? 0 : nbuf + 1;
  }
  __syncthreads();
#undef RING_STAGE
}
template <int K_> DI void row_rstd_table(const bf16_t* A, int lda, char* lds);
template <int NT, int RSK = 0>
DI void gemm_core(f32x4 (&acc)[4][NT], const bf16_t* __restrict__ A, int lda, const bf16_t* __restrict__ W, int ldw, int K, char* lds) {
  if constexpr (NT == 2) { gemm_core_ring2(acc, A, lda, W, ldw, K, lds); return; }
  constexpr int STAGE = 32768;
  const int tid = tidx(), lane = tid & 63, wid = tid >> 6, wr = wid >> 1, wc = wid & 1, fr = lane & 15, fq = lane >> 4;
  const int crow = tid >> 3, csrc = (tid & 7) ^ ((crow >> 1) & 7);
  const int nk = K >> 6;
  const bf16_t* ap = A + (size_t)crow * lda + csrc * 8;
  const bf16_t* wp = W + (size_t)crow * ldw + csrc * 8;
  const int sw = (fr >> 1) & 7;
  const int wbase = __builtin_amdgcn_readfirstlane(wid) * 1024;
#define GEMM_STAGE(KT, BUF) do { char* a_ = lds + (BUF) * STAGE + wbase; char* w_ = a_ + 16384; \
    _Pragma("unroll") for (int i = 0; i < 4; ++i) GLDS16(ap + (size_t)(32 * i) * lda + (KT) * 64, a_ + i * 4096); \
    _Pragma("unroll") for (int i = 0; i < NT; ++i) GLDS16(wp + (size_t)(32 * i) * ldw + (KT) * 64, w_ + i * 4096); } while (0)
#define GEMM_LDFR(BUF, KS, BF, AF) do { const char* a = lds + (BUF) * STAGE; const char* w = a + 16384; const int co = (((KS) * 4 + fq) ^ sw) * 16; \
      _Pragma("unroll") for (int mi = 0; mi < 4; ++mi) BF[mi] = *(const bf16x8*)(a + (wr * 64 + mi * 16 + fr) * 128 + co); \
      _Pragma("unroll") for (int ni = 0; ni < NT; ++ni) AF[ni] = *(const bf16x8*)(w + (wc * NT * 16 + ni * 16 + fr) * 128 + co); } while (0)
#define GEMM_MMA(BF, AF) do { \
      _Pragma("unroll") for (int mi = 0; mi < 4; ++mi) \
        _Pragma("unroll") for (int ni = 0; ni < NT; ++ni) acc[mi][ni] = __builtin_amdgcn_mfma_f32_16x16x32_bf16(AF[ni], BF[mi], acc[mi][ni], 0, 0, 0); } while (0)
#define GEMM_COMPUTE(BUF) do { bf16x8 bf0[4], af0[NT], bf1[4], af1[NT]; \
    GEMM_LDFR(BUF, 0, bf0, af0); \
    __builtin_amdgcn_sched_barrier(0); \
    GEMM_LDFR(BUF, 1, bf1, af1); \
    GEMM_MMA(bf0, af0); \
    __builtin_amdgcn_sched_barrier(0); \
    GEMM_MMA(bf1, af1); } while (0)
  GEMM_STAGE(0, 0);
  if constexpr (RSK != 0) row_rstd_table<RSK>(A, lda, lds);
  __syncthreads();
  for (int kt = 0; kt + 1 < nk; ++kt) {
    GEMM_STAGE(kt + 1, (kt + 1) & 1);
    GEMM_COMPUTE(kt & 1);
    __syncthreads();
  }
  GEMM_COMPUTE((nk - 1) & 1);
  __syncthreads();
#undef GEMM_COMPUTE
#undef GEMM_MMA
#undef GEMM_LDFR
#undef GEMM_STAGE
}
template <int NT> DI void zero_acc(f32x4 (&acc)[4][NT]) {
#pragma unroll
  for (int mi = 0; mi < 4; ++mi)
#pragma unroll
    for (int ni = 0; ni < NT; ++ni) acc[mi][ni] = (f32x4){0.f, 0.f, 0.f, 0.f};
}
DI float ssq8(uint4 v) { const float a = lo2f(v.x), b = hi2f(v.x), c = lo2f(v.y), d = hi2f(v.y), e = lo2f(v.z), f = hi2f(v.z), g = lo2f(v.w), h = hi2f(v.w); return a * a + b * b + c * c + d * d + e * e + f * f + g * g + h * h; }
DI void store4bf(bf16_t* p, f32x4 v) { uint2 w; w.x = pack2(v[0], v[1]); w.y = pack2(v[2], v[3]); *(uint2*)p = w; }

template <int K>
DI void row_rstd_table(const bf16_t* A, int lda, char* lds) {
  const int tid = tidx(), row = tid >> 1, hf = tid & 1;
  const bf16_t* p = A + (size_t)row * lda + hf * (K >> 1);
  float ss = 0.f;
#pragma unroll
  for (int i0 = 0; i0 < (K >> 4); i0 += 8) {
    uint4 v[8];
#pragma unroll
    for (int i = 0; i < 8; ++i) v[i] = *(const uint4*)(p + (i0 + i) * 8);
#pragma unroll
    for (int i = 0; i < 8; ++i) ss += ssq8(v[i]);
  }
  ss += __shfl_xor(ss, 1);
  if (hf == 0) ((float*)(lds + LDS_RS))[row] = rsqrtf(ss / (float)K + EPS);
}

DI void phase0(const Params& P, char* lds) {
  const int tid = tidx(), lane = tid & 63, wid = tid >> 6;
  float* sil = (float*)lds;
  float* part = (float*)(lds + 9 * 1024 * 4);
  float* MOD = (float*)(P.ws + OFF_MOD);
  for (int u = blockIdx.x; u < 192 + 384 + 1; u += gridDim.x) {
    if (u < 192) {
      const int l = u / 96, cg_ = u % 96;
      __syncthreads();
      for (int i = tid; i < 9 * 1024; i += 256) { const int r = i >> 10, k = i & 1023; const float v = r < 8 ? P.c[r * 1024 + k] : P.c_ctx[k]; sil[i] = siluf_(v); }
      __syncthreads();
      float acc[9];
#pragma unroll
      for (int r = 0; r < 9; ++r) acc[r] = 0.f;
      const float* wm = P.w_mod + (size_t)l * 1024 * 6144 + cg_ * 64 + lane;
      for (int k = wid * 256; k < wid * 256 + 256; k += 8) {
        float w[8];
#pragma unroll
        for (int e = 0; e < 8; ++e) w[e] = wm[(size_t)(k + e) * 6144];
#pragma unroll
        for (int e = 0; e < 8; ++e)
#pragma unroll
          for (int r = 0; r < 9; ++r) acc[r] += sil[r * 1024 + k + e] * w[e];
      }
#pragma unroll
      for (int r = 0; r < 9; ++r) part[(wid * 9 + r) * 64 + lane] = acc[r];
      __syncthreads();
      for (int i = tid; i < 9 * 64; i += 256) {
        const int r = i >> 6, cc = i & 63;
        const float s = part[(0 * 9 + r) * 64 + cc] + part[(1 * 9 + r) * 64 + cc] + part[(2 * 9 + r) * 64 + cc] + part[(3 * 9 + r) * 64 + cc];
        MOD[((size_t)l * 9 + r) * 6144 + cg_ * 64 + cc] = s + P.b_mod[l * 6144 + cg_ * 64 + cc];
      }
    } else if (u < 192 + 384) {
      const int i = (u - 192) * 256 + tid;
      const int t = i / 48, e = i % 48;
      const float rowid = (float)(t >> 6), colid = (float)(t & 63);
      if (e < 16) {
        const int fi = e & 7; const float fr_ = powf(10000.0f, -(float)fi / 8.0f);
        const float ang = (e < 8 ? rowid : colid) * fr_;
        ((float*)(P.ws + OFF_RM))[t * 16 + e] = cosf(ang);
        ((float*)(P.ws + OFF_RM))[2048 * 16 + t * 16 + e] = sinf(ang);
      } else {
        const int e2 = e - 16, fi = e2 & 15; const float fr_ = powf(10000.0f, -(float)fi / 16.0f);
        const float ang = (e2 < 16 ? rowid : colid) * fr_;
        ((float*)(P.ws + OFF_RD))[t * 32 + e2] = cosf(ang);
        ((float*)(P.ws + OFF_RD))[2048 * 32 + t * 32 + e2] = sinf(ang);
      }
    } else {
      if (tid < 2) {
        const float* dl = P.diff_lambda + tid * 256;
        float s1 = 0.f, s2 = 0.f;
        for (int i = 0; i < 64; ++i) { s1 += dl[i] * dl[64 + i]; s2 += dl[128 + i] * dl[192 + i]; }
        ((float*)(P.ws + OFF_LAM))[tid] = expf(s1) - expf(s2) + lam_init_of(tid);
      }
    }
  }
}

constexpr int CT_WIN = (N1 / 64) * 16, CT_WMG = CT_WIN + 48 * 16, CT_WUQ = CT_WMG + 24 * 6, CT_WUKV = CT_WUQ + 32 * 4, CT_WLRU = CT_WUKV + 64 * 2,
              CT_WBR = CT_WLRU + 4 * 16 * 16, CT_WFI = CT_WBR + 88 * 16, CT_WFO = CT_WFI + 16 * 44;
DI void convert_weights(const Params& P, int l, char* lds) {
  const int tid = tidx();
  bf16_t* tl = (bf16_t*)lds;
  for (int t = blockIdx.x; t < CT_WFO; t += gridDim.x) {
    int m, lt, NTl, K; bf16_t* dst; const float* sbase; int sstride; const float* kscale = nullptr;
    if (t < CT_WIN) { m = 0; lt = t; NTl = N1 / 64; K = 1024; dst = (bf16_t*)(P.ws + OFF_WIN); sbase = P.w_in + (size_t)l * 1024 * INC; sstride = INC; }
    else if (t < CT_WMG) { m = 1; lt = t - CT_WIN; NTl = 48; K = 1024; dst = (bf16_t*)(P.ws + OFF_WMG); sbase = P.w_in + (size_t)l * 1024 * INC; sstride = INC; }
    else if (t < CT_WUQ) { m = 2; lt = t - CT_WMG; NTl = 24; K = 384; dst = (bf16_t*)(P.ws + OFF_WUQ); sbase = P.mla_w_uq + (size_t)l * 384 * 1536; sstride = 1536; kscale = P.mla_qn_g + l * 384; }
    else if (t < CT_WUKV) { m = 3; lt = t - CT_WUQ; NTl = 32; K = 256; dst = (bf16_t*)(P.ws + OFF_WUKV); sbase = P.mla_w_ukv + (size_t)l * 256 * 2048; sstride = 2048; kscale = P.mla_kvn_g + l * 256; }
    else if (t < CT_WLRU) { m = 4; lt = t - CT_WUKV; NTl = 64; K = 128; dst = (bf16_t*)(P.ws + OFF_WLRU); sbase = nullptr; sstride = 128; }
    else if (t < CT_WBR) { const int q = t - CT_WLRU; const int mm = q >> 8; m = 5; lt = q & 255; NTl = 16; K = 1024; dst = (bf16_t*)(P.ws + OFF_WBRA + (size_t)mm * (OFF_WBRB - OFF_WBRA));
      sbase = (mm == 0 ? P.w_br_a : mm == 1 ? P.w_br_b : mm == 2 ? P.w_br_c : P.w_out) + (size_t)l * 1024 * 1024; sstride = 1024; }
    else if (t < CT_WFI) { m = 6; lt = t - CT_WBR; NTl = 88; K = 1024; dst = (bf16_t*)(P.ws + OFF_WFI); sbase = P.w_ffn_in + (size_t)l * 1024 * 5632; sstride = 5632; }
    else { m = 7; lt = t - CT_WFI; NTl = 16; K = FH; dst = (bf16_t*)(P.ws + OFF_WFO); sbase = P.w_ffn_out + (size_t)l * FH * 1024; sstride = 1024; }
    const int tn = lt % NTl, tk = lt / NTl;
    const int n = tn * 64 + (tid & 15) * 4;
    int sc = n; const float* sb = sbase;
    if (m == 0) { if (n < 2048) sc = n; else if (n < 2816) { const int j = n - 2048; sc = j < 672 ? 2048 + j : -1; } else sc = 2720 + (n - 2816); }
    else if (m == 1) sc = 5792 + n;
    else if (m == 4) { const int blk = n >> 9, r = (n >> 8) & 1, q4 = (n >> 6) & 3, g32 = (n >> 5) & 1, gate = (n >> 4) & 1, cc = n & 15;
      sb = (gate ? P.lru_wi : P.lru_wa) + (((size_t)l * 2 + r) * 8 + blk) * 128 * 128; sc = q4 * 32 + g32 * 16 + cc; }
    else if (m == 6) { const int tn2 = n >> 7, c16 = (n >> 5) & 3, gate = (n >> 4) & 1, cc = n & 15; sc = gate * FH + tn2 * 64 + c16 * 16 + cc; }
    __syncthreads();
#pragma unroll
    for (int p = 0; p < 4; ++p) {
      const int kl = (tid >> 4) + 16 * p, k = tk * 64 + kl;
      f32x4 v = {0.f, 0.f, 0.f, 0.f};
      if (sc >= 0) v = *(const f32x4*)(sb + (size_t)k * sstride + sc);
      if (kscale) v = v * kscale[k];
      const int nl = (tid & 15) * 4;
      tl[(nl + 0) * 72 + kl] = f2bf(v[0]); tl[(nl + 1) * 72 + kl] = f2bf(v[1]); tl[(nl + 2) * 72 + kl] = f2bf(v[2]); tl[(nl + 3) * 72 + kl] = f2bf(v[3]);
    }
    __syncthreads();
    {
      const int nl = tid >> 2, kc = (tid & 3) * 16;
      const uint4 a = *(const uint4*)(tl + nl * 72 + kc), b2 = *(const uint4*)(tl + nl * 72 + kc + 8);
      bf16_t* d = dst + (size_t)(tn * 64 + nl) * K + tk * 64 + kc;
      *(uint4*)d = a; *(uint4*)(d + 8) = b2;
    }
  }
}
static_assert(OFF_WBRC - OFF_WBRB == OFF_WBRB - OFF_WBRA && OFF_WOUT - OFF_WBRC == OFF_WBRB - OFF_WBRA, "br weights equally spaced");

DI void norm_phase(const Params& P, int l, int half_, int which  , int nrows, int rph = 0  ) {
  const int lane = tidx() & 63, wid = tidx() >> 6;
  const float* g = (which == 0 ? P.norm1_g : P.norm2_g) + l * 1024;
  const float* MOD = (const float*)(P.ws + OFF_MOD) + (size_t)l * 9 * 6144;
  bf16_t* H = (bf16_t*)(P.ws + OFF_HBF);
  for (int grow = blockIdx.x * 4 + wid; grow < nrows; grow += gridDim.x * 4) {
    const int half = rph ? grow / rph : half_, row = rph ? grow % rph : grow;
    const RowInfo ri = rowinfo(row);
    const float* src = (which == 0 && l == 0) ? input_ptr(P, half, row) : resid_ptr(P, half, row);
    const float* md = MOD + (size_t)(ri.isctx ? 8 : half * HB + ri.bl) * 6144 + (which == 0 ? 0 : 3072);
    f32x4 v[4]; float ss = 0.f;
#pragma unroll
    for (int i = 0; i < 4; ++i) { v[i] = *(const f32x4*)(src + i * 256 + lane * 4); ss += v[i][0] * v[i][0] + v[i][1] * v[i][1] + v[i][2] * v[i][2] + v[i][3] * v[i][3]; }
#pragma unroll
    for (int o = 1; o < 64; o <<= 1) ss += __shfl_xor(ss, o);
    const float rstd = rsqrtf(ss * (1.0f / 1024.0f) + EPS);
#pragma unroll
    for (int i = 0; i < 4; ++i) {
      const int c0 = i * 256 + lane * 4;
      const f32x4 gg = *(const f32x4*)(g + c0), sh = *(const f32x4*)(md + c0), sc = *(const f32x4*)(md + 1024 + c0);
      f32x4 o;
#pragma unroll
      for (int j = 0; j < 4; ++j) o[j] = v[i][j] * rstd * gg[j] * (1.0f + sc[j]) + sh[j];
      store4bf(H + (size_t)grow * 1024 + c0, o);
    }
  }
}

DI void g1_phase(const Params& P, int l, int half, char* lds) {
  const int tid = tidx(), lane = tid & 63, wid = tid >> 6, wr = wid >> 1, wc = wid & 1, fr = lane & 15, fq = lane >> 4;
  const bf16_t* H = (const bf16_t*)(P.ws + OFF_HBF);
  const bf16_t* W = (const bf16_t*)(P.ws + OFF_WIN);
  const float* RDc = (const float*)(P.ws + OFF_RD); const float* RDs = RDc + 2048 * 32;
  constexpr int MT = MH / 128, NTL = N1 / 128;
  for (int u = blockIdx.x; u < MT * NTL; u += gridDim.x) {
    const int tn = u / MT, tm = u % MT;
    f32x4 acc[4][4]; zero_acc<4>(acc);
    gemm_core<4>(acc, H + (size_t)tm * 128 * 1024, 1024, W + (size_t)tn * 128 * 1024, 1024, 1024, lds);
    const int rowb = tm * 128 + wr * 64 + fr;
    if (tn < 8) {
      bf16_t* O = (bf16_t*)(P.ws + OFF_RX);
#pragma unroll
      for (int mi = 0; mi < 4; ++mi)
#pragma unroll
        for (int ni = 0; ni < 4; ++ni) store4bf(O + (size_t)(rowb + mi * 16) * 1024 + tn * 128 + wc * 64 + ni * 16 + fq * 4, acc[mi][ni]);
    } else if (tn < 16) {
      bf16_t* O = (bf16_t*)(P.ws + OFF_GRG);
#pragma unroll
      for (int mi = 0; mi < 4; ++mi)
#pragma unroll
        for (int ni = 0; ni < 4; ++ni) { f32x4 v = acc[mi][ni];
#pragma unroll
          for (int j = 0; j < 4; ++j) v[j] = geluf_(v[j]);
          store4bf(O + (size_t)(rowb + mi * 16) * 1024 + (tn - 8) * 128 + wc * 64 + ni * 16 + fq * 4, v); }
    } else if (tn < 22) {
      bf16_t* O = (bf16_t*)(P.ws + OFF_CQKV);
#pragma unroll
      for (int mi = 0; mi < 4; ++mi)
#pragma unroll
        for (int ni = 0; ni < 4; ++ni) store4bf(O + (size_t)(rowb + mi * 16) * 768 + (tn - 16) * 128 + wc * 64 + ni * 16 + fq * 4, acc[mi][ni]);
    } else if (tn < 38) {
      const int isk = tn >= 30; const int tl = isk ? tn - 30 : tn - 22;
      bf16_t* O = (bf16_t*)(P.ws + (isk ? OFF_DK : OFF_DQ));
      const float* g = (isk ? P.diff_k_g : P.diff_q_g) + l * 64;
#pragma unroll
      for (int mi = 0; mi < 4; ++mi) {
        const int row = rowb + mi * 16; const RowInfo ri = rowinfo(row);
        float ss = 0.f;
#pragma unroll
        for (int ni = 0; ni < 4; ++ni)
#pragma unroll
          for (int j = 0; j < 4; ++j) ss += acc[mi][ni][j] * acc[mi][ni][j];
        ss += __shfl_xor(ss, 16); ss += __shfl_xor(ss, 32);
        const float rstd = rsqrtf(ss * (1.0f / 64.0f) + EPS);
#pragma unroll
        for (int ni = 0; ni < 4; ++ni) {
          const int d0 = ni * 16 + fq * 4;
          const f32x4 gg = *(const f32x4*)(g + d0);
          f32x4 y;
#pragma unroll
          for (int j = 0; j < 4; ++j) y[j] = acc[mi][ni][j] * rstd * gg[j];
          if (!ri.isctx) {
            const int pi = d0 >> 1;
            const float c0 = RDc[ri.t * 32 + pi], s0 = RDs[ri.t * 32 + pi], c1 = RDc[ri.t * 32 + pi + 1], s1 = RDs[ri.t * 32 + pi + 1];
            const float a0 = y[0] * c0 - y[1] * s0, a1 = y[0] * s0 + y[1] * c0, a2 = y[2] * c1 - y[3] * s1, a3 = y[2] * s1 + y[3] * c1;
            y = (f32x4){a0, a1, a2, a3};
          }
          store4bf(O + (size_t)row * 1024 + tl * 128 + wc * 64 + d0, y);
        }
      }
    } else {
      bf16_t* O = (bf16_t*)(P.ws + OFF_DVT);
      const int h = tn - 38;
#pragma unroll
      for (int mi = 0; mi < 4; ++mi) {
        const int row = rowb + mi * 16; const RowInfo ri = rowinfo(row);
        const int pos = keypos(ri.isctx ? 2048 + ri.t : ri.t);
        bf16_t* ob = O + ((size_t)(ri.bl * 8 + h) * 128) * NKEY + pos;
#pragma unroll
        for (int ni = 0; ni < 4; ++ni)
#pragma unroll
          for (int j = 0; j < 4; ++j) ob[(size_t)(wc * 64 + ni * 16 + fq * 4 + j) * NKEY] = f2bf(acc[mi][ni][j]);
      }
    }
  }
}

template <int CTRL> DI float dppf(float old, float v) { return __int_as_float(__builtin_amdgcn_update_dpp(__float_as_int(old), __float_as_int(v), CTRL, 0xf, 0xf, false)); }
template <int R> DI void row_scan(float& a, float& b) {
  constexpr int B0 = R == 0 ? 0x110 : 0x100;
  { const float ap = dppf<B0 + 1>(1.0f, a), bp = dppf<B0 + 1>(0.0f, b); b = a * bp + b; a = a * ap; }
  { const float ap = dppf<B0 + 2>(1.0f, a), bp = dppf<B0 + 2>(0.0f, b); b = a * bp + b; a = a * ap; }
  { const float ap = dppf<B0 + 4>(1.0f, a), bp = dppf<B0 + 4>(0.0f, b); b = a * bp + b; a = a * ap; }
  { const float ap = dppf<B0 + 8>(1.0f, a), bp = dppf<B0 + 8>(0.0f, b); b = a * bp + b; a = a * ap; }
}
DI void conv_items(const Params& P, int l, int item0, int nitems) {
  const bf16_t* RX = (const bf16_t*)(P.ws + OFF_RX);
  bf16_t* XV = (bf16_t*)(P.ws + OFF_XCV);
  const int it = item0 + tidx();
  if (it >= nitems) return;
  const int row0 = (it >> 7) * 8, ch = (it & 127) * 8;
  const RowInfo ri = rowinfo(row0); const int Tseq = ri.isctx ? 256 : 2048;
  uint4 tv[11];
#pragma unroll
  for (int i = 0; i < 11; ++i) {
    const int tt = ri.t + i - 2; const bool ok = tt >= 0 && tt < Tseq;
    const uint4 v = *(const uint4*)(RX + (size_t)(row0 + (ok ? i - 2 : 0)) * 1024 + ch);
    tv[i] = ok ? v : make_uint4(0u, 0u, 0u, 0u);
  }
  float cwf[4][8], bias[8];
#pragma unroll
  for (int e = 0; e < 8; ++e) bias[e] = P.conv_b[l * 1024 + ch + e];
#pragma unroll
  for (int j = 0; j < 4; ++j)
#pragma unroll
    for (int e = 0; e < 8; ++e) cwf[j][e] = P.conv_w[((size_t)l * 4 + j) * 1024 + ch + e];
#pragma unroll
  for (int o = 0; o < 8; ++o) {
    float a8[8];
#pragma unroll
    for (int e = 0; e < 8; ++e) a8[e] = bias[e];
#pragma unroll
    for (int j = 0; j < 4; ++j) {
      const unsigned w[4] = {tv[o + j].x, tv[o + j].y, tv[o + j].z, tv[o + j].w};
#pragma unroll
      for (int e = 0; e < 4; ++e) { a8[2 * e] += lo2f(w[e]) * cwf[j][2 * e]; a8[2 * e + 1] += hi2f(w[e]) * cwf[j][2 * e + 1]; }
    }
    uint4 ov; ov.x = pack2(a8[0], a8[1]); ov.y = pack2(a8[2], a8[3]); ov.z = pack2(a8[4], a8[5]); ov.w = pack2(a8[6], a8[7]);
    *(uint4*)(XV + (size_t)(row0 + o) * 1024 + ch) = ov;
  }
}

template <int R>
DI void lru_seq_step(const Params& P, int l, int row0, int blk, int q4, bool need_out, float (&hcar)[4], const char* As, const char* Wsb, char* lds, int next_row0, bool has_next) {
  const int tid = tidx(), lane = tid & 63, wid = tid >> 6, wr = wid >> 1, wc = wid & 1, fr = lane & 15, fq = lane >> 4;
  float2* XW = (float2*)(lds + LDS_SEG);
  const int chq = wc * 16 + fq * 4, chg = blk * 128 + q4 * 32 + chq;
  bf16_t* TMP = (bf16_t*)(P.ws + OFF_RX);
  bf16_t* GRG = (bf16_t*)(P.ws + OFF_GRG);
  uint2 pf[4], pg[4];
  if (R == 1 && need_out) {
#pragma unroll
    for (int mi = 0; mi < 4; ++mi) { const size_t o = (size_t)(row0 + wr * 64 + mi * 16 + fr) * 1024 + chg; pf[mi] = *(const uint2*)(TMP + o); pg[mi] = *(const uint2*)(GRG + o); }
  }
  asm volatile("s_waitcnt vmcnt(0)" ::: "memory");
  __syncthreads();
  f32x4 acc[4][2]; zero_acc<2>(acc);
#pragma unroll
  for (int ks = 0; ks < 4; ++ks) {
    bf16x8 bfr[4], afr[2];
#pragma unroll
    for (int mi = 0; mi < 4; ++mi) bfr[mi] = *(const bf16x8*)(As + (wr * 64 + mi * 16 + fr) * 256 + (((ks * 4 + fq) ^ fr) * 16));
#pragma unroll
    for (int ni = 0; ni < 2; ++ni) afr[ni] = *(const bf16x8*)(Wsb + (wc * 32 + ni * 16 + fr) * 256 + (((ks * 4 + fq) ^ fr) * 16));
#pragma unroll
    for (int mi = 0; mi < 4; ++mi)
#pragma unroll
      for (int ni = 0; ni < 2; ++ni) acc[mi][ni] = __builtin_amdgcn_mfma_f32_16x16x32_bf16(afr[ni], bfr[mi], acc[mi][ni], 0, 0, 0);
  }
  float xcv[4][4];
#pragma unroll
  for (int mi = 0; mi < 4; ++mi) {
    const int tok = wr * 64 + mi * 16 + fr;
    const uint2 x2 = *(const uint2*)(As + tok * 256 + (((q4 * 4 + wc * 2 + (fq >> 1)) ^ fr) * 16) + (fq & 1) * 8);
    xcv[mi][0] = lo2f(x2.x); xcv[mi][1] = hi2f(x2.x); xcv[mi][2] = lo2f(x2.y); xcv[mi][3] = hi2f(x2.y);
  }
  float spl[4], bav[4], biv[4];
  {
    const f32x4* PRM = (const f32x4*)(lds + LDS_SEG + 1024);
#pragma unroll
    for (int j = 0; j < 4; ++j) { const f32x4 pv = PRM[R * 32 + chq + j]; spl[j] = pv[0]; bav[j] = pv[1]; biv[j] = pv[2]; }
  }
  asm volatile("s_waitcnt lgkmcnt(0)" ::: "memory");
  __syncthreads();
  if (has_next) {
    const bf16_t* XV = (const bf16_t*)(P.ws + OFF_XCV);
    const int wbase = __builtin_amdgcn_readfirstlane(wid) * 1024;
    const int xrow = tid >> 4, xsrc = (tid & 15) ^ (xrow & 15);
#pragma unroll
    for (int i = 0; i < 8; ++i) GLDS16(XV + (size_t)(next_row0 + xrow + 16 * i) * 1024 + blk * 128 + xsrc * 8, (char*)As + wbase + i * 4096);
  }
  float av[4][4], bv[4][4];
#pragma unroll
  for (int mi = 0; mi < 4; ++mi)
#pragma unroll
    for (int j = 0; j < 4; ++j) {
      const float sr = __builtin_amdgcn_rcpf(1.0f + __expf(-(acc[mi][0][j] + bav[j]))), si = __builtin_amdgcn_rcpf(1.0f + __expf(-(acc[mi][1][j] + biv[j])));
      const float la = -8.0f * sr * spl[j];
      const float a = __expf(la);
      av[mi][j] = a; bv[mi][j] = __builtin_amdgcn_sqrtf(fmaxf(0.f, 1.0f - a * a)) * si * xcv[mi][j];
    }
  const int endlane = (lane & ~15) | (R == 0 ? 15 : 0);
  float Ac[4][4], Bc[4][4], Aw[4], Bw[4];
#pragma unroll
  for (int j = 0; j < 4; ++j) { Aw[j] = 1.f; Bw[j] = 0.f; }
#pragma unroll
  for (int m = 0; m < 4; ++m) {
    const int mi = R == 0 ? m : 3 - m;
#pragma unroll
    for (int j = 0; j < 4; ++j) {
      row_scan<R>(av[mi][j], bv[mi][j]);
      const float At = __shfl(av[mi][j], endlane), Bt = __shfl(bv[mi][j], endlane);
      Ac[mi][j] = Aw[j]; Bc[mi][j] = Bw[j];
      Bw[j] = At * Bw[j] + Bt; Aw[j] = At * Aw[j];
    }
  }
  if (fr == 0) {
#pragma unroll
    for (int j = 0; j < 4; ++j) XW[wr * 32 + chq + j] = make_float2(Aw[j], Bw[j]);
  }
  asm volatile("s_waitcnt lgkmcnt(0)" ::: "memory");
  __builtin_amdgcn_s_barrier();
  asm volatile("" ::: "memory");
  const int first = R == 0 ? 0 : 1;
#pragma unroll
  for (int j = 0; j < 4; ++j) {
    const float2 e0 = XW[first * 32 + chq + j], e1 = XW[(1 - first) * 32 + chq + j];
    const float hw = (wr == first) ? hcar[j] : e0.x * hcar[j] + e0.y;
    float hout[4];
#pragma unroll
    for (int mi = 0; mi < 4; ++mi) { const float hb = Ac[mi][j] * hw + Bc[mi][j]; hout[mi] = av[mi][j] * hb + bv[mi][j]; }
#pragma unroll
    for (int mi = 0; mi < 4; ++mi) av[mi][j] = hout[mi];
    hcar[j] = e1.x * (e0.x * hcar[j] + e0.y) + e1.y;
  }
  if (need_out) {
#pragma unroll
    for (int mi = 0; mi < 4; ++mi) {
      const size_t o = (size_t)(row0 + wr * 64 + mi * 16 + fr) * 1024 + chg;
      if (R == 0) { store4bf(TMP + o, (f32x4){av[mi][0], av[mi][1], av[mi][2], av[mi][3]}); }
      else {
        const f32x4 y = {(av[mi][0] + lo2f(pf[mi].x)) * lo2f(pg[mi].x), (av[mi][1] + hi2f(pf[mi].x)) * hi2f(pg[mi].x),
                         (av[mi][2] + lo2f(pf[mi].y)) * lo2f(pg[mi].y), (av[mi][3] + hi2f(pf[mi].y)) * hi2f(pg[mi].y)};
        store4bf(GRG + o, y);
      }
    }
  }
}
DI void lru_seq_unit(const Params& P, int l, int u, char* lds) {
  const int tid = tidx(), wid = tid >> 6;
  const int bl = u >> 5, blk = (u >> 2) & 7, q4 = u & 3;
  const bf16_t* WL = (const bf16_t*)(P.ws + OFF_WLRU);
  const bf16_t* XV = (const bf16_t*)(P.ws + OFF_XCV);
  char* As = lds;
  char* Wb = lds + 32768;
  __syncthreads();
  const int wbase = __builtin_amdgcn_readfirstlane(wid) * 1024;
  {
    const int wrow = tid >> 4, wsrc = (tid & 15) ^ (wrow & 15);
#pragma unroll
    for (int r = 0; r < 2; ++r) {
      const bf16_t* ws_ = WL + (size_t)(blk * 512 + r * 256 + q4 * 64 + wrow) * 128 + wsrc * 8;
#pragma unroll
      for (int i = 0; i < 4; ++i) GLDS16(ws_ + (size_t)(16 * i) * 128, Wb + r * 16384 + wbase + i * 4096);
    }
    if (tid < 64) {
      const int r = tid >> 5, c = tid & 31, ch = blk * 128 + q4 * 32 + c;
      const float lm = P.lru_lambda[(l * 2 + r) * 1024 + ch];
      const float sp_ = (lm > 15.f) ? __expf(-lm) : log1pf(__expf(-lm));
      ((f32x4*)(lds + LDS_SEG + 1024))[tid] = (f32x4){sp_, P.lru_ba[(l * 2 + r) * 1024 + ch], P.lru_bi[(l * 2 + r) * 1024 + ch], 0.f};
    }
    const int xrow = tid >> 4, xsrc = (tid & 15) ^ (xrow & 15);
    const int r0 = ML + bl * 256;
#pragma unroll
    for (int i = 0; i < 8; ++i) GLDS16(XV + (size_t)(r0 + xrow + 16 * i) * 1024 + blk * 128 + xsrc * 8, As + wbase + i * 4096);
  }
  const bool ctx_out = (l == 0);
  float hcar[4] = {0.f, 0.f, 0.f, 0.f};
  for (int s = 0; s < 18; ++s) {
    const int row0 = s < 2 ? ML + bl * 256 + s * 128 : bl * 2048 + (s - 2) * 128;
    const int sn = s + 1;
    const int nrow0 = sn < 18 ? (sn < 2 ? ML + bl * 256 + sn * 128 : bl * 2048 + (sn - 2) * 128) : ML + bl * 256 + 128;
    lru_seq_step<0>(P, l, row0, blk, q4, s >= 2 || ctx_out, hcar, As, Wb, lds, nrow0, true);
  }
#pragma unroll
  for (int j = 0; j < 4; ++j) hcar[j] = 0.f;
  for (int s = 0; s < 18; ++s) {
    const int row0 = s < 2 ? ML + bl * 256 + (1 - s) * 128 : bl * 2048 + (15 - (s - 2)) * 128;
    const int sn = s + 1;
    const int nrow0 = sn < 2 ? ML + bl * 256 + (1 - sn) * 128 : bl * 2048 + (15 - (sn - 2)) * 128;
    lru_seq_step<1>(P, l, row0, blk, q4, s >= 2 || ctx_out, hcar, As, Wb + 16384, lds, nrow0, sn < 18);
  }
  asm volatile("s_waitcnt vmcnt(0)" ::: "memory");
  __syncthreads();
}

DI void pc_phase(const Params& P, int l, int half, char* lds) {
  const int tid = tidx(), lane = tid & 63, wid = tid >> 6, wr = wid >> 1, wc = wid & 1, fr = lane & 15, fq = lane >> 4;
  constexpr int MT = MH / 128;
  constexpr int NU_LRU = (MH / 8) * 128 / 256, NU_UQ = MT * 12, NU_UKV = MT * 16;
  const bf16_t* CQKV = (const bf16_t*)(P.ws + OFF_CQKV);
  const float* rs = (const float*)(lds + LDS_RS);
  const float* RMc = (const float*)(P.ws + OFF_RM); const float* RMs = RMc + 2048 * 16;
  for (int u = blockIdx.x; u < NU_LRU + NU_UQ + NU_UKV; u += gridDim.x) {
    if (u < NU_LRU) { conv_items(P, l, u * 256, (MH / 8) * 128); continue; }
    if (u < NU_LRU + NU_UQ) {
      const int v = u - NU_LRU, tn = v / MT, tm = v % MT;
      const bf16_t* A = CQKV + (size_t)tm * 128 * 768;
      __syncthreads();
      f32x4 acc[4][4]; zero_acc<4>(acc);
      gemm_core<4, 384>(acc, A, 768, (const bf16_t*)(P.ws + OFF_WUQ) + (size_t)tn * 128 * 384, 384, 384, lds);
      bf16_t* O = (bf16_t*)(P.ws + OFF_QM);
#pragma unroll
      for (int mi = 0; mi < 4; ++mi) {
        const int rl = wr * 64 + mi * 16 + fr; const float s = rs[rl];
#pragma unroll
        for (int ni = 0; ni < 4; ++ni) store4bf(O + (size_t)(tm * 128 + rl) * 1536 + tn * 128 + wc * 64 + ni * 16 + fq * 4, acc[mi][ni] * s);
      }
    } else {
      const int v = u - NU_LRU - NU_UQ, h = v / MT, tm = v % MT;
      const bf16_t* A = CQKV + (size_t)tm * 128 * 768 + 384;
      __syncthreads();
      f32x4 acc[4][4]; zero_acc<4>(acc);
      gemm_core<4, 256>(acc, A, 768, (const bf16_t*)(P.ws + OFF_WUKV) + (size_t)h * 128 * 256, 256, 256, lds);
      if (wc == 0) {
        bf16_t* O = (bf16_t*)(P.ws + OFF_KM);
        const float* kg = P.mla_k_g + l * 96;
#pragma unroll
        for (int mi = 0; mi < 4; ++mi) {
          const int rl = wr * 64 + mi * 16 + fr, row = tm * 128 + rl; const float s = rs[rl]; const RowInfo ri = rowinfo(row);
          const uint4 kr = *(const uint4*)(CQKV + (size_t)row * 768 + 640 + fq * 8);
          float k8[8] = {lo2f(kr.x), hi2f(kr.x), lo2f(kr.y), hi2f(kr.y), lo2f(kr.z), hi2f(kr.z), lo2f(kr.w), hi2f(kr.w)};
          float ss = 0.f;
#pragma unroll
          for (int e = 0; e < 8; ++e) ss += k8[e] * k8[e];
          f32x4 vv[4];
#pragma unroll
          for (int ni = 0; ni < 4; ++ni) { vv[ni] = acc[mi][ni] * s;
#pragma unroll
            for (int j = 0; j < 4; ++j) ss += vv[ni][j] * vv[ni][j]; }
          ss += __shfl_xor(ss, 16); ss += __shfl_xor(ss, 32);
          const float rstd = rsqrtf(ss * (1.0f / 96.0f) + EPS);
          bf16_t* orow = O + (size_t)row * 1536 + h * 96;
#pragma unroll
          for (int ni = 0; ni < 4; ++ni) { const int d0 = ni * 16 + fq * 4; const f32x4 gg = *(const f32x4*)(kg + d0); store4bf(orow + d0, vv[ni] * rstd * gg); }
#pragma unroll
          for (int e = 0; e < 8; ++e) k8[e] *= rstd * kg[64 + fq * 8 + e];
          if (!ri.isctx) {
#pragma unroll
            for (int e = 0; e < 4; ++e) {
              const int pi = fq * 4 + e; const float c = RMc[ri.t * 16 + pi], sn = RMs[ri.t * 16 + pi];
              const float x1 = k8[2 * e], x2 = k8[2 * e + 1]; k8[2 * e] = x1 * c - x2 * sn; k8[2 * e + 1] = x1 * sn + x2 * c;
            }
          }
          uint4 o; o.x = pack2(k8[0], k8[1]); o.y = pack2(k8[2], k8[3]); o.z = pack2(k8[4], k8[5]); o.w = pack2(k8[6], k8[7]);
          *(uint4*)(orow + 64 + fq * 8) = o;
        }
      } else {
        bf16_t* O = (bf16_t*)(P.ws + OFF_VMT);
#pragma unroll
        for (int mi = 0; mi < 4; ++mi) {
          const int rl = wr * 64 + mi * 16 + fr, row = tm * 128 + rl; const float s = rs[rl]; const RowInfo ri = rowinfo(row);
          const int pos = keypos(ri.isctx ? 2048 + ri.t : ri.t);
          bf16_t* ob = O + ((size_t)(ri.bl * 16 + h) * 64) * NKEY + pos;
#pragma unroll
          for (int ni = 0; ni < 4; ++ni)
#pragma unroll
            for (int j = 0; j < 4; ++j) ob[(size_t)(ni * 16 + fq * 4 + j) * NKEY] = f2bf(acc[mi][ni][j] * s);
        }
      }
    }
  }
}

struct QFrag { bf16x8 f0, f1, f2, f3, f4, f5; };
template <int KS> DI bf16x8 mla_qfrag(uint4 v, float rstd, const float* qg, int hh, int isctx, int t, const float* RMc, const float* RMs, float qscale) {
  float q[8] = {lo2f(v.x), hi2f(v.x), lo2f(v.y), hi2f(v.y), lo2f(v.z), hi2f(v.z), lo2f(v.w), hi2f(v.w)};
#pragma unroll
  for (int e = 0; e < 8; ++e) q[e] *= rstd * qg[KS * 16 + hh * 8 + e];
  if constexpr (KS >= 4) {
#pragma unroll
    for (int e = 0; e < 4; ++e) {
      const int pi = (KS - 4) * 8 + hh * 4 + e; const float c = isctx ? 1.0f : RMc[t * 16 + pi], sn = isctx ? 0.0f : RMs[t * 16 + pi];
      const float x1 = q[2 * e], x2 = q[2 * e + 1]; q[2 * e] = x1 * c - x2 * sn; q[2 * e + 1] = x1 * sn + x2 * c;
    }
  }
  uint4 w; w.x = pack2(q[0] * qscale, q[1] * qscale); w.y = pack2(q[2] * qscale, q[3] * qscale); w.z = pack2(q[4] * qscale, q[5] * qscale); w.w = pack2(q[6] * qscale, q[7] * qscale);
  return __builtin_bit_cast(bf16x8, w);
}
DI bf16x8 scale_qfrag(uint4 v, float qscale) {
  uint4 w; w.x = pack2(lo2f(v.x) * qscale, hi2f(v.x) * qscale); w.y = pack2(lo2f(v.y) * qscale, hi2f(v.y) * qscale);
  w.z = pack2(lo2f(v.z) * qscale, hi2f(v.z) * qscale); w.w = pack2(lo2f(v.w) * qscale, hi2f(v.w) * qscale);
  return __builtin_bit_cast(bf16x8, w);
}
template <int DK, int DV>
DI void attn_prestage(const bf16_t* __restrict__ Kb, int kstride, const bf16_t* __restrict__ Vt, int bl, int kt0, char* lds) {
  constexpr int KROW = (DK == 96) ? 256 : 128;
  constexpr int STG = 64 * KROW + DV * 128;
  const int tid = tidx();
  const int wbase = __builtin_amdgcn_readfirstlane(tid >> 6) * 1024;
  const int vrow = tid >> 3, vsrc = (tid & 7) ^ ((vrow >> 1) & 7);
  const int krow = (DK == 96) ? (tid >> 4) : (tid >> 3);
  const int ksrc = (DK == 96) ? ((tid & 15) ^ (krow & 15)) : ((tid & 7) ^ ((krow >> 1) & 7));
  __syncthreads();
#pragma unroll
  for (int s = 0; s < 2; ++s) {
    const int kt_ = kt0 + s; const int keyrow0 = kt_ < 32 ? bl * 2048 + kt_ * 64 : ML + bl * 256 + (kt_ - 32) * 64;
    char* kd_ = lds + s * STG + wbase; char* vd_ = kd_ + 64 * KROW;
    if (DK == 96) { if (ksrc < 12) {
#pragma unroll
        for (int i = 0; i < 4; ++i) GLDS16(Kb + (size_t)(keyrow0 + krow + 16 * i) * kstride + ksrc * 8, kd_ + i * 4096); } }
    else {
#pragma unroll
      for (int i = 0; i < 2; ++i) GLDS16(Kb + (size_t)(keyrow0 + krow + 32 * i) * kstride + ksrc * 8, kd_ + i * 4096); }
#pragma unroll
    for (int i = 0; i < DV / 32; ++i) GLDS16(Vt + (size_t)(vrow + 32 * i) * NKEY + kt_ * 64 + vsrc * 8, vd_ + i * 4096);
  }
}
template <int DK, int DV, bool PRE = false>
DI void attn_stream(f32x16 (&O)[DV / 32], float& lsum, const QFrag& qf, const bf16_t* __restrict__ Kb, int kstride, const bf16_t* __restrict__ Vt,
                    int bl, int kt0, int kt1, char* lds) {
  constexpr int KROW = (DK == 96) ? 256 : 128;
  constexpr int STG = 64 * KROW + DV * 128;
  const int tid = tidx(), lane = tid & 63, r = lane & 31, hh = lane >> 5;
  const int wbase = __builtin_amdgcn_readfirstlane(tid >> 6) * 1024;
  const int vrow = tid >> 3, vsrc = (tid & 7) ^ ((vrow >> 1) & 7);
  const int krow = (DK == 96) ? (tid >> 4) : (tid >> 3);
  const int ksrc = (DK == 96) ? ((tid & 15) ^ (krow & 15)) : ((tid & 7) ^ ((krow >> 1) & 7));
#define ATT_STAGE(KT, BUF) do { const int kt_ = (KT); const int keyrow0 = kt_ < 32 ? bl * 2048 + kt_ * 64 : ML + bl * 256 + (kt_ - 32) * 64; \
    char* kd_ = lds + (BUF) * STG + wbase; char* vd_ = kd_ + 64 * KROW; \
    if (DK == 96) { if (ksrc < 12) { _Pragma("unroll") for (int i = 0; i < 4; ++i) GLDS16(Kb + (size_t)(keyrow0 + krow + 16 * i) * kstride + ksrc * 8, kd_ + i * 4096); } } \
    else { _Pragma("unroll") for (int i = 0; i < 2; ++i) GLDS16(Kb + (size_t)(keyrow0 + krow + 32 * i) * kstride + ksrc * 8, kd_ + i * 4096); } \
    _Pragma("unroll") for (int i = 0; i < DV / 32; ++i) GLDS16(Vt + (size_t)(vrow + 32 * i) * NKEY + kt_ * 64 + vsrc * 8, vd_ + i * 4096); } while (0)
  float mrun = -1e30f; lsum = 0.f;
#pragma unroll
  for (int b = 0; b < DV / 32; ++b)
#pragma unroll
    for (int i = 0; i < 16; ++i) O[b][i] = 0.f;
  if (!PRE) { __syncthreads(); ATT_STAGE(kt0, 0); ATT_STAGE(kt0 + 1, 1); }
  int buf = 0, nbuf = 2;
  for (int kt = kt0; kt < kt1; ++kt) {
    if (kt + 1 < kt1) asm volatile("s_waitcnt vmcnt(6)" ::: "memory"); else asm volatile("s_waitcnt vmcnt(0)" ::: "memory");
    asm volatile("s_waitcnt lgkmcnt(0)" ::: "memory");
    __builtin_amdgcn_s_barrier();
    asm volatile("" ::: "memory");
    if (kt + 2 < kt1) ATT_STAGE(kt + 2, nbuf);
    const char* ks_ = lds + buf * STG; const char* vs_ = ks_ + 64 * KROW;
    f32x16 S[2];
    {
      const char* kp0 = ks_ + r * KROW; const char* kp1 = kp0 + 32 * KROW;
      const int ksw = (DK == 96) ? (r & 15) : ((r >> 1) & 7);
      constexpr int NKS = DK / 16;
      bf16x8 ka[NKS], kc[NKS];
#pragma unroll
      for (int i = 0; i < NKS; ++i) { const int co = ((i * 2 + hh) ^ ksw) * 16; ka[i] = *(const bf16x8*)(kp0 + co); kc[i] = *(const bf16x8*)(kp1 + co); }
      f32x16 zc;
#pragma unroll
      for (int i = 0; i < 16; ++i) zc[i] = 0.f;
      S[0] = __builtin_amdgcn_mfma_f32_32x32x16_bf16(ka[0], qf.f0, zc, 0, 0, 0);
      S[1] = __builtin_amdgcn_mfma_f32_32x32x16_bf16(kc[0], qf.f0, zc, 0, 0, 0);
#define QK_STEP(i) S[0] = __builtin_amdgcn_mfma_f32_32x32x16_bf16(ka[i], qf.f##i, S[0], 0, 0, 0); S[1] = __builtin_amdgcn_mfma_f32_32x32x16_bf16(kc[i], qf.f##i, S[1], 0, 0, 0)
      QK_STEP(1); QK_STEP(2); QK_STEP(3);
      if constexpr (DK == 96) { QK_STEP(4); QK_STEP(5); }
#undef QK_STEP
    }
    bf16x8 vpre[DV / 32][2];
#pragma unroll
    for (int b = 0; b < DV / 32; ++b)
#pragma unroll
      for (int s = 0; s < 2; ++s) vpre[b][s] = *(const bf16x8*)(vs_ + (b * 32 + r) * 128 + (((0 * 4 + s * 2 + hh) ^ ((r >> 1) & 7)) * 16));
    float mx = S[0][0];
#pragma unroll
    for (int kb = 0; kb < 2; ++kb)
#pragma unroll
      for (int i = 0; i < 16; ++i) mx = fmaxf(mx, S[kb][i]);
    { const auto sw_ = __builtin_amdgcn_permlane32_swap(__float_as_uint(mx), __float_as_uint(mx), false, false); mx = fmaxf(__uint_as_float(sw_[0]), __uint_as_float(sw_[1])); }
    const float mnew = fmaxf(mrun, mx);
    const float alpha = __builtin_amdgcn_exp2f(mrun - mnew);
    mrun = mnew;
    f32x2n psa = {0.f, 0.f}, psb = {0.f, 0.f};
    const f32x2n m2 = {mnew, mnew};
#pragma unroll
    for (int kb = 0; kb < 2; ++kb)
#pragma unroll
      for (int i = 0; i < 16; i += 4) {
        const f32x2n d0 = (f32x2n){S[kb][i], S[kb][i + 1]} - m2, d1 = (f32x2n){S[kb][i + 2], S[kb][i + 3]} - m2;
        const f32x2n e0 = {__builtin_amdgcn_exp2f(d0[0]), __builtin_amdgcn_exp2f(d0[1])}, e1 = {__builtin_amdgcn_exp2f(d1[0]), __builtin_amdgcn_exp2f(d1[1])};
        S[kb][i] = e0[0]; S[kb][i + 1] = e0[1]; S[kb][i + 2] = e1[0]; S[kb][i + 3] = e1[1];
        psa += e0; psb += e1;
      }
    lsum = lsum * alpha + ((psa[0] + psa[1]) + (psb[0] + psb[1]));
#pragma unroll
    for (int b = 0; b < DV / 32; ++b) O[b] = O[b] * alpha;
#pragma unroll
    for (int kb = 0; kb < 2; ++kb)
#pragma unroll
      for (int s = 0; s < 2; ++s) {
        uint4 pw; pw.x = pack2(S[kb][8 * s], S[kb][8 * s + 1]); pw.y = pack2(S[kb][8 * s + 2], S[kb][8 * s + 3]);
        pw.z = pack2(S[kb][8 * s + 4], S[kb][8 * s + 5]); pw.w = pack2(S[kb][8 * s + 6], S[kb][8 * s + 7]);
        const bf16x8 pf = __builtin_bit_cast(bf16x8, pw);
#pragma unroll
        for (int b = 0; b < DV / 32; ++b) {
          const bf16x8 vf = (kb == 0) ? vpre[b][s] : *(const bf16x8*)(vs_ + (b * 32 + r) * 128 + (((kb * 4 + s * 2 + hh) ^ ((r >> 1) & 7)) * 16));
          O[b] = __builtin_amdgcn_mfma_f32_32x32x16_bf16(vf, pf, O[b], 0, 0, 0);
        }
      }
    buf = (buf == 2) ? 0 : buf + 1; nbuf = (nbuf == 2) ? 0 : nbuf + 1;
  }
  __syncthreads();
}

DI void mla_unit(const Params& P, int l, int bl, int h, int qt, char* lds) {
  const int lane = tidx() & 63, wid = tidx() >> 6, r = lane & 31, hh = lane >> 5;
  const int isctx = qt >= 16;
  const int row = (isctx ? ML + bl * 256 + (qt - 16) * 128 : bl * 2048 + qt * 128) + wid * 32 + r;
  const int t = isctx ? 0 : qt * 128 + wid * 32 + r;
  attn_prestage<96, 64>((const bf16_t*)(P.ws + OFF_KM) + h * 96, 1536, (const bf16_t*)(P.ws + OFF_VMT) + ((size_t)(bl * 16 + h) * 64) * NKEY, bl, isctx ? 32 : 0, lds);
  const bf16_t* qp = (const bf16_t*)(P.ws + OFF_QM) + (size_t)row * 1536 + h * 96;
  const float* qg = P.mla_q_g + l * 96;
  const float* RMc = (const float*)(P.ws + OFF_RM); const float* RMs = RMc + 2048 * 16;
  const uint4 r0 = *(const uint4*)(qp + 0 * 16 + hh * 8), r1 = *(const uint4*)(qp + 1 * 16 + hh * 8), r2 = *(const uint4*)(qp + 2 * 16 + hh * 8),
              r3 = *(const uint4*)(qp + 3 * 16 + hh * 8), r4 = *(const uint4*)(qp + 4 * 16 + hh * 8), r5 = *(const uint4*)(qp + 5 * 16 + hh * 8);
  float ss = ssq8(r0) + ssq8(r1) + ssq8(r2) + ssq8(r3) + ssq8(r4) + ssq8(r5);
  ss += __shfl_xor(ss, 32);
  const float rstd = rsqrtf(ss * (1.0f / 96.0f) + EPS);
  const float qscale = 0.10206207261596577f * LOG2E;
  QFrag qf;
  qf.f0 = mla_qfrag<0>(r0, rstd, qg, hh, isctx, t, RMc, RMs, qscale); qf.f1 = mla_qfrag<1>(r1, rstd, qg, hh, isctx, t, RMc, RMs, qscale);
  qf.f2 = mla_qfrag<2>(r2, rstd, qg, hh, isctx, t, RMc, RMs, qscale); qf.f3 = mla_qfrag<3>(r3, rstd, qg, hh, isctx, t, RMc, RMs, qscale);
  qf.f4 = mla_qfrag<4>(r4, rstd, qg, hh, isctx, t, RMc, RMs, qscale); qf.f5 = mla_qfrag<5>(r5, rstd, qg, hh, isctx, t, RMc, RMs, qscale);
  f32x16 O[2]; float lsum;
  attn_stream<96, 64, true>(O, lsum, qf, (const bf16_t*)(P.ws + OFF_KM) + h * 96, 1536, (const bf16_t*)(P.ws + OFF_VMT) + ((size_t)(bl * 16 + h) * 64) * NKEY, bl, isctx ? 32 : 0, 36, lds);
  lsum += __shfl_xor(lsum, 32);
  const float inv = 1.0f / lsum;
  bf16_t* op = (bf16_t*)(P.ws + OFF_OB) + (size_t)row * 1024 + h * 64;
#pragma unroll
  for (int b = 0; b < 2; ++b)
#pragma unroll
    for (int g = 0; g < 4; ++g) {
      const f32x4 v = {O[b][4 * g] * inv, O[b][4 * g + 1] * inv, O[b][4 * g + 2] * inv, O[b][4 * g + 3] * inv};
      store4bf(op + b * 32 + 8 * g + 4 * hh, v);
    }
}

DI void diff_unit(const Params& P, int l, int bl, int h, int qt, char* lds) {
  const int lane = tidx() & 63, wid = tidx() >> 6, r = lane & 31, hh = lane >> 5;
  const int isctx = qt >= 16;
  const int row = (isctx ? ML + bl * 256 + (qt - 16) * 128 : bl * 2048 + qt * 128) + wid * 32 + r;
  bf16_t* qp = (bf16_t*)(P.ws + OFF_DQ) + (size_t)row * 1024 + h * 128;
  const bf16_t* Vt = (const bf16_t*)(P.ws + OFF_DVT) + ((size_t)(bl * 8 + h) * 128) * NKEY;
  const float qscale = 0.125f * LOG2E;
  const float lam = ((const float*)(P.ws + OFF_LAM))[l];
  f32x16 O[4]; float lsum;
  attn_prestage<64, 128>((const bf16_t*)(P.ws + OFF_DK) + h * 128, 1024, Vt, bl, isctx ? 32 : 0, lds);
  QFrag qa, qb;
  qa.f0 = scale_qfrag(*(const uint4*)(qp + 0 * 16 + hh * 8), qscale); qa.f1 = scale_qfrag(*(const uint4*)(qp + 1 * 16 + hh * 8), qscale);
  qa.f2 = scale_qfrag(*(const uint4*)(qp + 2 * 16 + hh * 8), qscale); qa.f3 = scale_qfrag(*(const uint4*)(qp + 3 * 16 + hh * 8), qscale);
  qa.f4 = qa.f0; qa.f5 = qa.f0;
  qb.f0 = scale_qfrag(*(const uint4*)(qp + 64 + 0 * 16 + hh * 8), qscale); qb.f1 = scale_qfrag(*(const uint4*)(qp + 64 + 1 * 16 + hh * 8), qscale);
  qb.f2 = scale_qfrag(*(const uint4*)(qp + 64 + 2 * 16 + hh * 8), qscale); qb.f3 = scale_qfrag(*(const uint4*)(qp + 64 + 3 * 16 + hh * 8), qscale);
  qb.f4 = qb.f0; qb.f5 = qb.f0;
  attn_stream<64, 128, true>(O, lsum, qa, (const bf16_t*)(P.ws + OFF_DK) + h * 128, 1024, Vt, bl, isctx ? 32 : 0, 36, lds);
  attn_prestage<64, 128>((const bf16_t*)(P.ws + OFF_DK) + h * 128 + 64, 1024, Vt, bl, isctx ? 32 : 0, lds);
  lsum += __shfl_xor(lsum, 32);
  {
    const float inv = 1.0f / lsum;
#pragma unroll
    for (int b = 0; b < 4; ++b)
#pragma unroll
      for (int g = 0; g < 4; ++g) {
        const f32x4 v = {O[b][4 * g] * inv, O[b][4 * g + 1] * inv, O[b][4 * g + 2] * inv, O[b][4 * g + 3] * inv};
        store4bf(qp + b * 32 + 8 * g + 4 * hh, v);
      }
  }
  attn_stream<64, 128, true>(O, lsum, qb, (const bf16_t*)(P.ws + OFF_DK) + h * 128 + 64, 1024, Vt, bl, isctx ? 32 : 0, 36, lds);
  lsum += __shfl_xor(lsum, 32);
  {
    const float inv = lam / lsum;
    float ss = 0.f;
#pragma unroll
    for (int b = 0; b < 4; ++b)
#pragma unroll
      for (int g = 0; g < 4; ++g) {
        const uint2 w = *(const uint2*)(qp + b * 32 + 8 * g + 4 * hh);
        const float a0 = lo2f(w.x) - O[b][4 * g] * inv, a1 = hi2f(w.x) - O[b][4 * g + 1] * inv, a2 = lo2f(w.y) - O[b][4 * g + 2] * inv, a3 = hi2f(w.y) - O[b][4 * g + 3] * inv;
        O[b][4 * g] = a0; O[b][4 * g + 1] = a1; O[b][4 * g + 2] = a2; O[b][4 * g + 3] = a3;
        ss += a0 * a0 + a1 * a1 + a2 * a2 + a3 * a3;
      }
    ss += __shfl_xor(ss, 32);
    const float rstd = rsqrtf(ss * (1.0f / 128.0f) + EPS) * (1.0f - lam_init_of(l));
    const float* sg = P.diff_subln_g + l * 128;
#pragma unroll
    for (int b = 0; b < 4; ++b)
#pragma unroll
      for (int g = 0; g < 4; ++g) {
        const int dv0 = b * 32 + 8 * g + 4 * hh;
        const f32x4 gg = *(const f32x4*)(sg + dv0);
        const f32x4 v = {O[b][4 * g] * rstd * gg[0], O[b][4 * g + 1] * rstd * gg[1], O[b][4 * g + 2] * rstd * gg[2], O[b][4 * g + 3] * rstd * gg[3]};
        store4bf(qp + dv0, v);
      }
  }
}

DI void pd_phase(const Params& P, int l, int half, int ph, char* lds) {
  const int nq_ctx = (l == 0) ? 2 : 0;
  const int n_dl = HB * 8 * 16, n_lru = HB * 8 * 4, n_ml = HB * 16 * 16, n_dc = HB * 8 * nq_ctx, n_mc = HB * 16 * nq_ctx;
  const int tot = n_dl + n_lru + n_ml + n_dc + n_mc;
  unsigned* ctr = (unsigned*)(P.ws + OFF_CTR) + ph * 8;
  volatile int* slot = (volatile int*)(lds + LDS_BAR + 8);
  const int myx = (int)((unsigned)__builtin_amdgcn_s_getreg((3 << 11) | 20) & 7u);
  for (;;) {
    __syncthreads();
    if (threadIdx.x == 0) {
      int got = -1;
      for (int y = 0; y < 8 && got < 0; ++y) {
        const int xx = (myx + y) & 7;
        const int i = (int)__hip_atomic_fetch_add(ctr + xx, 1u, __ATOMIC_RELAXED, __HIP_MEMORY_SCOPE_AGENT);
        const int uu = i * 8 + xx;
        if (uu < tot) got = uu;
      }
      *slot = got;
    }
    __syncthreads();
    const int u = *slot;
    if (u < 0) break;
    int v = u, kind, bl = 0, h = 0, qt = 0;
    if (v < n_dl) { kind = 0; const int x = v & 7, s = (v >> 3) & 63, rnd = v >> 9; const int g = x + 8 * ((s >> 4) + 4 * rnd); qt = s & 15; bl = g >> 3; h = g & 7; }
    else if ((v -= n_dl) < n_lru) { kind = 2; }
    else if ((v -= n_lru) < n_ml) { kind = 1; const int x = v & 7, s = (v >> 3) & 63, rnd = v >> 9; const int g = x + 8 * ((s >> 4) + 4 * rnd); qt = s & 15; bl = g >> 4; h = g & 15; }
    else if ((v -= n_ml) < n_dc) { kind = 0; bl = v >> 4; h = (v >> 1) & 7; qt = 16 + (v & 1); }
    else { v -= n_dc; kind = 1; bl = v >> 5; h = (v >> 1) & 15; qt = 16 + (v & 1); }
#ifndef NO_DIFF
    if (kind == 0) diff_unit(P, l, bl, h, qt, lds);
#endif
#ifndef NO_MLA
    if (kind == 1) mla_unit(P, l, bl, h, qt, lds);
#endif
#ifndef NO_LRUF
    if (kind == 2) lru_seq_unit(P, l, v, lds);
#endif
  }
}

DI void merge_phase(const Params& P, int l, int half, int MT, char* lds) {
  const int tid = tidx(), lane = tid & 63, wid = tid >> 6, wr = wid >> 1, wc = wid & 1, fr = lane & 15, fq = lane >> 4;
  const bf16_t* H = (const bf16_t*)(P.ws + OFF_HBF);
  bf16_t* Z = (bf16_t*)(P.ws + OFF_RX);
  for (int u = blockIdx.x; u < MT * 16; u += gridDim.x) {
    const int tn = u / MT, tm = u % MT, n0 = tn * 64;
    f32x4 z[4][2]; zero_acc<2>(z);
#pragma unroll 1
    for (int br = 0; br < 3; ++br) {
      const bf16_t* Ab = (const bf16_t*)(P.ws + (br == 0 ? OFF_GRG : br == 1 ? OFF_OB : OFF_DQ));
      const bf16_t* Wb = (const bf16_t*)(P.ws + OFF_WBRA + (size_t)br * (OFF_WBRB - OFF_WBRA));
      f32x4 g[4][2]; zero_acc<2>(g);
      gemm_core<2>(g, H + (size_t)tm * 128 * 1024, 1024, (const bf16_t*)(P.ws + OFF_WMG) + (size_t)(br * 1024 + n0) * 1024, 1024, 1024, lds);
#pragma unroll
      for (int mi = 0; mi < 4; ++mi)
#pragma unroll
        for (int ni = 0; ni < 2; ++ni)
#pragma unroll
          for (int j = 0; j < 4; ++j) g[mi][ni][j] = sigmoidf_(g[mi][ni][j]);
      f32x4 v[4][2]; zero_acc<2>(v);
      gemm_core<2>(v, Ab + (size_t)tm * 128 * 1024, 1024, Wb + (size_t)n0 * 1024, 1024, 1024, lds);
#pragma unroll
      for (int mi = 0; mi < 4; ++mi)
#pragma unroll
        for (int ni = 0; ni < 2; ++ni) z[mi][ni] += g[mi][ni] * v[mi][ni];
    }
#pragma unroll
    for (int mi = 0; mi < 4; ++mi)
#pragma unroll
      for (int ni = 0; ni < 2; ++ni) store4bf(Z + (size_t)(tm * 128 + wr * 64 + mi * 16 + fr) * 1024 + n0 + wc * 32 + ni * 16 + fq * 4, z[mi][ni]);
  }
}

DI void resid_gemm_phase(const Params& P, int l, int half_, int MT, const bf16_t* A, int K, const bf16_t* W, int goff, bool src_is_input, char* lds, int rph = 0) {
  const int tid = tidx(), lane = tid & 63, wid = tid >> 6, wr = wid >> 1, wc = wid & 1, fr = lane & 15, fq = lane >> 4;
  const float* MOD = (const float*)(P.ws + OFF_MOD) + (size_t)l * 9 * 6144 + goff;
  for (int u = blockIdx.x; u < MT * 16; u += gridDim.x) {
    const int L_ = u >> 3, tm = (u & 7) + 8 * (L_ >> 4), tn = L_ & 15, n0 = tn * 64;
    f32x4 acc[4][2]; zero_acc<2>(acc);
    gemm_core<2>(acc, A + (size_t)tm * 128 * K, K, W + (size_t)n0 * K, K, K, lds);
#pragma unroll
    for (int mi = 0; mi < 4; ++mi) {
      const int grow = tm * 128 + wr * 64 + mi * 16 + fr;
      const int half = rph ? grow / rph : half_, row = rph ? grow % rph : grow; const RowInfo ri = rowinfo(row);
      const float* md = MOD + (size_t)(ri.isctx ? 8 : half * HB + ri.bl) * 6144;
      float* dst = resid_ptr(P, half, row);
      const float* src = src_is_input ? input_ptr(P, half, row) : dst;
#pragma unroll
      for (int ni = 0; ni < 2; ++ni) {
        const int c0 = n0 + wc * 32 + ni * 16 + fq * 4;
        const f32x4 gt = *(const f32x4*)(md + c0), sv = *(const f32x4*)(src + c0);
        *(f32x4*)(dst + c0) = sv + gt * acc[mi][ni];
      }
    }
  }
}

DI void ffn_in_phase(const Params& P, int l, int half, int MT, char* lds) {
  const int tid = tidx(), lane = tid & 63, wid = tid >> 6, wr = wid >> 1, wc = wid & 1, fr = lane & 15, fq = lane >> 4;
  const bf16_t* H = (const bf16_t*)(P.ws + OFF_HBF);
  bf16_t* HH = (bf16_t*)(P.ws + OFF_DQ);
  for (int u = blockIdx.x; u < MT * 44; u += gridDim.x) {
    const int L_ = u >> 3, m8_ = MT >> 3;
    int tn, tm;
    if (L_ < 32 * m8_) { const int g_ = L_ / (16 * m8_), Lg = L_ - g_ * 16 * m8_; tn = g_ * 16 + (Lg & 15); tm = (u & 7) + 8 * (Lg >> 4); }
    else { const int Lg = L_ - 32 * m8_; tn = 32 + Lg % 12; tm = (u & 7) + 8 * (Lg / 12); }
    f32x4 acc[4][4]; zero_acc<4>(acc);
    gemm_core<4>(acc, H + (size_t)tm * 128 * 1024, 1024, (const bf16_t*)(P.ws + OFF_WFI) + (size_t)tn * 128 * 1024, 1024, 1024, lds);
#pragma unroll
    for (int mi = 0; mi < 4; ++mi) {
      const int row = tm * 128 + wr * 64 + mi * 16 + fr;
#pragma unroll
      for (int q = 0; q < 2; ++q) {
        f32x4 v;
#pragma unroll
        for (int j = 0; j < 4; ++j) v[j] = siluf_(acc[mi][2 * q][j]) * acc[mi][2 * q + 1][j];
        store4bf(HH + (size_t)row * FH + tn * 64 + (wc * 2 + q) * 16 + fq * 4, v);
      }
    }
  }
}

#define XB_TMO      128
#define XB_XCNT(j)  (256  + 64 * (j))
#define XB_XSUB(j)  (1280 + 64 * (j))
#define XB_XGEN(j)  (2304 + 64 * (j))
#define XB_TOP      3328
#define XB_TOPGEN   3392
#define XCD_BAR_WORDS 3456
#define XB_SPIN_CAP (1u << 20)
#define LAS __attribute__((address_space(3)))
DI unsigned xb_ld(unsigned* p) { return __hip_atomic_load(p, __ATOMIC_RELAXED, __HIP_MEMORY_SCOPE_AGENT); }
DI unsigned xb_add(unsigned* p, unsigned v) { return __hip_atomic_fetch_add(p, v, __ATOMIC_RELAXED, __HIP_MEMORY_SCOPE_AGENT); }
DI unsigned xb_xcc_id() { return (unsigned)__builtin_amdgcn_s_getreg((3 << 11) | 20) & 0xFu; }
#define XB_SPIN(cond, bar) do { unsigned _sp = 0; while (cond) { __builtin_amdgcn_s_sleep(1); \
    if ((++_sp & 255u) == 0u) { if (xb_ld(&(bar)[XB_TMO])) break; if (_sp > XB_SPIN_CAP) { atomicAdd(&(bar)[XB_TMO], 1u); break; } } } } while (0)
struct XcdBarrier { unsigned* bar; unsigned x; volatile LAS unsigned* st; };
DI XcdBarrier xcd_barrier_post(unsigned* bar, volatile LAS unsigned* st) {
  XcdBarrier b; b.bar = bar; b.x = xb_xcc_id(); b.st = st;
  if (threadIdx.x == 0) (void)xb_add(&bar[XB_XCNT(b.x)], 1u);
  return b;
}
DI void xcd_barrier_complete(unsigned* bar, unsigned x, unsigned& nloc, unsigned& nx) {
  const unsigned G = gridDim.x * gridDim.y * gridDim.z;
  unsigned sum, cnt, mine, sp = 0u;
  for (;;) {
    sum = 0u; cnt = 0u; mine = 0u;
#pragma unroll
    for (unsigned j = 0; j < 16; ++j) { const unsigned c = xb_ld(&bar[XB_XCNT(j)]); sum += c; cnt += (c > 0u) ? 1u : 0u; mine = (j == x) ? c : mine; }
    if (sum == G) break;
    __builtin_amdgcn_s_sleep(1);
    if ((++sp & 255u) == 0u) { if (xb_ld(&bar[XB_TMO])) break; if (sp > XB_SPIN_CAP) { atomicAdd(&bar[XB_TMO], 1u); break; } }
  }
  nloc = mine > 0u ? mine : 1u; nx = cnt > 0u ? cnt : 1u;
}
DI void xcd_barrier(const XcdBarrier& b) {
  asm volatile("s_waitcnt vmcnt(0)" ::: "memory");
  __syncthreads();
  if (threadIdx.x == 0) {
    unsigned* bar = b.bar;
    __builtin_amdgcn_s_waitcnt(0);
    unsigned nloc = b.st[0], nx = b.st[1];
    if (nloc == 0u) { xcd_barrier_complete(bar, b.x, nloc, nx); b.st[0] = nloc; b.st[1] = nx; }
    const unsigned old = xb_add(&bar[XB_XSUB(b.x)], 1u);
    const unsigned gen = old / nloc;
    if (old + 1u == (gen + 1u) * nloc) {
      __builtin_amdgcn_fence(__ATOMIC_RELEASE, "agent");
      asm volatile("s_waitcnt vmcnt(0)" ::: "memory");
      const unsigned og = xb_add(&bar[XB_TOP], 1u);
      const unsigned tg = og / nx;
      if (og + 1u == (tg + 1u) * nx) xb_add(&bar[XB_TOPGEN], 1u);
      else XB_SPIN(xb_ld(&bar[XB_TOPGEN]) == tg, bar);
      __builtin_amdgcn_fence(__ATOMIC_ACQUIRE, "agent");
      xb_add(&bar[XB_XGEN(b.x)], 1u);
      asm volatile("s_waitcnt vmcnt(0)" ::: "memory");
    } else {
      XB_SPIN(xb_ld(&bar[XB_XGEN(b.x)]) == gen, bar);
      __builtin_amdgcn_fence(__ATOMIC_ACQUIRE, "agent");
      asm volatile("s_waitcnt vmcnt(0)" ::: "memory");
    }
  }
  __syncthreads();
}

constexpr int NPHASE = 1 + 2 * 15;
static_assert(OFF_RX == OFF_HBF + SZ1K, "joint HBF2 spans HBF + RX");
static_assert(OFF_QM - OFF_DQ >= (size_t)2 * MH * FH * 2, "joint HH spans DQ..VMT");
DI void run_phase(const Params& P, int ph, char* lds) {
  if (ph == 0) { phase0(P, lds); return; }
  const int q = ph - 1, l = q / 15, r = q % 15;
  const int MTl = (l == 0) ? MH / 128 : ML / 128;
  if (r >= 12) {
    const int rph = MTl * 128;
    if (r == 12) norm_phase(P, l, 0, 1, 2 * rph, rph);
    else if (r == 13) ffn_in_phase(P, l, 0, 2 * MTl, lds);
    else resid_gemm_phase(P, l, 0, 2 * MTl, (const bf16_t*)(P.ws + OFF_DQ), FH, (const bf16_t*)(P.ws + OFF_WFO), 5120, false, lds, rph);
    return;
  }
  const int half = r / 6, k = r % 6;
  switch (k) {
    case 0: if (half == 0) convert_weights(P, l, lds); norm_phase(P, l, half, 0, MH); break;
    case 1: g1_phase(P, l, half, lds); break;
    case 2: pc_phase(P, l, half, lds); break;
    case 3: pd_phase(P, l, half, ph, lds); break;
    case 4: merge_phase(P, l, half, MTl, lds); break;
    default: resid_gemm_phase(P, l, half, MTl, (const bf16_t*)(P.ws + OFF_RX), 1024, (const bf16_t*)(P.ws + OFF_WOUT), 2048, l == 0, lds); break;
  }
}

__global__ void __launch_bounds__(256, 2) fwd_kernel(Params P, int ph0, int ph1) {
  extern __shared__ __attribute__((aligned(16))) char smem[];
  volatile LAS unsigned* st = (volatile LAS unsigned*)(smem + LDS_BAR);
  if (threadIdx.x < 2) st[threadIdx.x] = 0u;
  __syncthreads();
  const XcdBarrier xb = xcd_barrier_post((unsigned*)(P.ws + OFF_BAR), st);
  for (int ph = ph0; ph < ph1; ++ph) {
    run_phase(P, ph, smem);
    if (ph + 1 < ph1) { if (ph == 0) cg::this_grid().sync(); else xcd_barrier(xb); }
  }
}

extern "C" void kernel_launch(void* const* d_in, const int* in_sizes, int n_in, void* d_out, int out_size, void* d_ws, size_t ws_size, hipStream_t stream) {
  static int grid_blocks = 0;
  if (!grid_blocks) {
    hipFuncSetAttribute((const void*)fwd_kernel, hipFuncAttributeMaxDynamicSharedMemorySize, LDS_BYTES);
    int dev = 0, cus = 0, per_cu = 0;
    hipGetDevice(&dev);
    hipDeviceGetAttribute(&cus, hipDeviceAttributeMultiprocessorCount, dev);
    hipOccupancyMaxActiveBlocksPerMultiprocessor(&per_cu, fwd_kernel, 256, LDS_BYTES);
    if (per_cu > 2) per_cu = 2;
    grid_blocks = cus * per_cu;
    if (grid_blocks <= 0) grid_blocks = 256;
  }
  if (ws_size < WS_NEED) { fprintf(stderr, "workspace too small: %zu < %zu\n", ws_size, (size_t)WS_NEED); return; }
  hipMemsetAsync((char*)d_ws + OFF_BAR, 0, XCD_BAR_WORDS * 4 + 2048, stream);
  Params p{};
  const float** f = (const float**)&p;
  for (int i = 0; i < 32; ++i) f[i] = (const float*)d_in[i];
  p.out = (float*)d_out; p.ws = (char*)d_ws;
#if ONE_LAUNCH
  int ph0 = 0, ph1 = NPHASE;
  void* args[] = {&p, &ph0, &ph1};
  hipError_t e = hipLaunchCooperativeKernel((const void*)fwd_kernel, dim3(grid_blocks), dim3(256), args, LDS_BYTES, stream);
  if (e != hipSuccess) fprintf(stderr, "cooperative launch failed: %s (grid %d)\n", hipGetErrorString(e), grid_blocks);
#else
  for (int ph = 0; ph < NPHASE; ++ph) fwd_kernel<<<grid_blocks, 256, LDS_BYTES, stream>>>(p, ph, ph + 1);
#endif
}
```
